# Optimizing an MI355X kernel written in HIP

```python
import math
import jax, jax.numpy as jnp
from jax import lax
import numpy as np

D_MODEL = 1024
BATCH = 4
SEQ = 4096
DEPTH = 2

N_MIXERS = 2
PLE_DIM = 256
FOX_HEADS = 16
FOX_HEAD_DIM = D_MODEL // FOX_HEADS
FOX_BLOCK = 128
FOX_IN = 3 * D_MODEL + FOX_HEADS
RET_HEADS = 4
RET_KEY_DIM = D_MODEL // RET_HEADS
RET_VAL_DIM = 2 * D_MODEL // RET_HEADS
RET_CHUNK = 128
RET_IN = 2 * D_MODEL + 2 * (2 * D_MODEL)
ROPE_BASE = 10000.0
N_GROUPS = 4
EXPERTS_PER_GROUP = 4
N_EXPERTS = N_GROUPS * EXPERTS_PER_GROUP
D_EXPERT = 512
TOP_K_IN_GROUP = 2
DEEPNORM_ALPHA = (2.0 * DEPTH) ** 0.25
DEEPNORM_BETA = (8.0 * DEPTH) ** -0.25
LN_EPS = 1e-5
N_FOX_LAYERS = (DEPTH + 1) // 2
N_RET_LAYERS = DEPTH // 2

kernel_name = "fox_retnet_interleaved_hmoe_deepnorm"


def layer_norm(x, g, b):
    xf = x.astype(jnp.float32)
    mu = jnp.mean(xf, axis=-1, keepdims=True)
    var = jnp.mean(jnp.square(xf - mu), axis=-1, keepdims=True)
    y = (xf - mu) * lax.rsqrt(var + LN_EPS)
    return (y * g.astype(jnp.float32) + b.astype(jnp.float32)).astype(x.dtype)


def fox_attention(x, w_in, b_f, w_out):
    B, S, _ = x.shape
    H, dh = FOX_HEADS, FOX_HEAD_DIM
    proj = x @ w_in
    q, k, v, f = jnp.split(proj, [D_MODEL, 2 * D_MODEL, 3 * D_MODEL], axis=-1)
    q = q.reshape(B, S, H, dh).transpose(0, 2, 1, 3)
    k = k.reshape(B, S, H, dh).transpose(0, 2, 1, 3)
    v = v.reshape(B, S, H, dh).transpose(0, 2, 1, 3)
    log_f = jax.nn.log_sigmoid((f + b_f).astype(jnp.float32))
    c = jnp.cumsum(log_f, axis=1).transpose(0, 2, 1)
    nb = S // FOX_BLOCK
    q_blocks = q.reshape(B, H, nb, FOX_BLOCK, dh).transpose(2, 0, 1, 3, 4)
    c_blocks = c.reshape(B, H, nb, FOX_BLOCK).transpose(2, 0, 1, 3)
    key_pos = jnp.arange(S)
    scale = FOX_HEAD_DIM ** -0.5

    def one_block(args):
        qb, cb, blk = args
        q_pos = blk * FOX_BLOCK + jnp.arange(FOX_BLOCK)
        s = jnp.einsum('bhqd,bhkd->bhqk', qb, k).astype(jnp.float32) * scale
        s = s + (cb[..., :, None] - c[:, :, None, :])
        s = jnp.where(key_pos[None, :] <= q_pos[:, None], s, -jnp.inf)
        pr = jax.nn.softmax(s, axis=-1).astype(v.dtype)
        return jnp.einsum('bhqk,bhkd->bhqd', pr, v)

    o = lax.map(one_block, (q_blocks, c_blocks, jnp.arange(nb)))
    o = o.transpose(1, 0, 3, 2, 4).reshape(B, S, D_MODEL)
    return o @ w_out


def rotary(x, positions):
    d = x.shape[-1]
    half = d // 2
    inv_freq = ROPE_BASE ** (-jnp.arange(0, d, 2, dtype=jnp.float32) / d)
    ang = positions.astype(jnp.float32)[..., None] * inv_freq
    cos = jnp.cos(ang)[:, :, None, :].astype(x.dtype)
    sin = jnp.sin(ang)[:, :, None, :].astype(x.dtype)
    x1, x2 = x[..., :half], x[..., half:]
    return jnp.concatenate([x1 * cos - x2 * sin, x2 * cos + x1 * sin], axis=-1)


def retention(x, positions, w_in, w_out):
    B, S, _ = x.shape
    H, dk, dv, C = RET_HEADS, RET_KEY_DIM, RET_VAL_DIM, RET_CHUNK
    nc = S // C
    proj = x @ w_in
    q, k, v, g = jnp.split(proj, [D_MODEL, 2 * D_MODEL, 4 * D_MODEL], axis=-1)
    q = rotary(q.reshape(B, S, H, dk), positions)
    k = rotary(k.reshape(B, S, H, dk), positions) * (dk ** -0.5)
    v = v.reshape(B, S, H, dv)

    def to_chunks(t, d):
        return t.reshape(B, nc, C, H, d).transpose(1, 0, 3, 2, 4).astype(jnp.float32)

    qc, kc, vc = to_chunks(q, dk), to_chunks(k, dk), to_chunks(v, dv)
    log_gamma = jnp.log(1.0 - 2.0 ** (-5.0 - jnp.arange(H, dtype=jnp.float32)))
    idx = jnp.arange(C, dtype=jnp.float32)
    diff = idx[:, None] - idx[None, :]
    decay_intra = jnp.where(diff >= 0, jnp.exp(jnp.maximum(diff, 0.0)[None] * log_gamma[:, None, None]), 0.0)
    q_decay = jnp.exp((idx + 1.0)[None, :] * log_gamma[:, None])
    k_decay = jnp.exp((C - 1.0 - idx)[None, :] * log_gamma[:, None])
    chunk_decay = jnp.exp(C * log_gamma)

    def step(state, inp):
        qi, ki, vi = inp
        scores = jnp.einsum('bhid,bhjd->bhij', qi, ki) * decay_intra[None]
        o = jnp.einsum('bhij,bhje->bhie', scores, vi)
        o = o + jnp.einsum('bhid,bhde->bhie', qi * q_decay[None, :, :, None], state)
        new_state = state * chunk_decay[None, :, None, None] + jnp.einsum(
            'bhjd,bhje->bhde', ki * k_decay[None, :, :, None], vi)
        return new_state, o

    state0 = jnp.zeros((B, H, dk, dv), jnp.float32)
    _, o = lax.scan(step, state0, (qc, kc, vc))
    o = o.transpose(1, 0, 3, 2, 4).reshape(B, S, H, dv)
    mu = jnp.mean(o, axis=-1, keepdims=True)
    var = jnp.mean(jnp.square(o - mu), axis=-1, keepdims=True)
    o = ((o - mu) * lax.rsqrt(var + LN_EPS)).reshape(B, S, 2 * D_MODEL).astype(x.dtype)
    return (jax.nn.silu(g) * o) @ w_out


def hierarchical_moe(x, w_group, b_group, w_router, b_router, w_gate, w_up, w_down):
    B, S, _ = x.shape
    xt = x.reshape(B * S, D_MODEL)
    xf = xt.astype(jnp.float32)
    pg = jax.nn.softmax(xf @ w_group.astype(jnp.float32) + b_group.astype(jnp.float32), axis=-1)
    g_val, g_idx = lax.top_k(pg, 1)
    el = (xf @ w_router.astype(jnp.float32) + b_router.astype(jnp.float32)).reshape(-1, N_GROUPS, EXPERTS_PER_GROUP)
    el = jnp.take_along_axis(el, g_idx[:, :, None], axis=1)[:, 0]
    pe = jax.nn.softmax(el, axis=-1)
    e_val, e_idx = lax.top_k(pe, TOP_K_IN_GROUP)
    e_val = e_val / jnp.sum(e_val, axis=-1, keepdims=True)
    weights = g_val * e_val
    expert_ids = g_idx * EXPERTS_PER_GROUP + e_idx
    combine = jnp.sum(jax.nn.one_hot(expert_ids, N_EXPERTS, dtype=jnp.float32) * weights[..., None], axis=1)
    combine = combine.astype(xt.dtype)
    y = jnp.zeros_like(xt)
    for e in range(N_EXPERTS):
        h = jax.nn.silu(xt @ w_gate[e]) * (xt @ w_up[e])
        y = y + combine[:, e:e + 1] * (h @ w_down[e])
    return y.reshape(B, S, D_MODEL)


def setup_inputs(seed: int = 0) -> dict:
    key = jax.random.key(seed)
    ks = jax.random.split(key, 24)
    nrm = jax.random.normal
    D = D_MODEL
    beta = DEEPNORM_BETA
    x = nrm(ks[0], (BATCH, SEQ, D), jnp.float32)
    p = nrm(ks[1], (DEPTH, BATCH, SEQ, PLE_DIM), jnp.float32)
    positions = jnp.broadcast_to(jnp.arange(SEQ, dtype=jnp.int32)[None, :], (BATCH, SEQ))
    fox_w_in = nrm(ks[2], (N_FOX_LAYERS, D, FOX_IN), jnp.float32) * D ** -0.5
    fox_w_in = fox_w_in.at[:, :, 2 * D:3 * D].multiply(beta)
    fox_b_f = jax.random.uniform(ks[3], (N_FOX_LAYERS, FOX_HEADS), jnp.float32, 1.0, 5.0)
    fox_w_out = nrm(ks[4], (N_FOX_LAYERS, D, D), jnp.float32) * D ** -0.5 * beta
    ret_w_in = nrm(ks[5], (N_RET_LAYERS, D, RET_IN), jnp.float32) * D ** -0.5
    ret_w_in = ret_w_in.at[:, :, 2 * D:4 * D].multiply(beta)
    ret_w_out = nrm(ks[6], (N_RET_LAYERS, 2 * D, D), jnp.float32) * (2 * D) ** -0.5 * beta
    ln1_g = 1.0 + 0.05 * nrm(ks[7], (DEPTH, D), jnp.float32)
    ln1_b = 0.02 * nrm(ks[8], (DEPTH, D), jnp.float32)
    ln2_g = 1.0 + 0.05 * nrm(ks[9], (DEPTH, D), jnp.float32)
    ln2_b = 0.02 * nrm(ks[10], (DEPTH, D), jnp.float32)
    moe_w_group = nrm(ks[11], (DEPTH, D, N_GROUPS), jnp.float32) * D ** -0.5
    moe_b_group = 0.01 * nrm(ks[12], (DEPTH, N_GROUPS), jnp.float32)
    moe_w_router = nrm(ks[13], (DEPTH, D, N_EXPERTS), jnp.float32) * D ** -0.5
    moe_b_router = 0.01 * nrm(ks[14], (DEPTH, N_EXPERTS), jnp.float32)
    moe_w_gate = nrm(ks[15], (DEPTH, N_EXPERTS, D, D_EXPERT), jnp.float32) * D ** -0.5
    moe_w_up = nrm(ks[16], (DEPTH, N_EXPERTS, D, D_EXPERT), jnp.float32) * D ** -0.5 * beta
    moe_w_down = nrm(ks[17], (DEPTH, N_EXPERTS, D_EXPERT, D), jnp.float32) * D_EXPERT ** -0.5 * beta
    ple_w_proj = nrm(ks[18], (DEPTH, PLE_DIM, D), jnp.float32) * PLE_DIM ** -0.5
    ple_w_gate = nrm(ks[19], (DEPTH, D, D), jnp.float32) * D ** -0.5
    ple_b_gate = 0.02 * nrm(ks[20], (DEPTH, D), jnp.float32)
    return {"x": x, "p": p, "positions": positions,
            "fox_w_in": fox_w_in, "fox_b_f": fox_b_f, "fox_w_out": fox_w_out,
            "ret_w_in": ret_w_in, "ret_w_out": ret_w_out,
            "ln1_g": ln1_g, "ln1_b": ln1_b, "ln2_g": ln2_g, "ln2_b": ln2_b,
            "moe_w_group": moe_w_group, "moe_b_group": moe_b_group,
            "moe_w_router": moe_w_router, "moe_b_router": moe_b_router,
            "moe_w_gate": moe_w_gate, "moe_w_up": moe_w_up, "moe_w_down": moe_w_down,
            "ple_w_proj": ple_w_proj, "ple_w_gate": ple_w_gate, "ple_b_gate": ple_b_gate}


def reference(x, p, positions, fox_w_in, fox_b_f, fox_w_out, ret_w_in, ret_w_out,
              ln1_g, ln1_b, ln2_g, ln2_b, moe_w_group, moe_b_group, moe_w_router, moe_b_router,
              moe_w_gate, moe_w_up, moe_w_down, ple_w_proj, ple_w_gate, ple_b_gate):
    for i in range(DEPTH):
        j = i // N_MIXERS
        if i % N_MIXERS == 0:
            h = fox_attention(x, fox_w_in[j], fox_b_f[j], fox_w_out[j])
        else:
            h = retention(x, positions, ret_w_in[j], ret_w_out[j])
        x = layer_norm(DEEPNORM_ALPHA * x + h, ln1_g[i], ln1_b[i])
        m = hierarchical_moe(x, moe_w_group[i], moe_b_group[i], moe_w_router[i], moe_b_router[i],
                             moe_w_gate[i], moe_w_up[i], moe_w_down[i])
        x = layer_norm(DEEPNORM_ALPHA * x + m, ln2_g[i], ln2_b[i])
        gate = jax.nn.sigmoid(x @ ple_w_gate[i] + ple_b_gate[i])
        x = x + gate * (p[i] @ ple_w_proj[i])
    return x
```

```cpp
#include <hip/hip_runtime.h>
#include <hip/hip_cooperative_groups.h>
#include <cstdio>
#include <cstdint>
namespace cg = cooperative_groups;

#ifndef MEGA
#define MEGA 0
#endif

typedef unsigned short u16;
using bf16x8 = __attribute__((ext_vector_type(8))) short;
using f32x4 = __attribute__((ext_vector_type(4))) float;
#define DEVI __device__ __forceinline__

constexpr int T = 16384, SEQ = 4096;
constexpr size_t MiB = 1ull << 20;
constexpr float ALPHA = 1.4142135623730951f;
constexpr float LN_EPS = 1e-5f;
constexpr int NPH = 23;
constexpr int LDS_BYTES = 65536;

constexpr size_t W0_QKV = 0, W0_OUT = 7 * MiB, W0_GU = 9 * MiB, W0_D = 41 * MiB, W0_PG = 57 * MiB, W0_PP = 59 * MiB;
constexpr size_t QKV0 = 60 * MiB, X1B0 = 60 * MiB, YBUF0 = 60 * MiB, HBUF0 = 124 * MiB, X2B0 = 124 * MiB;
constexpr size_t VR0 = 156 * MiB, PP0 = 220 * MiB, XB0 = 284 * MiB, O0 = 284 * MiB, X3B = 284 * MiB;
constexpr size_t PB = 316 * MiB, CS = 324 * MiB, LOGF = 340 * MiB, C8 = 341 * MiB, LISTS = 342 * MiB, TOKW = 343 * MiB;
constexpr size_t GNST = 343 * MiB + 512 * 1024, CNT = 344 * MiB;
constexpr size_t WRIN = 0, WROUT = 12 * MiB, Q1 = 16 * MiB, K1 = 48 * MiB, KTD = 80 * MiB, VT = 112 * MiB, O1 = 48 * MiB;
constexpr size_t KV = 176 * MiB, SP = 240 * MiB, W1_GU = 176 * MiB, W1_D = 208 * MiB, W1_PG = 224 * MiB, W1_PP = 226 * MiB;
constexpr size_t VR1 = 112 * MiB, PP1 = 240 * MiB, X1B1 = 16 * MiB, HBUF1 = 80 * MiB, YBUF1 = 0, X2B1 = 80 * MiB;

struct P {
  const float *x, *p; const int* pos;
  const float *fox_w_in, *fox_b_f, *fox_w_out, *ret_w_in, *ret_w_out, *ln1_g, *ln1_b, *ln2_g, *ln2_b;
  const float *w_group, *b_group, *w_router, *b_router, *w_gate, *w_up, *w_down, *ple_proj, *ple_gate, *ple_b;
  float* out; char* ws;
};

DEVI float bf2f(u16 b) { return __uint_as_float(((unsigned)b) << 16); }
DEVI u16 f2bf(float f) { unsigned u = __float_as_uint(f); u += 0x7FFFu + ((u >> 16) & 1u); return (u16)(u >> 16); }
DEVI unsigned pack2(float a, float b) { return (unsigned)f2bf(a) | ((unsigned)f2bf(b) << 16); }
DEVI float wsum(float v) {
#pragma unroll
  for (int o = 32; o >= 1; o >>= 1) v += __shfl_xor(v, o);
  return v;
}
DEVI float siluf(float v) { return v / (1.f + __expf(-v)); }
DEVI float logsig(float z) { return fminf(z, 0.f) - log1pf(__expf(-fabsf(z))); }

struct GemmLoad {
  const u16 *a0, *a1, *b0, *b1;
  const u16 *c0, *c1, *d0, *d1;
  int nt1, nt2;
};
DEVI void glds16(const u16* g, char* l) {
  __builtin_amdgcn_global_load_lds((const __attribute__((address_space(1))) void*)g, (__attribute__((address_space(3))) void*)l, 16, 0, 0);
}
template <class Epi>
DEVI void gemm_tile(const GemmLoad& L, int nt_max, char* lds, int tid, Epi&& epi) {
  const int wid = tid >> 6, lane = tid & 63, wr = wid >> 1, wc = wid & 1, fr = lane & 15, fq = lane >> 4;
  f32x4 acc[4][4];
#pragma unroll
  for (int m = 0; m < 4; ++m)
#pragma unroll
    for (int n = 0; n < 4; ++n) acc[m][n] = f32x4{0.f, 0.f, 0.f, 0.f};
  const int nt = L.nt1 + L.nt2;
  auto stage = [&](int t, int buf) {
    char* sa = lds + buf * 16384 + tid * 16; char* sb = sa + 8192;
    const u16 *pa0, *pa1, *pb0, *pb1;
    if (t < L.nt1) { pa0 = L.a0 + t * 32; pa1 = L.a1 + t * 32; pb0 = L.b0 + t * 32; pb1 = L.b1 + t * 32; }
    else { const int t2 = t - L.nt1; pa0 = L.c0 + t2 * 32; pa1 = L.c1 + t2 * 32; pb0 = L.d0 + t2 * 32; pb1 = L.d1 + t2 * 32; }
    glds16(pa0, sa); glds16(pa1, sa + 4096); glds16(pb0, sb); glds16(pb1, sb + 4096);
  };
  if (nt > 0) stage(0, 0);
  for (int t = 0; t < nt_max; ++t) {
    asm volatile("s_waitcnt vmcnt(0)" ::: "memory");
    __syncthreads();
    if (t + 1 < nt) stage(t + 1, (t + 1) & 1);
    if (t < nt) {
      const char* sa = lds + (t & 1) * 16384; const char* sb = sa + 8192;
      bf16x8 af[4], bfv[4];
#pragma unroll
      for (int m = 0; m < 4; ++m) af[m] = *reinterpret_cast<const bf16x8*>(sa + (wr * 64 + m * 16 + fr) * 64 + fq * 16);
#pragma unroll
      for (int n = 0; n < 4; ++n) bfv[n] = *reinterpret_cast<const bf16x8*>(sb + (wc * 64 + n * 16 + fr) * 64 + fq * 16);
#pragma unroll
      for (int m = 0; m < 4; ++m)
#pragma unroll
        for (int n = 0; n < 4; ++n) acc[m][n] = __builtin_amdgcn_mfma_f32_16x16x32_bf16(af[m], bfv[n], acc[m][n], 0, 0, 0);
    }
  }
  __syncthreads();
  epi(acc, wr, wc, fr, fq);
}
template <class TF>
DEVI void run_tiles(int ntiles, int vb, int nvb, TF&& f) {
  const int niter = (ntiles + nvb - 1) / nvb;
  for (int it = 0; it < niter; ++it) { const int tile = it * nvb + vb; const bool valid = tile < ntiles; f(valid ? tile : 0, valid); }
}
DEVI void set_seg1(GemmLoad& L, const u16* A, size_t lda, const u16* B, size_t ldb, int nt, int tid) {
  const int r = tid >> 2, kc = (tid & 3) * 8;
  L.a0 = A + (size_t)r * lda + kc; L.a1 = A + (size_t)(r + 64) * lda + kc;
  L.b0 = B + (size_t)r * ldb + kc; L.b1 = B + (size_t)(r + 64) * ldb + kc;
  L.c0 = L.a0; L.c1 = L.a1; L.d0 = L.b0; L.d1 = L.b1; L.nt1 = nt; L.nt2 = 0;
}

DEVI int rowmap(int mode, int n) {
  if (mode == 0) return n;
  if (mode == 1 || mode == 2) { const int tile = n >> 6, w = n & 63, wc = w >> 5, rr = w & 31; return tile * 128 + wc * 64 + (mode == 2 ? 32 : 0) + rr; }
  const int hh = n >> 8, ip = n & 255, comp = ip >> 7, i = ip & 127, th = i >> 6, w = i & 63, wc = w >> 5, rr = w & 31;
  return hh * 256 + th * 128 + wc * 64 + comp * 32 + rr;
}
DEVI void tconv(const float* __restrict__ src, size_t sbs, int ldsrc, int K, int N, int nbatch, u16* __restrict__ dst, size_t dbs, int mode, float* tl) {
  const int tid = threadIdx.x; const int tk = K >> 6, tn = N >> 6; const int per = tk * tn, nt = per * nbatch;
  for (int tile = blockIdx.x; tile < nt; tile += gridDim.x) {
    const int b = tile / per, tt = tile % per; const int k0 = (tt / tn) << 6, n0 = (tt % tn) << 6;
    const float* s = src + (size_t)b * sbs; u16* d = dst + (size_t)b * dbs;
    { const int ty = tid >> 6, tx = tid & 63;
#pragma unroll
      for (int r = 0; r < 8; ++r) { const int k = ty * 8 + r; tl[k * 65 + tx] = s[(size_t)(k0 + k) * ldsrc + n0 + tx]; } }
    __syncthreads();
    { const int n = tid >> 3, kc = tid & 7;
      const unsigned w0 = pack2(tl[(kc * 8 + 0) * 65 + n], tl[(kc * 8 + 1) * 65 + n]);
      const unsigned w1 = pack2(tl[(kc * 8 + 2) * 65 + n], tl[(kc * 8 + 3) * 65 + n]);
      const unsigned w2 = pack2(tl[(kc * 8 + 4) * 65 + n], tl[(kc * 8 + 5) * 65 + n]);
      const unsigned w3 = pack2(tl[(kc * 8 + 6) * 65 + n], tl[(kc * 8 + 7) * 65 + n]);
      const int nr = rowmap(mode, n0 + n);
      *reinterpret_cast<uint4*>(d + (size_t)nr * K + k0 + kc * 8) = make_uint4(w0, w1, w2, w3); }
    __syncthreads();
  }
}
DEVI void econv(const float* __restrict__ src, u16* __restrict__ dst, size_t n) {
  const size_t gt = (size_t)blockIdx.x * 512 + threadIdx.x, gn = (size_t)gridDim.x * 512;
  for (size_t i = gt * 4; i < n; i += gn * 4) {
    const float4 v = *reinterpret_cast<const float4*>(src + i);
    *reinterpret_cast<uint2*>(dst + i) = make_uint2(pack2(v.x, v.y), pack2(v.z, v.w));
  }
}

DEVI float gamma_log2(int h) { return log2f(1.0f - exp2f(-5.0f - (float)h)); }

DEVI int moe_ntiles(const int* cnt, int ntn) { int s = 0; for (int i = 0; i < 16; ++i) s += ((cnt[i] + 127) >> 7) * ntn; return s; }
DEVI void moe_tile(const int* cnt, int tile, int ntn, int& e, int& mt, int& nt, int& base, int& ce) {
  int at = 0, b = 0; e = 0; mt = 0; nt = 0; base = 0; ce = 0;
  for (int i = 0; i < 16; ++i) {
    const int c = cnt[i]; const int tl = ((c + 127) >> 7) * ntn;
    if (tile >= at && tile < at + tl) { const int r = tile - at; e = i; mt = r / ntn; nt = r % ntn; base = b; ce = c; }
    at += tl; b += c;
  }
}

template <int ph>
DEVI void run_phase(const P& p, char* smem) {
  const int half = threadIdx.x >> 8, tid = threadIdx.x & 255;
  const int vb = blockIdx.x * 2 + half, nvb = gridDim.x * 2;
  char* hl = smem + half * 32768;
  const int lane = threadIdx.x & 63;
  const int gw = blockIdx.x * 8 + (threadIdx.x >> 6), nw = gridDim.x * 8;
  char* ws = p.ws;
  (void)hl; (void)lane; (void)gw; (void)nw; (void)vb; (void)nvb; (void)tid;
  {
    constexpr int layer = (ph >= 10) ? 1 : 0;
    switch (ph) {
    case 0: {
      float* tl = (float*)smem;
      if (blockIdx.x == 0 && threadIdx.x < 32) ((int*)(ws + CNT))[threadIdx.x] = 0;
      econv(p.x, (u16*)(ws + XB0), (size_t)T * 1024);
      econv(p.p, (u16*)(ws + PB), (size_t)T * 256);
      tconv(p.fox_w_in, 0, 3088, 1024, 3072, 1, (u16*)(ws + W0_QKV), 0, 0, tl);
      {
        const int gt = blockIdx.x * 512 + threadIdx.x;
        if (gt < 16384) { const int n = gt >> 10, k = gt & 1023; ((u16*)(ws + W0_QKV))[(size_t)(3072 + n) * 1024 + k] = f2bf(p.fox_w_in[(size_t)k * 3088 + 3072 + n]); }
      }
      tconv(p.fox_w_out, 0, 1024, 1024, 1024, 1, (u16*)(ws + W0_OUT), 0, 0, tl);
      tconv(p.w_gate, 1024 * 512, 512, 1024, 512, 16, (u16*)(ws + W0_GU), 1024 * 1024, 1, tl);
      tconv(p.w_up, 1024 * 512, 512, 1024, 512, 16, (u16*)(ws + W0_GU), 1024 * 1024, 2, tl);
      tconv(p.w_down, 512 * 1024, 1024, 512, 1024, 16, (u16*)(ws + W0_D), 1024 * 512, 0, tl);
      tconv(p.ple_gate, 0, 1024, 1024, 1024, 1, (u16*)(ws + W0_PG), 0, 0, tl);
      tconv(p.ple_proj, 0, 1024, 256, 1024, 1, (u16*)(ws + W0_PP), 0, 0, tl);
    } break;
    case 1: {
      const u16* xb = (const u16*)(ws + XB0); const u16* w = (const u16*)(ws + W0_QKV);
      u16* qkv = (u16*)(ws + QKV0); float* logf_ = (float*)(ws + LOGF);
      run_tiles(128 * 25, vb, nvb, [&](int tile, bool valid) {
        const int mt = tile / 25, ntile = tile % 25;
        GemmLoad L; set_seg1(L, xb + (size_t)mt * 128 * 1024, 1024, w + (size_t)ntile * 128 * 1024, 1024, valid ? 32 : 0, tid);
        gemm_tile(L, 32, hl, tid, [&](f32x4 (&acc)[4][4], int wr, int wc, int fr, int fq) {
          if (!valid) return;
          if (ntile < 24) {
#pragma unroll
            for (int m = 0; m < 4; ++m)
#pragma unroll
              for (int n = 0; n < 4; ++n)
#pragma unroll
                for (int j = 0; j < 4; ++j) {
                  const int row = mt * 128 + wr * 64 + m * 16 + fq * 4 + j, col = ntile * 128 + wc * 64 + n * 16 + fr;
                  qkv[(size_t)row * 3072 + col] = f2bf(acc[m][n][j]);
                }
          } else if (wc == 0) {
            const float bf_ = p.fox_b_f[fr];
#pragma unroll
            for (int m = 0; m < 4; ++m)
#pragma unroll
              for (int j = 0; j < 4; ++j) {
                const int row = mt * 128 + wr * 64 + m * 16 + fq * 4 + j;
                logf_[row * 16 + fr] = logsig(acc[m][0][j] + bf_);
              }
          }
        });
      });
    } break;
    case 2: {
      const float* logf_ = (const float*)(ws + LOGF); float* c8 = (float*)(ws + C8);
      for (int bh = gw; bh < 64; bh += nw) {
        const int b = bh >> 4, h = bh & 15;
        const float* src = logf_ + (size_t)(b * SEQ + lane * 64) * 16 + h;
        float s = 0.f;
        for (int i = 0; i < 64; ++i) s += src[i * 16];
        float incl = s;
#pragma unroll
        for (int o = 1; o < 64; o <<= 1) { const float t2 = __shfl_up(incl, o); if (lane >= o) incl += t2; }
        float run = incl - s;
        float* dst = c8 + (size_t)bh * SEQ + lane * 64;
        for (int i = 0; i < 64; ++i) { run += src[i * 16]; dst[i] = 8.f * run; }
      }
    } break;
    case 3: {
      const u16* qkv = (const u16*)(ws + QKV0); const float* c8 = (const float*)(ws + C8); u16* O = (u16*)(ws + O0);
      for (int w = gw; w < 2048; w += nw) {
        const int bh = w >> 5, jp = w & 31; const int b = bh >> 4, h = bh & 15;
        for (int side = 0; side < 2; ++side) {
          const int qg = side ? 63 - jp : jp; const int qpos = qg * 64 + lane;
          const u16* qrow = qkv + (size_t)(b * SEQ + qpos) * 3072 + h * 64;
          float q[64], o[64];
#pragma unroll
          for (int c = 0; c < 8; ++c) { const uint4 v = *reinterpret_cast<const uint4*>(qrow + c * 8);
            q[c * 8 + 0] = __uint_as_float(v.x << 16); q[c * 8 + 1] = __uint_as_float(v.x & 0xffff0000u);
            q[c * 8 + 2] = __uint_as_float(v.y << 16); q[c * 8 + 3] = __uint_as_float(v.y & 0xffff0000u);
            q[c * 8 + 4] = __uint_as_float(v.z << 16); q[c * 8 + 5] = __uint_as_float(v.z & 0xffff0000u);
            q[c * 8 + 6] = __uint_as_float(v.w << 16); q[c * 8 + 7] = __uint_as_float(v.w & 0xffff0000u); }
#pragma unroll
          for (int d = 0; d < 64; ++d) o[d] = 0.f;
          const float cq = c8[(size_t)bh * SEQ + qpos];
          float mrun = -INFINITY, l = 0.f;
          const int kend = qg * 64 + 64;
#pragma unroll 1
          for (int key = 0; key < kend; ++key) {
            const u16* krow = qkv + (size_t)(b * SEQ + key) * 3072 + 1024 + h * 64;
            float dot = 0.f;
#pragma unroll
            for (int c = 0; c < 8; ++c) { const uint4 v = *reinterpret_cast<const uint4*>(krow + c * 8);
              dot += q[c * 8 + 0] * __uint_as_float(v.x << 16); dot += q[c * 8 + 1] * __uint_as_float(v.x & 0xffff0000u);
              dot += q[c * 8 + 2] * __uint_as_float(v.y << 16); dot += q[c * 8 + 3] * __uint_as_float(v.y & 0xffff0000u);
              dot += q[c * 8 + 4] * __uint_as_float(v.z << 16); dot += q[c * 8 + 5] * __uint_as_float(v.z & 0xffff0000u);
              dot += q[c * 8 + 6] * __uint_as_float(v.w << 16); dot += q[c * 8 + 7] * __uint_as_float(v.w & 0xffff0000u); }
            const float ck = c8[(size_t)bh * SEQ + key];
            const float s = (key <= qpos) ? 0.125f * (dot + cq - ck) : -INFINITY;
            const float mnew = fmaxf(mrun, s);
            const float al = __expf(mrun - mnew);
            const float pr = __expf(s - mnew);
            mrun = mnew;
            l = l * al + pr;
            const u16* vrow = qkv + (size_t)(b * SEQ + key) * 3072 + 2048 + h * 64;
#pragma unroll
            for (int c = 0; c < 8; ++c) { const uint4 v = *reinterpret_cast<const uint4*>(vrow + c * 8);
              o[c * 8 + 0] = o[c * 8 + 0] * al + pr * __uint_as_float(v.x << 16); o[c * 8 + 1] = o[c * 8 + 1] * al + pr * __uint_as_float(v.x & 0xffff0000u);
              o[c * 8 + 2] = o[c * 8 + 2] * al + pr * __uint_as_float(v.y << 16); o[c * 8 + 3] = o[c * 8 + 3] * al + pr * __uint_as_float(v.y & 0xffff0000u);
              o[c * 8 + 4] = o[c * 8 + 4] * al + pr * __uint_as_float(v.z << 16); o[c * 8 + 5] = o[c * 8 + 5] * al + pr * __uint_as_float(v.z & 0xffff0000u);
              o[c * 8 + 6] = o[c * 8 + 6] * al + pr * __uint_as_float(v.w << 16); o[c * 8 + 7] = o[c * 8 + 7] * al + pr * __uint_as_float(v.w & 0xffff0000u); }
          }
          const float il = 1.f / l;
          u16* orow = O + (size_t)(b * SEQ + qpos) * 1024 + h * 64;
#pragma unroll
          for (int c = 0; c < 8; ++c)
            *reinterpret_cast<uint4*>(orow + c * 8) = make_uint4(pack2(o[c * 8] * il, o[c * 8 + 1] * il), pack2(o[c * 8 + 2] * il, o[c * 8 + 3] * il),
                                                                 pack2(o[c * 8 + 4] * il, o[c * 8 + 5] * il), pack2(o[c * 8 + 6] * il, o[c * 8 + 7] * il));
        }
      }
    } break;
    case 4: case 17: {
      const u16* A = (const u16*)(ws + (layer ? O1 : O0)); const u16* W = (const u16*)(ws + (layer ? WROUT : W0_OUT));
      const int K = layer ? 2048 : 1024;
      const float* xres = layer ? p.out : p.x; float* vr = (float*)(ws + (layer ? VR1 : VR0));
      run_tiles(128 * 8, vb, nvb, [&](int tile, bool valid) {
        const int mt = tile >> 3, ntile = tile & 7;
        GemmLoad L; set_seg1(L, A + (size_t)mt * 128 * K, K, W + (size_t)ntile * 128 * K, K, valid ? K / 32 : 0, tid);
        gemm_tile(L, K / 32, hl, tid, [&](f32x4 (&acc)[4][4], int wr, int wc, int fr, int fq) {
          if (!valid) return;
#pragma unroll
          for (int m = 0; m < 4; ++m)
#pragma unroll
            for (int n = 0; n < 4; ++n)
#pragma unroll
              for (int j = 0; j < 4; ++j) {
                const size_t idx = (size_t)(mt * 128 + wr * 64 + m * 16 + fq * 4 + j) * 1024 + ntile * 128 + wc * 64 + n * 16 + fr;
                vr[idx] = ALPHA * xres[idx] + acc[m][n][j];
              }
        });
      });
      const u16* pb = (const u16*)(ws + PB); const u16* wpp = (const u16*)(ws + (layer ? W1_PP : W0_PP)); float* pp = (float*)(ws + (layer ? PP1 : PP0));
      run_tiles(128 * 8, vb, nvb, [&](int tile, bool valid) {
        const int mt = tile >> 3, ntile = tile & 7;
        GemmLoad L; set_seg1(L, pb + (size_t)mt * 128 * 256, 256, wpp + (size_t)ntile * 128 * 256, 256, valid ? 8 : 0, tid);
        gemm_tile(L, 8, hl, tid, [&](f32x4 (&acc)[4][4], int wr, int wc, int fr, int fq) {
          if (!valid) return;
#pragma unroll
          for (int m = 0; m < 4; ++m)
#pragma unroll
            for (int n = 0; n < 4; ++n)
#pragma unroll
              for (int j = 0; j < 4; ++j) {
                const size_t idx = (size_t)(mt * 128 + wr * 64 + m * 16 + fq * 4 + j) * 1024 + ntile * 128 + wc * 64 + n * 16 + fr;
                pp[idx] = acc[m][n][j];
              }
        });
      });
    } break;
    case 5: case 18: {
      float* vr = (float*)(ws + (layer ? VR1 : VR0)); u16* x1b = (u16*)(ws + (layer ? X1B1 : X1B0));
      const float* g = p.ln1_g + layer * 1024; const float* bb = p.ln1_b + layer * 1024;
      const float* wg = p.w_group + (size_t)layer * 1024 * 4; const float* wrt = p.w_router + (size_t)layer * 1024 * 16;
      const float* bg = p.b_group + layer * 4; const float* br = p.b_router + layer * 16;
      int* cnt = (int*)(ws + CNT) + layer * 16; int* lists = (int*)(ws + LISTS); float* tokw = (float*)(ws + TOKW);
      for (int tok = gw; tok < T; tok += nw) {
        float* row = vr + (size_t)tok * 1024;
        float4 v[4];
#pragma unroll
        for (int i = 0; i < 4; ++i) v[i] = *reinterpret_cast<const float4*>(row + i * 256 + lane * 4);
        float s = 0.f;
#pragma unroll
        for (int i = 0; i < 4; ++i) s += v[i].x + v[i].y + v[i].z + v[i].w;
        const float mu = wsum(s) * (1.f / 1024.f);
        float sq = 0.f;
#pragma unroll
        for (int i = 0; i < 4; ++i) { v[i].x -= mu; v[i].y -= mu; v[i].z -= mu; v[i].w -= mu; sq += v[i].x * v[i].x + v[i].y * v[i].y + v[i].z * v[i].z + v[i].w * v[i].w; }
        const float rstd = rsqrtf(wsum(sq) * (1.f / 1024.f) + LN_EPS);
        float lg[20];
#pragma unroll
        for (int o = 0; o < 20; ++o) lg[o] = 0.f;
#pragma unroll
        for (int i = 0; i < 4; ++i) {
          const int c0 = i * 256 + lane * 4;
          const float4 gg = *reinterpret_cast<const float4*>(g + c0), be = *reinterpret_cast<const float4*>(bb + c0);
          v[i].x = v[i].x * rstd * gg.x + be.x; v[i].y = v[i].y * rstd * gg.y + be.y; v[i].z = v[i].z * rstd * gg.z + be.z; v[i].w = v[i].w * rstd * gg.w + be.w;
          *reinterpret_cast<float4*>(row + c0) = v[i];
          *reinterpret_cast<uint2*>(x1b + (size_t)tok * 1024 + c0) = make_uint2(pack2(v[i].x, v[i].y), pack2(v[i].z, v[i].w));
          const float xe[4] = {v[i].x, v[i].y, v[i].z, v[i].w};
#pragma unroll
          for (int e = 0; e < 4; ++e) {
            const float4 w4 = *reinterpret_cast<const float4*>(wg + (size_t)(c0 + e) * 4);
            lg[0] += xe[e] * w4.x; lg[1] += xe[e] * w4.y; lg[2] += xe[e] * w4.z; lg[3] += xe[e] * w4.w;
#pragma unroll
            for (int q4 = 0; q4 < 4; ++q4) {
              const float4 r4 = *reinterpret_cast<const float4*>(wrt + (size_t)(c0 + e) * 16 + q4 * 4);
              lg[4 + q4 * 4 + 0] += xe[e] * r4.x; lg[4 + q4 * 4 + 1] += xe[e] * r4.y; lg[4 + q4 * 4 + 2] += xe[e] * r4.z; lg[4 + q4 * 4 + 3] += xe[e] * r4.w;
            }
          }
        }
#pragma unroll
        for (int o = 0; o < 20; ++o) lg[o] = wsum(lg[o]);
        if (lane == 0) {
          float gl[4];
#pragma unroll
          for (int i = 0; i < 4; ++i) gl[i] = lg[i] + bg[i];
          int gi = 0; float gm = gl[0];
#pragma unroll
          for (int i = 1; i < 4; ++i) if (gl[i] > gm) { gm = gl[i]; gi = i; }
          float gs = 0.f;
#pragma unroll
          for (int i = 0; i < 4; ++i) gs += __expf(gl[i] - gm);
          const float gval = 1.f / gs;
          float el[4];
#pragma unroll
          for (int i = 0; i < 4; ++i) {
            float t0 = lg[4 + i] + br[i], t1 = lg[8 + i] + br[4 + i], t2 = lg[12 + i] + br[8 + i], t3 = lg[16 + i] + br[12 + i];
            el[i] = gi == 0 ? t0 : (gi == 1 ? t1 : (gi == 2 ? t2 : t3));
          }
          int i0 = 0; float m0 = el[0];
#pragma unroll
          for (int i = 1; i < 4; ++i) if (el[i] > m0) { m0 = el[i]; i0 = i; }
          int i1 = -1; float m1 = -INFINITY;
#pragma unroll
          for (int i = 0; i < 4; ++i) if (i != i0 && el[i] > m1) { m1 = el[i]; i1 = i; }
          const float e1 = __expf(m1 - m0); const float w0 = gval / (1.f + e1), w1 = gval * e1 / (1.f + e1);
          const int ex0 = gi * 4 + i0, ex1 = gi * 4 + i1;
          const int s0 = atomicAdd(&cnt[ex0], 1); lists[ex0 * T + s0] = tok * 2;
          const int s1 = atomicAdd(&cnt[ex1], 1); lists[ex1 * T + s1] = tok * 2 + 1;
          tokw[tok * 2] = w0; tokw[tok * 2 + 1] = w1;
        }
      }
    } break;
    case 6: case 19: {
      const u16* x1b = (const u16*)(ws + (layer ? X1B1 : X1B0)); const u16* wgu = (const u16*)(ws + (layer ? W1_GU : W0_GU));
      u16* hb = (u16*)(ws + (layer ? HBUF1 : HBUF0));
      const int* cnt = (const int*)(ws + CNT) + layer * 16; const int* lists = (const int*)(ws + LISTS);
      const int ntiles = moe_ntiles(cnt, 8);
      run_tiles(ntiles, vb, nvb, [&](int tile, bool valid) {
        int e, mt, ntile, base, ce; moe_tile(cnt, tile, 8, e, mt, ntile, base, ce);
        if (ce == 0) valid = false;
        GemmLoad L; const int r = tid >> 2, kc = (tid & 3) * 8;
        int s0 = mt * 128 + r, s1 = s0 + 64; if (s0 >= ce) s0 = ce > 0 ? ce - 1 : 0; if (s1 >= ce) s1 = ce > 0 ? ce - 1 : 0;
        const int t0 = valid ? (lists[e * T + s0] >> 1) : 0, t1 = valid ? (lists[e * T + s1] >> 1) : 0;
        L.a0 = x1b + (size_t)t0 * 1024 + kc; L.a1 = x1b + (size_t)t1 * 1024 + kc;
        const u16* B = wgu + (size_t)e * 1024 * 1024 + (size_t)ntile * 128 * 1024;
        L.b0 = B + (size_t)r * 1024 + kc; L.b1 = B + (size_t)(r + 64) * 1024 + kc;
        L.c0 = L.a0; L.c1 = L.a1; L.d0 = L.b0; L.d1 = L.b1; L.nt1 = valid ? 32 : 0; L.nt2 = 0;
        gemm_tile(L, 32, hl, tid, [&](f32x4 (&acc)[4][4], int wr, int wc, int fr, int fq) {
          if (!valid) return;
#pragma unroll
          for (int m = 0; m < 4; ++m)
#pragma unroll
            for (int j = 0; j < 4; ++j) {
              const int slot = mt * 128 + wr * 64 + m * 16 + fq * 4 + j;
              if (slot < ce) {
#pragma unroll
                for (int n = 0; n < 2; ++n) {
                  const float hv = siluf(acc[m][n][j]) * acc[m][n + 2][j];
                  hb[(size_t)(base + slot) * 512 + ntile * 64 + wc * 32 + n * 16 + fr] = f2bf(hv);
                }
              }
            }
        });
      });
    } break;
    case 7: case 20: {
      const u16* hb = (const u16*)(ws + (layer ? HBUF1 : HBUF0)); const u16* wd = (const u16*)(ws + (layer ? W1_D : W0_D));
      u16* yb = (u16*)(ws + (layer ? YBUF1 : YBUF0));
      const int* cnt = (const int*)(ws + CNT) + layer * 16; const int* lists = (const int*)(ws + LISTS); const float* tokw = (const float*)(ws + TOKW);
      const int ntiles = moe_ntiles(cnt, 8);
      run_tiles(ntiles, vb, nvb, [&](int tile, bool valid) {
        int e, mt, ntile, base, ce; moe_tile(cnt, tile, 8, e, mt, ntile, base, ce);
        if (ce == 0) valid = false;
        GemmLoad L; const int r = tid >> 2, kc = (tid & 3) * 8;
        int s0 = mt * 128 + r, s1 = s0 + 64; if (s0 >= ce) s0 = ce > 0 ? ce - 1 : 0; if (s1 >= ce) s1 = ce > 0 ? ce - 1 : 0;
        L.a0 = hb + (size_t)(base + s0) * 512 + kc; L.a1 = hb + (size_t)(base + s1) * 512 + kc;
        const u16* B = wd + (size_t)e * 1024 * 512 + (size_t)ntile * 128 * 512;
        L.b0 = B + (size_t)r * 512 + kc; L.b1 = B + (size_t)(r + 64) * 512 + kc;
        L.c0 = L.a0; L.c1 = L.a1; L.d0 = L.b0; L.d1 = L.b1; L.nt1 = valid ? 16 : 0; L.nt2 = 0;
        gemm_tile(L, 16, hl, tid, [&](f32x4 (&acc)[4][4], int wr, int wc, int fr, int fq) {
          if (!valid) return;
#pragma unroll
          for (int m = 0; m < 4; ++m)
#pragma unroll
            for (int j = 0; j < 4; ++j) {
              const int slot = mt * 128 + wr * 64 + m * 16 + fq * 4 + j;
              if (slot < ce) {
                const int tk = lists[e * T + slot]; const float wgt = tokw[tk];
#pragma unroll
                for (int n = 0; n < 4; ++n) yb[(size_t)tk * 1024 + ntile * 128 + wc * 64 + n * 16 + fr] = f2bf(wgt * acc[m][n][j]);
              }
            }
        });
      });
    } break;
    case 8: case 21: {
      float* vr = (float*)(ws + (layer ? VR1 : VR0)); const u16* yb = (const u16*)(ws + (layer ? YBUF1 : YBUF0)); u16* x2b = (u16*)(ws + (layer ? X2B1 : X2B0));
      const float* g = p.ln2_g + layer * 1024; const float* bb = p.ln2_b + layer * 1024;
      for (int tok = gw; tok < T; tok += nw) {
        float* row = vr + (size_t)tok * 1024;
        float4 v[4];
#pragma unroll
        for (int i = 0; i < 4; ++i) {
          const int c0 = i * 256 + lane * 4;
          const float4 xv = *reinterpret_cast<const float4*>(row + c0);
          const uint2 ya = *reinterpret_cast<const uint2*>(yb + (size_t)(tok * 2) * 1024 + c0), yc = *reinterpret_cast<const uint2*>(yb + (size_t)(tok * 2 + 1) * 1024 + c0);
          v[i].x = ALPHA * xv.x + (__uint_as_float(ya.x << 16) + __uint_as_float(yc.x << 16));
          v[i].y = ALPHA * xv.y + (__uint_as_float(ya.x & 0xffff0000u) + __uint_as_float(yc.x & 0xffff0000u));
          v[i].z = ALPHA * xv.z + (__uint_as_float(ya.y << 16) + __uint_as_float(yc.y << 16));
          v[i].w = ALPHA * xv.w + (__uint_as_float(ya.y & 0xffff0000u) + __uint_as_float(yc.y & 0xffff0000u));
        }
        float s = 0.f;
#pragma unroll
        for (int i = 0; i < 4; ++i) s += v[i].x + v[i].y + v[i].z + v[i].w;
        const float mu = wsum(s) * (1.f / 1024.f);
        float sq = 0.f;
#pragma unroll
        for (int i = 0; i < 4; ++i) { v[i].x -= mu; v[i].y -= mu; v[i].z -= mu; v[i].w -= mu; sq += v[i].x * v[i].x + v[i].y * v[i].y + v[i].z * v[i].z + v[i].w * v[i].w; }
        const float rstd = rsqrtf(wsum(sq) * (1.f / 1024.f) + LN_EPS);
#pragma unroll
        for (int i = 0; i < 4; ++i) {
          const int c0 = i * 256 + lane * 4;
          const float4 gg = *reinterpret_cast<const float4*>(g + c0), be = *reinterpret_cast<const float4*>(bb + c0);
          v[i].x = v[i].x * rstd * gg.x + be.x; v[i].y = v[i].y * rstd * gg.y + be.y; v[i].z = v[i].z * rstd * gg.z + be.z; v[i].w = v[i].w * rstd * gg.w + be.w;
          *reinterpret_cast<float4*>(row + c0) = v[i];
          *reinterpret_cast<uint2*>(x2b + (size_t)tok * 1024 + c0) = make_uint2(pack2(v[i].x, v[i].y), pack2(v[i].z, v[i].w));
        }
      }
    } break;
    case 9: case 22: {
      const u16* A = (const u16*)(ws + (layer ? X2B1 : X2B0)); const u16* W = (const u16*)(ws + (layer ? W1_PG : W0_PG));
      const float* x2 = (const float*)(ws + (layer ? VR1 : VR0)); const float* pp = (const float*)(ws + (layer ? PP1 : PP0));
      const float* bgate = p.ple_b + layer * 1024; u16* x3b = (u16*)(ws + X3B); float* outp = p.out;
      run_tiles(128 * 8, vb, nvb, [&](int tile, bool valid) {
        const int mt = tile >> 3, ntile = tile & 7;
        GemmLoad L; set_seg1(L, A + (size_t)mt * 128 * 1024, 1024, W + (size_t)ntile * 128 * 1024, 1024, valid ? 32 : 0, tid);
        gemm_tile(L, 32, hl, tid, [&](f32x4 (&acc)[4][4], int wr, int wc, int fr, int fq) {
          if (!valid) return;
#pragma unroll
          for (int n = 0; n < 4; ++n) {
            const int col = ntile * 128 + wc * 64 + n * 16 + fr; const float bv = bgate[col];
#pragma unroll
            for (int m = 0; m < 4; ++m)
#pragma unroll
              for (int j = 0; j < 4; ++j) {
                const size_t idx = (size_t)(mt * 128 + wr * 64 + m * 16 + fq * 4 + j) * 1024 + col;
                const float gt = 1.f / (1.f + __expf(-(acc[m][n][j] + bv)));
                const float r = x2[idx] + gt * pp[idx];
                outp[idx] = r;
                if (layer == 0) x3b[idx] = f2bf(r);
              }
          }
        });
      });
    } break;
    case 10: {
      float* tl = (float*)smem;
      tconv(p.ret_w_in, 0, 6144, 1024, 2048, 1, (u16*)(ws + WRIN), 0, 3, tl);
      tconv(p.ret_w_in + 2048, 0, 6144, 1024, 4096, 1, (u16*)(ws + WRIN) + (size_t)2048 * 1024, 0, 0, tl);
      tconv(p.ret_w_out, 0, 1024, 2048, 1024, 1, (u16*)(ws + WROUT), 0, 0, tl);
      econv(p.p + (size_t)T * 256, (u16*)(ws + PB), (size_t)T * 256);
      float2* cs = (float2*)(ws + CS);
      const size_t gt = (size_t)blockIdx.x * 512 + threadIdx.x, gn = (size_t)gridDim.x * 512;
      for (size_t i = gt; i < (size_t)T * 128; i += gn) {
        const int tok = (int)(i >> 7), f = (int)(i & 127);
        const float invf = powf(10000.f, -(float)(2 * f) / 256.f);
        const float ang = (float)p.pos[tok] * invf;
        const double rev = (double)ang * 0.15915494309189535;
        const float fr_ = (float)(rev - rint(rev));
        cs[i] = make_float2(__builtin_amdgcn_cosf(fr_), __builtin_amdgcn_sinf(fr_));
      }
    } break;
    case 11: {
      const u16* A = (const u16*)(ws + X3B); const u16* W = (const u16*)(ws + WRIN);
      u16* q1 = (u16*)(ws + Q1); u16* k1 = (u16*)(ws + K1); u16* ktd = (u16*)(ws + KTD); u16* vt = (u16*)(ws + VT);
      const float2* cs = (const float2*)(ws + CS);
      run_tiles(128 * 32, vb, nvb, [&](int tile, bool valid) {
        const int mt = tile >> 5, ntile = tile & 31;
        GemmLoad L; set_seg1(L, A + (size_t)mt * 128 * 1024, 1024, W + (size_t)ntile * 128 * 1024, 1024, valid ? 32 : 0, tid);
        gemm_tile(L, 32, hl, tid, [&](f32x4 (&acc)[4][4], int wr, int wc, int fr, int fq) {
          if (!valid) return;
          if (ntile < 16) {
            const int isk = ntile >> 3, hh = (ntile & 7) >> 1, th = ntile & 1;
            const float lg2 = gamma_log2(hh);
#pragma unroll
            for (int m = 0; m < 4; ++m)
#pragma unroll
              for (int j = 0; j < 4; ++j) {
                const int tok = mt * 128 + wr * 64 + m * 16 + fq * 4 + j;
                const float kdec = exp2f((float)(255 - (tok & 255)) * lg2) * 0.0625f;
#pragma unroll
                for (int n = 0; n < 2; ++n) {
                  const int i = th * 64 + wc * 32 + n * 16 + fr;
                  const float2 c = cs[(size_t)tok * 128 + i];
                  const float x1 = acc[m][n][j], x2 = acc[m][n + 2][j];
                  const float r1 = x1 * c.x - x2 * c.y, r2 = x2 * c.x + x1 * c.y;
                  if (!isk) { q1[(size_t)tok * 1024 + hh * 256 + i] = f2bf(r1); q1[(size_t)tok * 1024 + hh * 256 + 128 + i] = f2bf(r2); }
                  else {
                    k1[(size_t)tok * 1024 + hh * 256 + i] = f2bf(r1 * 0.0625f); k1[(size_t)tok * 1024 + hh * 256 + 128 + i] = f2bf(r2 * 0.0625f);
                    ktd[(size_t)(hh * 256 + i) * T + tok] = f2bf(r1 * kdec); ktd[(size_t)(hh * 256 + 128 + i) * T + tok] = f2bf(r2 * kdec);
                  }
                }
              }
          } else {
            const int c0 = (ntile - 16) * 128;
#pragma unroll
            for (int m = 0; m < 4; ++m)
#pragma unroll
              for (int n = 0; n < 4; ++n) {
                const int tok = mt * 128 + wr * 64 + m * 16 + fq * 4, col = c0 + wc * 64 + n * 16 + fr;
                *reinterpret_cast<uint2*>(vt + (size_t)col * T + tok) = make_uint2(pack2(acc[m][n][0], acc[m][n][1]), pack2(acc[m][n][2], acc[m][n][3]));
              }
          }
        });
      });
    } break;
    case 12: {
      const u16* q1 = (const u16*)(ws + Q1); const u16* k1 = (const u16*)(ws + K1); const u16* ktd = (const u16*)(ws + KTD); const u16* vt = (const u16*)(ws + VT);
      u16* kv = (u16*)(ws + KV); u16* sp = (u16*)(ws + SP);
      run_tiles(256 * 8, vb, nvb, [&](int tile, bool valid) {
        const int item = tile >> 3, mt = (tile >> 1) & 3, ntile = tile & 1; const int b = item >> 6, h = (item >> 4) & 3, c = item & 15;
        const size_t t0 = (size_t)b * SEQ + c * 256;
        GemmLoad L; set_seg1(L, vt + (size_t)(h * 512 + mt * 128) * T + t0, T, ktd + (size_t)(h * 256 + ntile * 128) * T + t0, T, valid ? 8 : 0, tid);
        gemm_tile(L, 8, hl, tid, [&](f32x4 (&acc)[4][4], int wr, int wc, int fr, int fq) {
          if (!valid) return;
#pragma unroll
          for (int m = 0; m < 4; ++m)
#pragma unroll
            for (int n = 0; n < 4; ++n)
#pragma unroll
              for (int j = 0; j < 4; ++j)
                kv[(size_t)item * 131072 + (size_t)(mt * 128 + wr * 64 + m * 16 + fq * 4 + j) * 256 + ntile * 128 + wc * 64 + n * 16 + fr] = f2bf(acc[m][n][j]);
        });
      });
      run_tiles(256 * 3, vb, nvb, [&](int tile, bool valid) {
        const int item = tile / 3, tt = tile % 3; const int mt = tt ? 1 : 0, ntile = tt == 2 ? 1 : 0; const int b = item >> 6, h = (item >> 4) & 3, c = item & 15;
        const size_t t0 = (size_t)b * SEQ + c * 256;
        GemmLoad L; set_seg1(L, q1 + (t0 + mt * 128) * 1024 + h * 256, 1024, k1 + (t0 + ntile * 128) * 1024 + h * 256, 1024, valid ? 8 : 0, tid);
        const float lg2 = gamma_log2(h);
        gemm_tile(L, 8, hl, tid, [&](f32x4 (&acc)[4][4], int wr, int wc, int fr, int fq) {
          if (!valid) return;
#pragma unroll
          for (int n = 0; n < 4; ++n) {
            const int jj = ntile * 128 + wc * 64 + n * 16 + fr; const float sc = exp2f(-(float)(jj + 1) * lg2);
#pragma unroll
            for (int m = 0; m < 4; ++m)
#pragma unroll
              for (int j = 0; j < 4; ++j) {
                const int ii = mt * 128 + wr * 64 + m * 16 + fq * 4 + j;
                sp[(size_t)item * 65536 + (size_t)ii * 256 + jj] = f2bf(jj <= ii ? acc[m][n][j] * sc : 0.f);
              }
          }
        });
      });
    } break;
    case 13: {
      u16* kv = (u16*)(ws + KV);
      const size_t gt = (size_t)blockIdx.x * 512 + threadIdx.x, gn = (size_t)gridDim.x * 512;
      for (size_t i = gt; i < (size_t)16 * 16384; i += gn) {
        const int bh = (int)(i >> 14); const size_t el = (i & 16383) * 8; const int h = bh & 3;
        const float cd = exp2f(256.f * gamma_log2(h));
        float s[8];
#pragma unroll
        for (int e = 0; e < 8; ++e) s[e] = 0.f;
        for (int c = 0; c < 16; ++c) {
          uint4* ptr = reinterpret_cast<uint4*>(kv + (size_t)(bh * 16 + c) * 131072 + el);
          const uint4 v = *ptr;
          *ptr = make_uint4(pack2(s[0], s[1]), pack2(s[2], s[3]), pack2(s[4], s[5]), pack2(s[6], s[7]));
          s[0] = s[0] * cd + __uint_as_float(v.x << 16); s[1] = s[1] * cd + __uint_as_float(v.x & 0xffff0000u);
          s[2] = s[2] * cd + __uint_as_float(v.y << 16); s[3] = s[3] * cd + __uint_as_float(v.y & 0xffff0000u);
          s[4] = s[4] * cd + __uint_as_float(v.z << 16); s[5] = s[5] * cd + __uint_as_float(v.z & 0xffff0000u);
          s[6] = s[6] * cd + __uint_as_float(v.w << 16); s[7] = s[7] * cd + __uint_as_float(v.w & 0xffff0000u);
        }
      }
    } break;
    case 14: {
      const u16* q1 = (const u16*)(ws + Q1); const u16* vt = (const u16*)(ws + VT); const u16* kv = (const u16*)(ws + KV); const u16* sp = (const u16*)(ws + SP);
      u16* o1 = (u16*)(ws + O1);
      run_tiles(256 * 8, vb, nvb, [&](int tile, bool valid) {
        const int item = tile >> 3, mt = (tile >> 2) & 1, ntile = tile & 3; const int b = item >> 6, h = (item >> 4) & 3, c = item & 15;
        const size_t t0 = (size_t)b * SEQ + c * 256;
        GemmLoad L; set_seg1(L, sp + (size_t)item * 65536 + (size_t)mt * 128 * 256, 256, vt + (size_t)(h * 512 + ntile * 128) * T + t0, T, valid ? 4 * (mt + 1) : 0, tid);
        { const int r = tid >> 2, kc = (tid & 3) * 8;
          const u16* A2 = q1 + (t0 + mt * 128) * 1024 + h * 256; const u16* B2 = kv + (size_t)item * 131072 + (size_t)ntile * 128 * 256;
          L.c0 = A2 + (size_t)r * 1024 + kc; L.c1 = A2 + (size_t)(r + 64) * 1024 + kc; L.d0 = B2 + (size_t)r * 256 + kc; L.d1 = B2 + (size_t)(r + 64) * 256 + kc; L.nt2 = valid ? 8 : 0; }
        const float lg2 = gamma_log2(h);
        gemm_tile(L, 16, hl, tid, [&](f32x4 (&acc)[4][4], int wr, int wc, int fr, int fq) {
          if (!valid) return;
#pragma unroll
          for (int m = 0; m < 4; ++m)
#pragma unroll
            for (int j = 0; j < 4; ++j) {
              const int ii = mt * 128 + wr * 64 + m * 16 + fq * 4 + j; const float sc = exp2f((float)(ii + 1) * lg2);
#pragma unroll
              for (int n = 0; n < 4; ++n) o1[(t0 + ii) * 2048 + h * 512 + ntile * 128 + wc * 64 + n * 16 + fr] = f2bf(acc[m][n][j] * sc);
            }
        });
      });
    } break;
    case 15: {
      const u16* o1 = (const u16*)(ws + O1); float2* st = (float2*)(ws + GNST);
      for (int it = gw; it < T * 4; it += nw) {
        const uint4 v = *reinterpret_cast<const uint4*>(o1 + (size_t)it * 512 + lane * 8);
        float f[8] = {__uint_as_float(v.x << 16), __uint_as_float(v.x & 0xffff0000u), __uint_as_float(v.y << 16), __uint_as_float(v.y & 0xffff0000u),
                      __uint_as_float(v.z << 16), __uint_as_float(v.z & 0xffff0000u), __uint_as_float(v.w << 16), __uint_as_float(v.w & 0xffff0000u)};
        float s = 0.f;
#pragma unroll
        for (int e = 0; e < 8; ++e) s += f[e];
        const float mu = wsum(s) * (1.f / 512.f);
        float sq = 0.f;
#pragma unroll
        for (int e = 0; e < 8; ++e) { const float d = f[e] - mu; sq += d * d; }
        const float rstd = rsqrtf(wsum(sq) * (1.f / 512.f) + LN_EPS);
        if (lane == 0) st[it] = make_float2(mu, rstd);
      }
      float* tl = (float*)smem;
      const size_t lo = (size_t)16 * 1024 * 512;
      tconv(p.w_gate + lo, 1024 * 512, 512, 1024, 512, 16, (u16*)(ws + W1_GU), 1024 * 1024, 1, tl);
      tconv(p.w_up + lo, 1024 * 512, 512, 1024, 512, 16, (u16*)(ws + W1_GU), 1024 * 1024, 2, tl);
      tconv(p.w_down + lo, 512 * 1024, 1024, 512, 1024, 16, (u16*)(ws + W1_D), 1024 * 512, 0, tl);
      tconv(p.ple_gate + (size_t)1024 * 1024, 0, 1024, 1024, 1024, 1, (u16*)(ws + W1_PG), 0, 0, tl);
      tconv(p.ple_proj + (size_t)256 * 1024, 0, 1024, 256, 1024, 1, (u16*)(ws + W1_PP), 0, 0, tl);
    } break;
    case 16: {
      const u16* A = (const u16*)(ws + X3B); const u16* W = (const u16*)(ws + WRIN) + (size_t)4096 * 1024;
      u16* o1 = (u16*)(ws + O1); const float2* st = (const float2*)(ws + GNST);
      run_tiles(128 * 16, vb, nvb, [&](int tile, bool valid) {
        const int mt = tile >> 4, ntile = tile & 15;
        GemmLoad L; set_seg1(L, A + (size_t)mt * 128 * 1024, 1024, W + (size_t)ntile * 128 * 1024, 1024, valid ? 32 : 0, tid);
        gemm_tile(L, 32, hl, tid, [&](f32x4 (&acc)[4][4], int wr, int wc, int fr, int fq) {
          if (!valid) return;
          const int hh = ntile >> 2;
#pragma unroll
          for (int m = 0; m < 4; ++m)
#pragma unroll
            for (int j = 0; j < 4; ++j) {
              const int tok = mt * 128 + wr * 64 + m * 16 + fq * 4 + j; const float2 ms = st[tok * 4 + hh];
#pragma unroll
              for (int n = 0; n < 4; ++n) {
                const size_t idx = (size_t)tok * 2048 + ntile * 128 + wc * 64 + n * 16 + fr;
                o1[idx] = f2bf(siluf(acc[m][n][j]) * ((bf2f(o1[idx]) - ms.x) * ms.y));
              }
            }
        });
      });
    } break;
    default: break;
    }
  }
}

#define PHASE(n) if (ph0 <= n && n < ph1) { run_phase<n>(p, smem); if (n + 1 < ph1) grid.sync(); }
__global__ void __launch_bounds__(512) mega(P p, int ph0, int ph1) {
  extern __shared__ __attribute__((aligned(16))) char smem[];
  cg::grid_group grid = cg::this_grid();
  PHASE(0) PHASE(1) PHASE(2) PHASE(3) PHASE(4) PHASE(5) PHASE(6) PHASE(7) PHASE(8) PHASE(9) PHASE(10) PHASE(11)
  PHASE(12) PHASE(13) PHASE(14) PHASE(15) PHASE(16) PHASE(17) PHASE(18) PHASE(19) PHASE(20) PHASE(21) PHASE(22)
}

extern "C" void kernel_launch(void* const* d_in, const int* in_sizes, int n_in, void* d_out, int out_size, void* d_ws, size_t ws_size, hipStream_t stream) {
  static int grid_blocks = 0;
  if (!grid_blocks) {
    int dev = 0, cus = 0, per_cu = 0;
    hipGetDevice(&dev);
    hipDeviceGetAttribute(&cus, hipDeviceAttributeMultiprocessorCount, dev);
    hipFuncSetAttribute((const void*)mega, hipFuncAttributeMaxDynamicSharedMemorySize, LDS_BYTES);
    hipOccupancyMaxActiveBlocksPerMultiprocessor(&per_cu, (const void*)mega, 512, LDS_BYTES);
    if (per_cu < 1) { fprintf(stderr, "occupancy query returned %d\n", per_cu); per_cu = 1; }
    grid_blocks = cus * 1;
    if (ws_size < 345 * MiB) fprintf(stderr, "workspace too small: %zu\n", ws_size);
  }
  P p{};
  p.x = (const float*)d_in[0]; p.p = (const float*)d_in[1]; p.pos = (const int*)d_in[2];
  p.fox_w_in = (const float*)d_in[3]; p.fox_b_f = (const float*)d_in[4]; p.fox_w_out = (const float*)d_in[5];
  p.ret_w_in = (const float*)d_in[6]; p.ret_w_out = (const float*)d_in[7];
  p.ln1_g = (const float*)d_in[8]; p.ln1_b = (const float*)d_in[9]; p.ln2_g = (const float*)d_in[10]; p.ln2_b = (const float*)d_in[11];
  p.w_group = (const float*)d_in[12]; p.b_group = (const float*)d_in[13]; p.w_router = (const float*)d_in[14]; p.b_router = (const float*)d_in[15];
  p.w_gate = (const float*)d_in[16]; p.w_up = (const float*)d_in[17]; p.w_down = (const float*)d_in[18];
  p.ple_proj = (const float*)d_in[19]; p.ple_gate = (const float*)d_in[20]; p.ple_b = (const float*)d_in[21];
  p.out = (float*)d_out; p.ws = (char*)d_ws;
#if MEGA
  int ph0 = 0, ph1 = NPH;
  void* args[] = {&p, &ph0, &ph1};
  hipError_t e = hipLaunchCooperativeKernel((const void*)mega, dim3(grid_blocks), dim3(512), args, LDS_BYTES, stream);
  if (e != hipSuccess) fprintf(stderr, "cooperative launch failed: %s (grid %d)\n", hipGetErrorString(e), grid_blocks);
#else
  for (int ph = 0; ph < NPH; ++ph) hipLaunchKernelGGL(mega, dim3(grid_blocks), dim3(512), LDS_BYTES, stream, p, ph, ph + 1);
#endif
}
```

```cpp
#include <hip/hip_runtime.h>
#include <hip/hip_cooperative_groups.h>
#include <cstdio>
#include <cstdint>
namespace cg = cooperative_groups;

#ifndef MEGA
#define MEGA 1
#endif

typedef unsigned short u16;
using bf16x8 = __attribute__((ext_vector_type(8))) short;
using f32x4 = __attribute__((ext_vector_type(4))) float;
#define DEVI __device__ __forceinline__

constexpr int T = 16384, SEQ = 4096;
constexpr size_t MiB = 1ull << 20;
constexpr float ALPHA = 1.4142135623730951f;
constexpr float LN_EPS = 1e-5f;
constexpr int NPH = 23;
constexpr int LDS_BYTES = 65536;

constexpr size_t W0_QKV = 0, W0_OUT = 7 * MiB, W0_GU = 9 * MiB, W0_D = 41 * MiB, W0_PG = 57 * MiB, W0_PP = 59 * MiB;
constexpr size_t QKV0 = 60 * MiB, X1B0 = 60 * MiB, YBUF0 = 60 * MiB, HBUF0 = 124 * MiB, X2B0 = 124 * MiB;
constexpr size_t VR0 = 156 * MiB, PP0 = 220 * MiB, XB0 = 284 * MiB, O0 = 284 * MiB, X3B = 284 * MiB;
constexpr size_t PB = 316 * MiB, CS = 324 * MiB, LOGF = 340 * MiB, C8 = 341 * MiB, LISTS = 342 * MiB, TOKW = 343 * MiB;
constexpr size_t GNST = 343 * MiB + 512 * 1024, CNT = 344 * MiB;
constexpr size_t WRIN = 0, WROUT = 12 * MiB, Q1 = 16 * MiB, K1 = 48 * MiB, KTD = 80 * MiB, VT = 112 * MiB, O1 = 48 * MiB;
constexpr size_t KV = 176 * MiB, SP = 240 * MiB, W1_GU = 176 * MiB, W1_D = 208 * MiB, W1_PG = 224 * MiB, W1_PP = 226 * MiB;
constexpr size_t VR1 = 112 * MiB, PP1 = 240 * MiB, X1B1 = 16 * MiB, HBUF1 = 80 * MiB, YBUF1 = 0, X2B1 = 80 * MiB;

struct P {
  const float *x, *p; const int* pos;
  const float *fox_w_in, *fox_b_f, *fox_w_out, *ret_w_in, *ret_w_out, *ln1_g, *ln1_b, *ln2_g, *ln2_b;
  const float *w_group, *b_group, *w_router, *b_router, *w_gate, *w_up, *w_down, *ple_proj, *ple_gate, *ple_b;
  float* out; char* ws;
};

DEVI float bf2f(u16 b) { return __uint_as_float(((unsigned)b) << 16); }
DEVI u16 f2bf(float f) { unsigned u = __float_as_uint(f); u += 0x7FFFu + ((u >> 16) & 1u); return (u16)(u >> 16); }
DEVI unsigned pack2(float a, float b) { return (unsigned)f2bf(a) | ((unsigned)f2bf(b) << 16); }
DEVI float wsum(float v) {
#pragma unroll
  for (int o = 32; o >= 1; o >>= 1) v += __shfl_xor(v, o);
  return v;
}
DEVI float siluf(float v) { return v / (1.f + __expf(-v)); }
DEVI float logsig(float z) { return fminf(z, 0.f) - log1pf(__expf(-fabsf(z))); }

struct GemmLoad {
  const u16 *a0, *a1, *b0, *b1;
  const u16 *c0, *c1, *d0, *d1;
  int nt1, nt2;
};
DEVI void glds16(const u16* g, char* l) {
  __builtin_amdgcn_global_load_lds((const __attribute__((address_space(1))) void*)g, (__attribute__((address_space(3))) void*)l, 16, 0, 0);
}
template <class Epi>
DEVI void gemm_tile(const GemmLoad& L, int nt_max, char* lds, int tid, Epi&& epi) {
  const int wid = tid >> 6, lane = tid & 63, wr = wid >> 1, wc = wid & 1, fr = lane & 15, fq = lane >> 4;
  f32x4 acc[4][4];
#pragma unroll
  for (int m = 0; m < 4; ++m)
#pragma unroll
    for (int n = 0; n < 4; ++n) acc[m][n] = f32x4{0.f, 0.f, 0.f, 0.f};
  const int nt = L.nt1 + L.nt2;
  auto stage = [&](int t, int buf) {
    char* sa = lds + buf * 16384 + tid * 16; char* sb = sa + 8192;
    const u16 *pa0, *pa1, *pb0, *pb1;
    if (t < L.nt1) { pa0 = L.a0 + t * 32; pa1 = L.a1 + t * 32; pb0 = L.b0 + t * 32; pb1 = L.b1 + t * 32; }
    else { const int t2 = t - L.nt1; pa0 = L.c0 + t2 * 32; pa1 = L.c1 + t2 * 32; pb0 = L.d0 + t2 * 32; pb1 = L.d1 + t2 * 32; }
    glds16(pa0, sa); glds16(pa1, sa + 4096); glds16(pb0, sb); glds16(pb1, sb + 4096);
  };
  if (nt > 0) stage(0, 0);
  for (int t = 0; t < nt_max; ++t) {
    asm volatile("s_waitcnt vmcnt(0)" ::: "memory");
    __syncthreads();
    if (t + 1 < nt) stage(t + 1, (t + 1) & 1);
    if (t < nt) {
      const char* sa = lds + (t & 1) * 16384; const char* sb = sa + 8192;
      bf16x8 af[4], bfv[4];
#pragma unroll
      for (int m = 0; m < 4; ++m) af[m] = *reinterpret_cast<const bf16x8*>(sa + (wr * 64 + m * 16 + fr) * 64 + fq * 16);
#pragma unroll
      for (int n = 0; n < 4; ++n) bfv[n] = *reinterpret_cast<const bf16x8*>(sb + (wc * 64 + n * 16 + fr) * 64 + fq * 16);
#pragma unroll
      for (int m = 0; m < 4; ++m)
#pragma unroll
        for (int n = 0; n < 4; ++n) acc[m][n] = __builtin_amdgcn_mfma_f32_16x16x32_bf16(af[m], bfv[n], acc[m][n], 0, 0, 0);
    }
  }
  __syncthreads();
  epi(acc, wr, wc, fr, fq);
}
template <class TF>
DEVI void run_tiles(int ntiles, int vb, int nvb, TF&& f) {
  const int niter = (ntiles + nvb - 1) / nvb;
  for (int it = 0; it < niter; ++it) { const int tile = it * nvb + vb; const bool valid = tile < ntiles; f(valid ? tile : 0, valid); }
}
DEVI void set_seg1(GemmLoad& L, const u16* A, size_t lda, const u16* B, size_t ldb, int nt, int tid) {
  const int r = tid >> 2, kc = (tid & 3) * 8;
  L.a0 = A + (size_t)r * lda + kc; L.a1 = A + (size_t)(r + 64) * lda + kc;
  L.b0 = B + (size_t)r * ldb + kc; L.b1 = B + (size_t)(r + 64) * ldb + kc;
  L.c0 = L.a0; L.c1 = L.a1; L.d0 = L.b0; L.d1 = L.b1; L.nt1 = nt; L.nt2 = 0;
}

DEVI int rowmap(int mode, int n) {
  if (mode == 0) return n;
  if (mode == 1 || mode == 2) { const int tile = n >> 6, w = n & 63, wc = w >> 5, rr = w & 31; return tile * 128 + wc * 64 + (mode == 2 ? 32 : 0) + rr; }
  const int hh = n >> 8, ip = n & 255, comp = ip >> 7, i = ip & 127, th = i >> 6, w = i & 63, wc = w >> 5, rr = w & 31;
  return hh * 256 + th * 128 + wc * 64 + comp * 32 + rr;
}
DEVI void tconv(const float* __restrict__ src, size_t sbs, int ldsrc, int K, int N, int nbatch, u16* __restrict__ dst, size_t dbs, int mode, float* tl) {
  const int tid = threadIdx.x; const int tk = K >> 6, tn = N >> 6; const int per = tk * tn, nt = per * nbatch;
  for (int tile = blockIdx.x; tile < nt; tile += gridDim.x) {
    const int b = tile / per, tt = tile % per; const int k0 = (tt / tn) << 6, n0 = (tt % tn) << 6;
    const float* s = src + (size_t)b * sbs; u16* d = dst + (size_t)b * dbs;
    { const int ty = tid >> 6, tx = tid & 63;
#pragma unroll
      for (int r = 0; r < 8; ++r) { const int k = ty * 8 + r; tl[k * 65 + tx] = s[(size_t)(k0 + k) * ldsrc + n0 + tx]; } }
    __syncthreads();
    { const int n = tid >> 3, kc = tid & 7;
      const unsigned w0 = pack2(tl[(kc * 8 + 0) * 65 + n], tl[(kc * 8 + 1) * 65 + n]);
      const unsigned w1 = pack2(tl[(kc * 8 + 2) * 65 + n], tl[(kc * 8 + 3) * 65 + n]);
      const unsigned w2 = pack2(tl[(kc * 8 + 4) * 65 + n], tl[(kc * 8 + 5) * 65 + n]);
      const unsigned w3 = pack2(tl[(kc * 8 + 6) * 65 + n], tl[(kc * 8 + 7) * 65 + n]);
      const int nr = rowmap(mode, n0 + n);
      *reinterpret_cast<uint4*>(d + (size_t)nr * K + k0 + kc * 8) = make_uint4(w0, w1, w2, w3); }
    __syncthreads();
  }
}
DEVI void econv(const float* __restrict__ src, u16* __restrict__ dst, size_t n) {
  const size_t gt = (size_t)blockIdx.x * 512 + threadIdx.x, gn = (size_t)gridDim.x * 512;
  for (size_t i = gt * 4; i < n; i += gn * 4) {
    const float4 v = *reinterpret_cast<const float4*>(src + i);
    *reinterpret_cast<uint2*>(dst + i) = make_uint2(pack2(v.x, v.y), pack2(v.z, v.w));
  }
}

DEVI float gamma_log2(int h) { return log2f(1.0f - exp2f(-5.0f - (float)h)); }

DEVI int moe_ntiles(const int* cnt, int ntn) { int s = 0; for (int i = 0; i < 16; ++i) s += ((cnt[i] + 127) >> 7) * ntn; return s; }
DEVI void moe_tile(const int* cnt, int tile, int ntn, int& e, int& mt, int& nt, int& base, int& ce) {
  int at = 0, b = 0; e = 0; mt = 0; nt = 0; base = 0; ce = 0;
  for (int i = 0; i < 16; ++i) {
    const int c = cnt[i]; const int tl = ((c + 127) >> 7) * ntn;
    if (tile >= at && tile < at + tl) { const int r = tile - at; e = i; mt = r / ntn; nt = r % ntn; base = b; ce = c; }
    at += tl; b += c;
  }
}

template <int ph>
DEVI void run_phase(const P& p, char* smem) {
  const int half = threadIdx.x >> 8, tid = threadIdx.x & 255;
  const int vb = blockIdx.x * 2 + half, nvb = gridDim.x * 2;
  char* hl = smem + half * 32768;
  const int lane = threadIdx.x & 63;
  const int gw = blockIdx.x * 8 + (threadIdx.x >> 6), nw = gridDim.x * 8;
  char* ws = p.ws;
  (void)hl; (void)lane; (void)gw; (void)nw; (void)vb; (void)nvb; (void)tid;
  {
    constexpr int layer = (ph >= 10) ? 1 : 0;
    switch (ph) {
    case 0: {
      float* tl = (float*)smem;
      if (blockIdx.x == 0 && threadIdx.x < 32) ((int*)(ws + CNT))[threadIdx.x] = 0;
      econv(p.x, (u16*)(ws + XB0), (size_t)T * 1024);
      econv(p.p, (u16*)(ws + PB), (size_t)T * 256);
      tconv(p.fox_w_in, 0, 3088, 1024, 3072, 1, (u16*)(ws + W0_QKV), 0, 0, tl);
      {
        const int gt = blockIdx.x * 512 + threadIdx.x;
        if (gt < 16384) { const int n = gt >> 10, k = gt & 1023; ((u16*)(ws + W0_QKV))[(size_t)(3072 + n) * 1024 + k] = f2bf(p.fox_w_in[(size_t)k * 3088 + 3072 + n]); }
      }
      tconv(p.fox_w_out, 0, 1024, 1024, 1024, 1, (u16*)(ws + W0_OUT), 0, 0, tl);
      tconv(p.w_gate, 1024 * 512, 512, 1024, 512, 16, (u16*)(ws + W0_GU), 1024 * 1024, 1, tl);
      tconv(p.w_up, 1024 * 512, 512, 1024, 512, 16, (u16*)(ws + W0_GU), 1024 * 1024, 2, tl);
      tconv(p.w_down, 512 * 1024, 1024, 512, 1024, 16, (u16*)(ws + W0_D), 1024 * 512, 0, tl);
      tconv(p.ple_gate, 0, 1024, 1024, 1024, 1, (u16*)(ws + W0_PG), 0, 0, tl);
      tconv(p.ple_proj, 0, 1024, 256, 1024, 1, (u16*)(ws + W0_PP), 0, 0, tl);
    } break;
    case 1: {
      const u16* xb = (const u16*)(ws + XB0); const u16* w = (const u16*)(ws + W0_QKV);
      u16* qkv = (u16*)(ws + QKV0); float* logf_ = (float*)(ws + LOGF);
      run_tiles(128 * 25, vb, nvb, [&](int tile, bool valid) {
        const int mt = tile / 25, ntile = tile % 25;
        GemmLoad L; set_seg1(L, xb + (size_t)mt * 128 * 1024, 1024, w + (size_t)ntile * 128 * 1024, 1024, valid ? 32 : 0, tid);
        gemm_tile(L, 32, hl, tid, [&](f32x4 (&acc)[4][4], int wr, int wc, int fr, int fq) {
          if (!valid) return;
          if (ntile < 24) {
#pragma unroll
            for (int m = 0; m < 4; ++m)
#pragma unroll
              for (int n = 0; n < 4; ++n)
#pragma unroll
                for (int j = 0; j < 4; ++j) {
                  const int row = mt * 128 + wr * 64 + m * 16 + fq * 4 + j, col = ntile * 128 + wc * 64 + n * 16 + fr;
                  qkv[(size_t)row * 3072 + col] = f2bf(acc[m][n][j]);
                }
          } else if (wc == 0) {
            const float bf_ = p.fox_b_f[fr];
#pragma unroll
            for (int m = 0; m < 4; ++m)
#pragma unroll
              for (int j = 0; j < 4; ++j) {
                const int row = mt * 128 + wr * 64 + m * 16 + fq * 4 + j;
                logf_[row * 16 + fr] = logsig(acc[m][0][j] + bf_);
              }
          }
        });
      });
    } break;
    case 2: {
      const float* logf_ = (const float*)(ws + LOGF); float* c8 = (float*)(ws + C8);
      for (int bh = gw; bh < 64; bh += nw) {
        const int b = bh >> 4, h = bh & 15;
        const float* src = logf_ + (size_t)(b * SEQ + lane * 64) * 16 + h;
        float s = 0.f;
        for (int i = 0; i < 64; ++i) s += src[i * 16];
        float incl = s;
#pragma unroll
        for (int o = 1; o < 64; o <<= 1) { const float t2 = __shfl_up(incl, o); if (lane >= o) incl += t2; }
        float run = incl - s;
        float* dst = c8 + (size_t)bh * SEQ + lane * 64;
        for (int i = 0; i < 64; ++i) { run += src[i * 16]; dst[i] = 8.f * run; }
      }
    } break;
    case 3: {
      const u16* qkv = (const u16*)(ws + QKV0); const float* c8 = (const float*)(ws + C8); u16* O = (u16*)(ws + O0);
      for (int w = gw; w < 2048; w += nw) {
        const int bh = w >> 5, jp = w & 31; const int b = bh >> 4, h = bh & 15;
        for (int side = 0; side < 2; ++side) {
          const int qg = side ? 63 - jp : jp; const int qpos = qg * 64 + lane;
          const u16* qrow = qkv + (size_t)(b * SEQ + qpos) * 3072 + h * 64;
          float q[64], o[64];
#pragma unroll
          for (int c = 0; c < 8; ++c) { const uint4 v = *reinterpret_cast<const uint4*>(qrow + c * 8);
            q[c * 8 + 0] = __uint_as_float(v.x << 16); q[c * 8 + 1] = __uint_as_float(v.x & 0xffff0000u);
            q[c * 8 + 2] = __uint_as_float(v.y << 16); q[c * 8 + 3] = __uint_as_float(v.y & 0xffff0000u);
            q[c * 8 + 4] = __uint_as_float(v.z << 16); q[c * 8 + 5] = __uint_as_float(v.z & 0xffff0000u);
            q[c * 8 + 6] = __uint_as_float(v.w << 16); q[c * 8 + 7] = __uint_as_float(v.w & 0xffff0000u); }
#pragma unroll
          for (int d = 0; d < 64; ++d) o[d] = 0.f;
          const float cq = c8[(size_t)bh * SEQ + qpos];
          float mrun = -INFINITY, l = 0.f;
          const int kend = qg * 64 + 64;
#pragma unroll 1
          for (int key = 0; key < kend; ++key) {
            const u16* krow = qkv + (size_t)(b * SEQ + key) * 3072 + 1024 + h * 64;
            float dot = 0.f;
#pragma unroll
            for (int c = 0; c < 8; ++c) { const uint4 v = *reinterpret_cast<const uint4*>(krow + c * 8);
              dot += q[c * 8 + 0] * __uint_as_float(v.x << 16); dot += q[c * 8 + 1] * __uint_as_float(v.x & 0xffff0000u);
              dot += q[c * 8 + 2] * __uint_as_float(v.y << 16); dot += q[c * 8 + 3] * __uint_as_float(v.y & 0xffff0000u);
              dot += q[c * 8 + 4] * __uint_as_float(v.z << 16); dot += q[c * 8 + 5] * __uint_as_float(v.z & 0xffff0000u);
              dot += q[c * 8 + 6] * __uint_as_float(v.w << 16); dot += q[c * 8 + 7] * __uint_as_float(v.w & 0xffff0000u); }
            const float ck = c8[(size_t)bh * SEQ + key];
            const float s = (key <= qpos) ? 0.125f * (dot + cq - ck) : -INFINITY;
            const float mnew = fmaxf(mrun, s);
            const float al = __expf(mrun - mnew);
            const float pr = __expf(s - mnew);
            mrun = mnew;
            l = l * al + pr;
            const u16* vrow = qkv + (size_t)(b * SEQ + key) * 3072 + 2048 + h * 64;
#pragma unroll
            for (int c = 0; c < 8; ++c) { const uint4 v = *reinterpret_cast<const uint4*>(vrow + c * 8);
              o[c * 8 + 0] = o[c * 8 + 0] * al + pr * __uint_as_float(v.x << 16); o[c * 8 + 1] = o[c * 8 + 1] * al + pr * __uint_as_float(v.x & 0xffff0000u);
              o[c * 8 + 2] = o[c * 8 + 2] * al + pr * __uint_as_float(v.y << 16); o[c * 8 + 3] = o[c * 8 + 3] * al + pr * __uint_as_float(v.y & 0xffff0000u);
              o[c * 8 + 4] = o[c * 8 + 4] * al + pr * __uint_as_float(v.z << 16); o[c * 8 + 5] = o[c * 8 + 5] * al + pr * __uint_as_float(v.z & 0xffff0000u);
              o[c * 8 + 6] = o[c * 8 + 6] * al + pr * __uint_as_float(v.w << 16); o[c * 8 + 7] = o[c * 8 + 7] * al + pr * __uint_as_float(v.w & 0xffff0000u); }
          }
          const float il = 1.f / l;
          u16* orow = O + (size_t)(b * SEQ + qpos) * 1024 + h * 64;
#pragma unroll
          for (int c = 0; c < 8; ++c)
            *reinterpret_cast<uint4*>(orow + c * 8) = make_uint4(pack2(o[c * 8] * il, o[c * 8 + 1] * il), pack2(o[c * 8 + 2] * il, o[c * 8 + 3] * il),
                                                                 pack2(o[c * 8 + 4] * il, o[c * 8 + 5] * il), pack2(o[c * 8 + 6] * il, o[c * 8 + 7] * il));
        }
      }
    } break;
    case 4: case 17: {
      const u16* A = (const u16*)(ws + (layer ? O1 : O0)); const u16* W = (const u16*)(ws + (layer ? WROUT : W0_OUT));
      const int K = layer ? 2048 : 1024;
      const float* xres = layer ? p.out : p.x; float* vr = (float*)(ws + (layer ? VR1 : VR0));
      run_tiles(128 * 8, vb, nvb, [&](int tile, bool valid) {
        const int mt = tile >> 3, ntile = tile & 7;
        GemmLoad L; set_seg1(L, A + (size_t)mt * 128 * K, K, W + (size_t)ntile * 128 * K, K, valid ? K / 32 : 0, tid);
        gemm_tile(L, K / 32, hl, tid, [&](f32x4 (&acc)[4][4], int wr, int wc, int fr, int fq) {
          if (!valid) return;
#pragma unroll
          for (int m = 0; m < 4; ++m)
#pragma unroll
            for (int n = 0; n < 4; ++n)
#pragma unroll
              for (int j = 0; j < 4; ++j) {
                const size_t idx = (size_t)(mt * 128 + wr * 64 + m * 16 + fq * 4 + j) * 1024 + ntile * 128 + wc * 64 + n * 16 + fr;
                vr[idx] = ALPHA * xres[idx] + acc[m][n][j];
              }
        });
      });
      const u16* pb = (const u16*)(ws + PB); const u16* wpp = (const u16*)(ws + (layer ? W1_PP : W0_PP)); float* pp = (float*)(ws + (layer ? PP1 : PP0));
      run_tiles(128 * 8, vb, nvb, [&](int tile, bool valid) {
        const int mt = tile >> 3, ntile = tile & 7;
        GemmLoad L; set_seg1(L, pb + (size_t)mt * 128 * 256, 256, wpp + (size_t)ntile * 128 * 256, 256, valid ? 8 : 0, tid);
        gemm_tile(L, 8, hl, tid, [&](f32x4 (&acc)[4][4], int wr, int wc, int fr, int fq) {
          if (!valid) return;
#pragma unroll
          for (int m = 0; m < 4; ++m)
#pragma unroll
            for (int n = 0; n < 4; ++n)
#pragma unroll
              for (int j = 0; j < 4; ++j) {
                const size_t idx = (size_t)(mt * 128 + wr * 64 + m * 16 + fq * 4 + j) * 1024 + ntile * 128 + wc * 64 + n * 16 + fr;
                pp[idx] = acc[m][n][j];
              }
        });
      });
    } break;
    case 5: case 18: {
      float* vr = (float*)(ws + (layer ? VR1 : VR0)); u16* x1b = (u16*)(ws + (layer ? X1B1 : X1B0));
      const float* g = p.ln1_g + layer * 1024; const float* bb = p.ln1_b + layer * 1024;
      const float* wg = p.w_group + (size_t)layer * 1024 * 4; const float* wrt = p.w_router + (size_t)layer * 1024 * 16;
      const float* bg = p.b_group + layer * 4; const float* br = p.b_router + layer * 16;
      int* cnt = (int*)(ws + CNT) + layer * 16; int* lists = (int*)(ws + LISTS); float* tokw = (float*)(ws + TOKW);
      for (int tok = gw; tok < T; tok += nw) {
        float* row = vr + (size_t)tok * 1024;
        float4 v[4];
#pragma unroll
        for (int i = 0; i < 4; ++i) v[i] = *reinterpret_cast<const float4*>(row + i * 256 + lane * 4);
        float s = 0.f;
#pragma unroll
        for (int i = 0; i < 4; ++i) s += v[i].x + v[i].y + v[i].z + v[i].w;
        const float mu = wsum(s) * (1.f / 1024.f);
        float sq = 0.f;
#pragma unroll
        for (int i = 0; i < 4; ++i) { v[i].x -= mu; v[i].y -= mu; v[i].z -= mu; v[i].w -= mu; sq += v[i].x * v[i].x + v[i].y * v[i].y + v[i].z * v[i].z + v[i].w * v[i].w; }
        const float rstd = rsqrtf(wsum(sq) * (1.f / 1024.f) + LN_EPS);
        float lg[20];
#pragma unroll
        for (int o = 0; o < 20; ++o) lg[o] = 0.f;
#pragma unroll
        for (int i = 0; i < 4; ++i) {
          const int c0 = i * 256 + lane * 4;
          const float4 gg = *reinterpret_cast<const float4*>(g + c0), be = *reinterpret_cast<const float4*>(bb + c0);
          v[i].x = v[i].x * rstd * gg.x + be.x; v[i].y = v[i].y * rstd * gg.y + be.y; v[i].z = v[i].z * rstd * gg.z + be.z; v[i].w = v[i].w * rstd * gg.w + be.w;
          *reinterpret_cast<float4*>(row + c0) = v[i];
          *reinterpret_cast<uint2*>(x1b + (size_t)tok * 1024 + c0) = make_uint2(pack2(v[i].x, v[i].y), pack2(v[i].z, v[i].w));
          const float xe[4] = {v[i].x, v[i].y, v[i].z, v[i].w};
#pragma unroll
          for (int e = 0; e < 4; ++e) {
            const float4 w4 = *reinterpret_cast<const float4*>(wg + (size_t)(c0 + e) * 4);
            lg[0] += xe[e] * w4.x; lg[1] += xe[e] * w4.y; lg[2] += xe[e] * w4.z; lg[3] += xe[e] * w4.w;
#pragma unroll
            for (int q4 = 0; q4 < 4; ++q4) {
              const float4 r4 = *reinterpret_cast<const float4*>(wrt + (size_t)(c0 + e) * 16 + q4 * 4);
              lg[4 + q4 * 4 + 0] += xe[e] * r4.x; lg[4 + q4 * 4 + 1] += xe[e] * r4.y; lg[4 + q4 * 4 + 2] += xe[e] * r4.z; lg[4 + q4 * 4 + 3] += xe[e] * r4.w;
            }
          }
        }
#pragma unroll
        for (int o = 0; o < 20; ++o) lg[o] = wsum(lg[o]);
        if (lane == 0) {
          float gl[4];
#pragma unroll
          for (int i = 0; i < 4; ++i) gl[i] = lg[i] + bg[i];
          int gi = 0; float gm = gl[0];
#pragma unroll
          for (int i = 1; i < 4; ++i) if (gl[i] > gm) { gm = gl[i]; gi = i; }
          float gs = 0.f;
#pragma unroll
          for (int i = 0; i < 4; ++i) gs += __expf(gl[i] - gm);
          const float gval = 1.f / gs;
          float el[4];
#pragma unroll
          for (int i = 0; i < 4; ++i) {
            float t0 = lg[4 + i] + br[i], t1 = lg[8 + i] + br[4 + i], t2 = lg[12 + i] + br[8 + i], t3 = lg[16 + i] + br[12 + i];
            el[i] = gi == 0 ? t0 : (gi == 1 ? t1 : (gi == 2 ? t2 : t3));
          }
          int i0 = 0; float m0 = el[0];
#pragma unroll
          for (int i = 1; i < 4; ++i) if (el[i] > m0) { m0 = el[i]; i0 = i; }
          int i1 = -1; float m1 = -INFINITY;
#pragma unroll
          for (int i = 0; i < 4; ++i) if (i != i0 && el[i] > m1) { m1 = el[i]; i1 = i; }
          const float e1 = __expf(m1 - m0); const float w0 = gval / (1.f + e1), w1 = gval * e1 / (1.f + e1);
          const int ex0 = gi * 4 + i0, ex1 = gi * 4 + i1;
          const int s0 = atomicAdd(&cnt[ex0], 1); lists[ex0 * T + s0] = tok * 2;
          const int s1 = atomicAdd(&cnt[ex1], 1); lists[ex1 * T + s1] = tok * 2 + 1;
          tokw[tok * 2] = w0; tokw[tok * 2 + 1] = w1;
        }
      }
    } break;
    case 6: case 19: {
      const u16* x1b = (const u16*)(ws + (layer ? X1B1 : X1B0)); const u16* wgu = (const u16*)(ws + (layer ? W1_GU : W0_GU));
      u16* hb = (u16*)(ws + (layer ? HBUF1 : HBUF0));
      const int* cnt = (const int*)(ws + CNT) + layer * 16; const int* lists = (const int*)(ws + LISTS);
      const int ntiles = moe_ntiles(cnt, 8);
      run_tiles(ntiles, vb, nvb, [&](int tile, bool valid) {
        int e, mt, ntile, base, ce; moe_tile(cnt, tile, 8, e, mt, ntile, base, ce);
        if (ce == 0) valid = false;
        GemmLoad L; const int r = tid >> 2, kc = (tid & 3) * 8;
        int s0 = mt * 128 + r, s1 = s0 + 64; if (s0 >= ce) s0 = ce > 0 ? ce - 1 : 0; if (s1 >= ce) s1 = ce > 0 ? ce - 1 : 0;
        const int t0 = valid ? (lists[e * T + s0] >> 1) : 0, t1 = valid ? (lists[e * T + s1] >> 1) : 0;
        L.a0 = x1b + (size_t)t0 * 1024 + kc; L.a1 = x1b + (size_t)t1 * 1024 + kc;
        const u16* B = wgu + (size_t)e * 1024 * 1024 + (size_t)ntile * 128 * 1024;
        L.b0 = B + (size_t)r * 1024 + kc; L.b1 = B + (size_t)(r + 64) * 1024 + kc;
        L.c0 = L.a0; L.c1 = L.a1; L.d0 = L.b0; L.d1 = L.b1; L.nt1 = valid ? 32 : 0; L.nt2 = 0;
        gemm_tile(L, 32, hl, tid, [&](f32x4 (&acc)[4][4], int wr, int wc, int fr, int fq) {
          if (!valid) return;
#pragma unroll
          for (int m = 0; m < 4; ++m)
#pragma unroll
            for (int j = 0; j < 4; ++j) {
              const int slot = mt * 128 + wr * 64 + m * 16 + fq * 4 + j;
              if (slot < ce) {
#pragma unroll
                for (int n = 0; n < 2; ++n) {
                  const float hv = siluf(acc[m][n][j]) * acc[m][n + 2][j];
                  hb[(size_t)(base + slot) * 512 + ntile * 64 + wc * 32 + n * 16 + fr] = f2bf(hv);
                }
              }
            }
        });
      });
    } break;
    case 7: case 20: {
      const u16* hb = (const u16*)(ws + (layer ? HBUF1 : HBUF0)); const u16* wd = (const u16*)(ws + (layer ? W1_D : W0_D));
      u16* yb = (u16*)(ws + (layer ? YBUF1 : YBUF0));
      const int* cnt = (const int*)(ws + CNT) + layer * 16; const int* lists = (const int*)(ws + LISTS); const float* tokw = (const float*)(ws + TOKW);
      const int ntiles = moe_ntiles(cnt, 8);
      run_tiles(ntiles, vb, nvb, [&](int tile, bool valid) {
        int e, mt, ntile, base, ce; moe_tile(cnt, tile, 8, e, mt, ntile, base, ce);
        if (ce == 0) valid = false;
        GemmLoad L; const int r = tid >> 2, kc = (tid & 3) * 8;
        int s0 = mt * 128 + r, s1 = s0 + 64; if (s0 >= ce) s0 = ce > 0 ? ce - 1 : 0; if (s1 >= ce) s1 = ce > 0 ? ce - 1 : 0;
        L.a0 = hb + (size_t)(base + s0) * 512 + kc; L.a1 = hb + (size_t)(base + s1) * 512 + kc;
        const u16* B = wd + (size_t)e * 1024 * 512 + (size_t)ntile * 128 * 512;
        L.b0 = B + (size_t)r * 512 + kc; L.b1 = B + (size_t)(r + 64) * 512 + kc;
        L.c0 = L.a0; L.c1 = L.a1; L.d0 = L.b0; L.d1 = L.b1; L.nt1 = valid ? 16 : 0; L.nt2 = 0;
        gemm_tile(L, 16, hl, tid, [&](f32x4 (&acc)[4][4], int wr, int wc, int fr, int fq) {
          if (!valid) return;
#pragma unroll
          for (int m = 0; m < 4; ++m)
#pragma unroll
            for (int j = 0; j < 4; ++j) {
              const int slot = mt * 128 + wr * 64 + m * 16 + fq * 4 + j;
              if (slot < ce) {
                const int tk = lists[e * T + slot]; const float wgt = tokw[tk];
#pragma unroll
                for (int n = 0; n < 4; ++n) yb[(size_t)tk * 1024 + ntile * 128 + wc * 64 + n * 16 + fr] = f2bf(wgt * acc[m][n][j]);
              }
            }
        });
      });
    } break;
    case 8: case 21: {
      float* vr = (float*)(ws + (layer ? VR1 : VR0)); const u16* yb = (const u16*)(ws + (layer ? YBUF1 : YBUF0)); u16* x2b = (u16*)(ws + (layer ? X2B1 : X2B0));
      const float* g = p.ln2_g + layer * 1024; const float* bb = p.ln2_b + layer * 1024;
      for (int tok = gw; tok < T; tok += nw) {
        float* row = vr + (size_t)tok * 1024;
        float4 v[4];
#pragma unroll
        for (int i = 0; i < 4; ++i) {
          const int c0 = i * 256 + lane * 4;
          const float4 xv = *reinterpret_cast<const float4*>(row + c0);
          const uint2 ya = *reinterpret_cast<const uint2*>(yb + (size_t)(tok * 2) * 1024 + c0), yc = *reinterpret_cast<const uint2*>(yb + (size_t)(tok * 2 + 1) * 1024 + c0);
          v[i].x = ALPHA * xv.x + (__uint_as_float(ya.x << 16) + __uint_as_float(yc.x << 16));
          v[i].y = ALPHA * xv.y + (__uint_as_float(ya.x & 0xffff0000u) + __uint_as_float(yc.x & 0xffff0000u));
          v[i].z = ALPHA * xv.z + (__uint_as_float(ya.y << 16) + __uint_as_float(yc.y << 16));
          v[i].w = ALPHA * xv.w + (__uint_as_float(ya.y & 0xffff0000u) + __uint_as_float(yc.y & 0xffff0000u));
        }
        float s = 0.f;
#pragma unroll
        for (int i = 0; i < 4; ++i) s += v[i].x + v[i].y + v[i].z + v[i].w;
        const float mu = wsum(s) * (1.f / 1024.f);
        float sq = 0.f;
#pragma unroll
        for (int i = 0; i < 4; ++i) { v[i].x -= mu; v[i].y -= mu; v[i].z -= mu; v[i].w -= mu; sq += v[i].x * v[i].x + v[i].y * v[i].y + v[i].z * v[i].z + v[i].w * v[i].w; }
        const float rstd = rsqrtf(wsum(sq) * (1.f / 1024.f) + LN_EPS);
#pragma unroll
        for (int i = 0; i < 4; ++i) {
          const int c0 = i * 256 + lane * 4;
          const float4 gg = *reinterpret_cast<const float4*>(g + c0), be = *reinterpret_cast<const float4*>(bb + c0);
          v[i].x = v[i].x * rstd * gg.x + be.x; v[i].y = v[i].y * rstd * gg.y + be.y; v[i].z = v[i].z * rstd * gg.z + be.z; v[i].w = v[i].w * rstd * gg.w + be.w;
          *reinterpret_cast<float4*>(row + c0) = v[i];
          *reinterpret_cast<uint2*>(x2b + (size_t)tok * 1024 + c0) = make_uint2(pack2(v[i].x, v[i].y), pack2(v[i].z, v[i].w));
        }
      }
    } break;
    case 9: case 22: {
      const u16* A = (const u16*)(ws + (layer ? X2B1 : X2B0)); const u16* W = (const u16*)(ws + (layer ? W1_PG : W0_PG));
      const float* x2 = (const float*)(ws + (layer ? VR1 : VR0)); const float* pp = (const float*)(ws + (layer ? PP1 : PP0));
      const float* bgate = p.ple_b + layer * 1024; u16* x3b = (u16*)(ws + X3B); float* outp = p.out;
      run_tiles(128 * 8, vb, nvb, [&](int tile, bool valid) {
        const int mt = tile >> 3, ntile = tile & 7;
        GemmLoad L; set_seg1(L, A + (size_t)mt * 128 * 1024, 1024, W + (size_t)ntile * 128 * 1024, 1024, valid ? 32 : 0, tid);
        gemm_tile(L, 32, hl, tid, [&](f32x4 (&acc)[4][4], int wr, int wc, int fr, int fq) {
          if (!valid) return;
#pragma unroll
          for (int n = 0; n < 4; ++n) {
            const int col = ntile * 128 + wc * 64 + n * 16 + fr; const float bv = bgate[col];
#pragma unroll
            for (int m = 0; m < 4; ++m)
#pragma unroll
              for (int j = 0; j < 4; ++j) {
                const size_t idx = (size_t)(mt * 128 + wr * 64 + m * 16 + fq * 4 + j) * 1024 + col;
                const float gt = 1.f / (1.f + __expf(-(acc[m][n][j] + bv)));
                const float r = x2[idx] + gt * pp[idx];
                outp[idx] = r;
                if (layer == 0) x3b[idx] = f2bf(r);
              }
          }
        });
      });
    } break;
    case 10: {
      float* tl = (float*)smem;
      tconv(p.ret_w_in, 0, 6144, 1024, 2048, 1, (u16*)(ws + WRIN), 0, 3, tl);
      tconv(p.ret_w_in + 2048, 0, 6144, 1024, 4096, 1, (u16*)(ws + WRIN) + (size_t)2048 * 1024, 0, 0, tl);
      tconv(p.ret_w_out, 0, 1024, 2048, 1024, 1, (u16*)(ws + WROUT), 0, 0, tl);
      econv(p.p + (size_t)T * 256, (u16*)(ws + PB), (size_t)T * 256);
      float2* cs = (float2*)(ws + CS);
      const size_t gt = (size_t)blockIdx.x * 512 + threadIdx.x, gn = (size_t)gridDim.x * 512;
      for (size_t i = gt; i < (size_t)T * 128; i += gn) {
        const int tok = (int)(i >> 7), f = (int)(i & 127);
        const float invf = powf(10000.f, -(float)(2 * f) / 256.f);
        const float ang = (float)p.pos[tok] * invf;
        const double rev = (double)ang * 0.15915494309189535;
        const float fr_ = (float)(rev - rint(rev));
        cs[i] = make_float2(__builtin_amdgcn_cosf(fr_), __builtin_amdgcn_sinf(fr_));
      }
    } break;
    case 11: {
      const u16* A = (const u16*)(ws + X3B); const u16* W = (const u16*)(ws + WRIN);
      u16* q1 = (u16*)(ws + Q1); u16* k1 = (u16*)(ws + K1); u16* ktd = (u16*)(ws + KTD); u16* vt = (u16*)(ws + VT);
      const float2* cs = (const float2*)(ws + CS);
      run_tiles(128 * 32, vb, nvb, [&](int tile, bool valid) {
        const int mt = tile >> 5, ntile = tile & 31;
        GemmLoad L; set_seg1(L, A + (size_t)mt * 128 * 1024, 1024, W + (size_t)ntile * 128 * 1024, 1024, valid ? 32 : 0, tid);
        gemm_tile(L, 32, hl, tid, [&](f32x4 (&acc)[4][4], int wr, int wc, int fr, int fq) {
          if (!valid) return;
          if (ntile < 16) {
            const int isk = ntile >> 3, hh = (ntile & 7) >> 1, th = ntile & 1;
            const float lg2 = gamma_log2(hh);
#pragma unroll
            for (int m = 0; m < 4; ++m)
#pragma unroll
              for (int j = 0; j < 4; ++j) {
                const int tok = mt * 128 + wr * 64 + m * 16 + fq * 4 + j;
                const float kdec = exp2f((float)(255 - (tok & 255)) * lg2) * 0.0625f;
#pragma unroll
                for (int n = 0; n < 2; ++n) {
                  const int i = th * 64 + wc * 32 + n * 16 + fr;
                  const float2 c = cs[(size_t)tok * 128 + i];
                  const float x1 = acc[m][n][j], x2 = acc[m][n + 2][j];
                  const float r1 = x1 * c.x - x2 * c.y, r2 = x2 * c.x + x1 * c.y;
                  if (!isk) { q1[(size_t)tok * 1024 + hh * 256 + i] = f2bf(r1); q1[(size_t)tok * 1024 + hh * 256 + 128 + i] = f2bf(r2); }
                  else {
                    k1[(size_t)tok * 1024 + hh * 256 + i] = f2bf(r1 * 0.0625f); k1[(size_t)tok * 1024 + hh * 256 + 128 + i] = f2bf(r2 * 0.0625f);
                    ktd[(size_t)(hh * 256 + i) * T + tok] = f2bf(r1 * kdec); ktd[(size_t)(hh * 256 + 128 + i) * T + tok] = f2bf(r2 * kdec);
                  }
                }
              }
          } else {
            const int c0 = (ntile - 16) * 128;
#pragma unroll
            for (int m = 0; m < 4; ++m)
#pragma unroll
              for (int n = 0; n < 4; ++n) {
                const int tok = mt * 128 + wr * 64 + m * 16 + fq * 4, col = c0 + wc * 64 + n * 16 + fr;
                *reinterpret_cast<uint2*>(vt + (size_t)col * T + tok) = make_uint2(pack2(acc[m][n][0], acc[m][n][1]), pack2(acc[m][n][2], acc[m][n][3]));
              }
          }
        });
      });
    } break;
    case 12: {
      const u16* q1 = (const u16*)(ws + Q1); const u16* k1 = (const u16*)(ws + K1); const u16* ktd = (const u16*)(ws + KTD); const u16* vt = (const u16*)(ws + VT);
      u16* kv = (u16*)(ws + KV); u16* sp = (u16*)(ws + SP);
      run_tiles(256 * 8, vb, nvb, [&](int tile, bool valid) {
        const int item = tile >> 3, mt = (tile >> 1) & 3, ntile = tile & 1; const int b = item >> 6, h = (item >> 4) & 3, c = item & 15;
        const size_t t0 = (size_t)b * SEQ + c * 256;
        GemmLoad L; set_seg1(L, vt + (size_t)(h * 512 + mt * 128) * T + t0, T, ktd + (size_t)(h * 256 + ntile * 128) * T + t0, T, valid ? 8 : 0, tid);
        gemm_tile(L, 8, hl, tid, [&](f32x4 (&acc)[4][4], int wr, int wc, int fr, int fq) {
          if (!valid) return;
#pragma unroll
          for (int m = 0; m < 4; ++m)
#pragma unroll
            for (int n = 0; n < 4; ++n)
#pragma unroll
              for (int j = 0; j < 4; ++j)
                kv[(size_t)item * 131072 + (size_t)(mt * 128 + wr * 64 + m * 16 + fq * 4 + j) * 256 + ntile * 128 + wc * 64 + n * 16 + fr] = f2bf(acc[m][n][j]);
        });
      });
      run_tiles(256 * 3, vb, nvb, [&](int tile, bool valid) {
        const int item = tile / 3, tt = tile % 3; const int mt = tt ? 1 : 0, ntile = tt == 2 ? 1 : 0; const int b = item >> 6, h = (item >> 4) & 3, c = item & 15;
        const size_t t0 = (size_t)b * SEQ + c * 256;
        GemmLoad L; set_seg1(L, q1 + (t0 + mt * 128) * 1024 + h * 256, 1024, k1 + (t0 + ntile * 128) * 1024 + h * 256, 1024, valid ? 8 : 0, tid);
        const float lg2 = gamma_log2(h);
        gemm_tile(L, 8, hl, tid, [&](f32x4 (&acc)[4][4], int wr, int wc, int fr, int fq) {
          if (!valid) return;
#pragma unroll
          for (int n = 0; n < 4; ++n) {
            const int jj = ntile * 128 + wc * 64 + n * 16 + fr; const float sc = exp2f(-(float)(jj + 1) * lg2);
#pragma unroll
            for (int m = 0; m < 4; ++m)
#pragma unroll
              for (int j = 0; j < 4; ++j) {
                const int ii = mt * 128 + wr * 64 + m * 16 + fq * 4 + j;
                sp[(size_t)item * 65536 + (size_t)ii * 256 + jj] = f2bf(jj <= ii ? acc[m][n][j] * sc : 0.f);
              }
          }
        });
      });
    } break;
    case 13: {
      u16* kv = (u16*)(ws + KV);
      const size_t gt = (size_t)blockIdx.x * 512 + threadIdx.x, gn = (size_t)gridDim.x * 512;
      for (size_t i = gt; i < (size_t)16 * 16384; i += gn) {
        const int bh = (int)(i >> 14); const size_t el = (i & 16383) * 8; const int h = bh & 3;
        const float cd = exp2f(256.f * gamma_log2(h));
        float s[8];
#pragma unroll
        for (int e = 0; e < 8; ++e) s[e] = 0.f;
        for (int c = 0; c < 16; ++c) {
          uint4* ptr = reinterpret_cast<uint4*>(kv + (size_t)(bh * 16 + c) * 131072 + el);
          const uint4 v = *ptr;
          *ptr = make_uint4(pack2(s[0], s[1]), pack2(s[2], s[3]), pack2(s[4], s[5]), pack2(s[6], s[7]));
          s[0] = s[0] * cd + __uint_as_float(v.x << 16); s[1] = s[1] * cd + __uint_as_float(v.x & 0xffff0000u);
          s[2] = s[2] * cd + __uint_as_float(v.y << 16); s[3] = s[3] * cd + __uint_as_float(v.y & 0xffff0000u);
          s[4] = s[4] * cd + __uint_as_float(v.z << 16); s[5] = s[5] * cd + __uint_as_float(v.z & 0xffff0000u);
          s[6] = s[6] * cd + __uint_as_float(v.w << 16); s[7] = s[7] * cd + __uint_as_float(v.w & 0xffff0000u);
        }
      }
    } break;
    case 14: {
      const u16* q1 = (const u16*)(ws + Q1); const u16* vt = (const u16*)(ws + VT); const u16* kv = (const u16*)(ws + KV); const u16* sp = (const u16*)(ws + SP);
      u16* o1 = (u16*)(ws + O1);
      run_tiles(256 * 8, vb, nvb, [&](int tile, bool valid) {
        const int item = tile >> 3, mt = (tile >> 2) & 1, ntile = tile & 3; const int b = item >> 6, h = (item >> 4) & 3, c = item & 15;
        const size_t t0 = (size_t)b * SEQ + c * 256;
        GemmLoad L; set_seg1(L, sp + (size_t)item * 65536 + (size_t)mt * 128 * 256, 256, vt + (size_t)(h * 512 + ntile * 128) * T + t0, T, valid ? 4 * (mt + 1) : 0, tid);
        { const int r = tid >> 2, kc = (tid & 3) * 8;
          const u16* A2 = q1 + (t0 + mt * 128) * 1024 + h * 256; const u16* B2 = kv + (size_t)item * 131072 + (size_t)ntile * 128 * 256;
          L.c0 = A2 + (size_t)r * 1024 + kc; L.c1 = A2 + (size_t)(r + 64) * 1024 + kc; L.d0 = B2 + (size_t)r * 256 + kc; L.d1 = B2 + (size_t)(r + 64) * 256 + kc; L.nt2 = valid ? 8 : 0; }
        const float lg2 = gamma_log2(h);
        gemm_tile(L, 16, hl, tid, [&](f32x4 (&acc)[4][4], int wr, int wc, int fr, int fq) {
          if (!valid) return;
#pragma unroll
          for (int m = 0; m < 4; ++m)
#pragma unroll
            for (int j = 0; j < 4; ++j) {
              const int ii = mt * 128 + wr * 64 + m * 16 + fq * 4 + j; const float sc = exp2f((float)(ii + 1) * lg2);
#pragma unroll
              for (int n = 0; n < 4; ++n) o1[(t0 + ii) * 2048 + h * 512 + ntile * 128 + wc * 64 + n * 16 + fr] = f2bf(acc[m][n][j] * sc);
            }
        });
      });
    } break;
    case 15: {
      const u16* o1 = (const u16*)(ws + O1); float2* st = (float2*)(ws + GNST);
      for (int it = gw; it < T * 4; it += nw) {
        const uint4 v = *reinterpret_cast<const uint4*>(o1 + (size_t)it * 512 + lane * 8);
        float f[8] = {__uint_as_float(v.x << 16), __uint_as_float(v.x & 0xffff0000u), __uint_as_float(v.y << 16), __uint_as_float(v.y & 0xffff0000u),
                      __uint_as_float(v.z << 16), __uint_as_float(v.z & 0xffff0000u), __uint_as_float(v.w << 16), __uint_as_float(v.w & 0xffff0000u)};
        float s = 0.f;
#pragma unroll
        for (int e = 0; e < 8; ++e) s += f[e];
        const float mu = wsum(s) * (1.f / 512.f);
        float sq = 0.f;
#pragma unroll
        for (int e = 0; e < 8; ++e) { const float d = f[e] - mu; sq += d * d; }
        const float rstd = rsqrtf(wsum(sq) * (1.f / 512.f) + LN_EPS);
        if (lane == 0) st[it] = make_float2(mu, rstd);
      }
      float* tl = (float*)smem;
      const size_t lo = (size_t)16 * 1024 * 512;
      tconv(p.w_gate + lo, 1024 * 512, 512, 1024, 512, 16, (u16*)(ws + W1_GU), 1024 * 1024, 1, tl);
      tconv(p.w_up + lo, 1024 * 512, 512, 1024, 512, 16, (u16*)(ws + W1_GU), 1024 * 1024, 2, tl);
      tconv(p.w_down + lo, 512 * 1024, 1024, 512, 1024, 16, (u16*)(ws + W1_D), 1024 * 512, 0, tl);
      tconv(p.ple_gate + (size_t)1024 * 1024, 0, 1024, 1024, 1024, 1, (u16*)(ws + W1_PG), 0, 0, tl);
      tconv(p.ple_proj + (size_t)256 * 1024, 0, 1024, 256, 1024, 1, (u16*)(ws + W1_PP), 0, 0, tl);
    } break;
    case 16: {
      const u16* A = (const u16*)(ws + X3B); const u16* W = (const u16*)(ws + WRIN) + (size_t)4096 * 1024;
      u16* o1 = (u16*)(ws + O1); const float2* st = (const float2*)(ws + GNST);
      run_tiles(128 * 16, vb, nvb, [&](int tile, bool valid) {
        const int mt = tile >> 4, ntile = tile & 15;
        GemmLoad L; set_seg1(L, A + (size_t)mt * 128 * 1024, 1024, W + (size_t)ntile * 128 * 1024, 1024, valid ? 32 : 0, tid);
        gemm_tile(L, 32, hl, tid, [&](f32x4 (&acc)[4][4], int wr, int wc, int fr, int fq) {
          if (!valid) return;
          const int hh = ntile >> 2;
#pragma unroll
          for (int m = 0; m < 4; ++m)
#pragma unroll
            for (int j = 0; j < 4; ++j) {
              const int tok = mt * 128 + wr * 64 + m * 16 + fq * 4 + j; const float2 ms = st[tok * 4 + hh];
#pragma unroll
              for (int n = 0; n < 4; ++n) {
                const size_t idx = (size_t)tok * 2048 + ntile * 128 + wc * 64 + n * 16 + fr;
                o1[idx] = f2bf(siluf(acc[m][n][j]) * ((bf2f(o1[idx]) - ms.x) * ms.y));
              }
            }
        });
      });
    } break;
    default: break;
    }
  }
}

#define PHASE(n) if (ph0 <= n && n < ph1) { run_phase<n>(p, smem); if (n + 1 < ph1) grid.sync(); }
__global__ void __launch_bounds__(512) mega(P p, int ph0, int ph1) {
  extern __shared__ __attribute__((aligned(16))) char smem[];
  cg::grid_group grid = cg::this_grid();
  PHASE(0) PHASE(1) PHASE(2) PHASE(3) PHASE(4) PHASE(5) PHASE(6) PHASE(7) PHASE(8) PHASE(9) PHASE(10) PHASE(11)
  PHASE(12) PHASE(13) PHASE(14) PHASE(15) PHASE(16) PHASE(17) PHASE(18) PHASE(19) PHASE(20) PHASE(21) PHASE(22)
}

extern "C" void kernel_launch(void* const* d_in, const int* in_sizes, int n_in, void* d_out, int out_size, void* d_ws, size_t ws_size, hipStream_t stream) {
  static int grid_blocks = 0;
  if (!grid_blocks) {
    int dev = 0, cus = 0, per_cu = 0;
    hipGetDevice(&dev);
    hipDeviceGetAttribute(&cus, hipDeviceAttributeMultiprocessorCount, dev);
    hipFuncSetAttribute((const void*)mega, hipFuncAttributeMaxDynamicSharedMemorySize, LDS_BYTES);
    hipOccupancyMaxActiveBlocksPerMultiprocessor(&per_cu, (const void*)mega, 512, LDS_BYTES);
    if (per_cu < 1) { fprintf(stderr, "occupancy query returned %d\n", per_cu); per_cu = 1; }
    grid_blocks = cus * 1;
    if (ws_size < 345 * MiB) fprintf(stderr, "workspace too small: %zu\n", ws_size);
  }
  P p{};
  p.x = (const float*)d_in[0]; p.p = (const float*)d_in[1]; p.pos = (const int*)d_in[2];
  p.fox_w_in = (const float*)d_in[3]; p.fox_b_f = (const float*)d_in[4]; p.fox_w_out = (const float*)d_in[5];
  p.ret_w_in = (const float*)d_in[6]; p.ret_w_out = (const float*)d_in[7];
  p.ln1_g = (const float*)d_in[8]; p.ln1_b = (const float*)d_in[9]; p.ln2_g = (const float*)d_in[10]; p.ln2_b = (const float*)d_in[11];
  p.w_group = (const float*)d_in[12]; p.b_group = (const float*)d_in[13]; p.w_router = (const float*)d_in[14]; p.b_router = (const float*)d_in[15];
  p.w_gate = (const float*)d_in[16]; p.w_up = (const float*)d_in[17]; p.w_down = (const float*)d_in[18];
  p.ple_proj = (const float*)d_in[19]; p.ple_gate = (const float*)d_in[20]; p.ple_b = (const float*)d_in[21];
  p.out = (float*)d_out; p.ws = (char*)d_ws;
#if MEGA
  int ph0 = 0, ph1 = NPH;
  void* args[] = {&p, &ph0, &ph1};
  hipError_t e = hipLaunchCooperativeKernel((const void*)mega, dim3(grid_blocks), dim3(512), args, LDS_BYTES, stream);
  if (e != hipSuccess) fprintf(stderr, "cooperative launch failed: %s (grid %d)\n", hipGetErrorString(e), grid_blocks);
#else
  for (int ph = 0; ph < NPH; ++ph) hipLaunchKernelGGL(mega, dim3(grid_blocks), dim3(512), LDS_BYTES, stream, p, ph, ph + 1);
#endif
}
```

```cpp
#include <hip/hip_runtime.h>
#include <hip/hip_cooperative_groups.h>
#include <cstdio>
#include <cstdint>
namespace cg = cooperative_groups;

#ifndef MEGA
#define MEGA 1
#endif

typedef unsigned short u16;
using bf16x8 = __attribute__((ext_vector_type(8))) short;
using f32x4 = __attribute__((ext_vector_type(4))) float;
#define DEVI __device__ __forceinline__

constexpr int T = 16384, SEQ = 4096;
constexpr size_t MiB = 1ull << 20;
constexpr float ALPHA = 1.4142135623730951f;
constexpr float LN_EPS = 1e-5f;
constexpr int NPH = 23;
constexpr int LDS_BYTES = 100352;

constexpr size_t W0_QKV = 0, W0_OUT = 7 * MiB, W0_GU = 9 * MiB, W0_D = 41 * MiB, W0_PG = 57 * MiB, W0_PP = 59 * MiB;
constexpr size_t QKV0 = 60 * MiB, X1B0 = 60 * MiB, YBUF0 = 60 * MiB, HBUF0 = 124 * MiB, X2B0 = 124 * MiB;
constexpr size_t VR0 = 156 * MiB, PP0 = 220 * MiB, XB0 = 284 * MiB, O0 = 284 * MiB, X3B = 284 * MiB;
constexpr size_t PB = 316 * MiB, CS = 324 * MiB, LOGF = 340 * MiB, C8 = 341 * MiB, LISTS = 342 * MiB, TOKW = 343 * MiB;
constexpr size_t GNST = 343 * MiB + 512 * 1024, CNT = 344 * MiB;
constexpr size_t WRIN = 0, WROUT = 12 * MiB, Q1 = 16 * MiB, K1 = 48 * MiB, KTD = 80 * MiB, VT = 112 * MiB, O1 = 48 * MiB;
constexpr size_t KV = 176 * MiB, SP = 240 * MiB, W1_GU = 176 * MiB, W1_D = 208 * MiB, W1_PG = 224 * MiB, W1_PP = 226 * MiB;
constexpr size_t VR1 = 112 * MiB, PP1 = 240 * MiB, X1B1 = 16 * MiB, HBUF1 = 80 * MiB, YBUF1 = 0, X2B1 = 80 * MiB;

struct P {
  const float *x, *p; const int* pos;
  const float *fox_w_in, *fox_b_f, *fox_w_out, *ret_w_in, *ret_w_out, *ln1_g, *ln1_b, *ln2_g, *ln2_b;
  const float *w_group, *b_group, *w_router, *b_router, *w_gate, *w_up, *w_down, *ple_proj, *ple_gate, *ple_b;
  float* out; char* ws;
};

DEVI float bf2f(u16 b) { return __uint_as_float(((unsigned)b) << 16); }
DEVI u16 f2bf(float f) { unsigned u = __float_as_uint(f); u += 0x7FFFu + ((u >> 16) & 1u); return (u16)(u >> 16); }
DEVI unsigned pack2(float a, float b) { return (unsigned)f2bf(a) | ((unsigned)f2bf(b) << 16); }
DEVI float wsum(float v) {
#pragma unroll
  for (int o = 32; o >= 1; o >>= 1) v += __shfl_xor(v, o);
  return v;
}
DEVI float siluf(float v) { return v / (1.f + __expf(-v)); }
DEVI float logsig(float z) { return fminf(z, 0.f) - log1pf(__expf(-fabsf(z))); }

struct GemmLoad {
  const u16 *a0, *a1, *b0, *b1;
  const u16 *c0, *c1, *d0, *d1;
  int nt1, nt2;
};
DEVI void glds16(const u16* g, char* l) {
  __builtin_amdgcn_global_load_lds((const __attribute__((address_space(1))) void*)g, (__attribute__((address_space(3))) void*)l, 16, 0, 0);
}
template <class Epi>
DEVI void gemm_tile(const GemmLoad& L, int nt_max, char* lds, int tid, Epi&& epi) {
  const int wid = tid >> 6, lane = tid & 63, wr = wid >> 1, wc = wid & 1, fr = lane & 15, fq = lane >> 4;
  f32x4 acc[4][4];
#pragma unroll
  for (int m = 0; m < 4; ++m)
#pragma unroll
    for (int n = 0; n < 4; ++n) acc[m][n] = f32x4{0.f, 0.f, 0.f, 0.f};
  const int nt = L.nt1 + L.nt2;
  auto stage = [&](int t, int buf) {
    char* sa = lds + buf * 16384 + tid * 16; char* sb = sa + 8192;
    const u16 *pa0, *pa1, *pb0, *pb1;
    if (t < L.nt1) { pa0 = L.a0 + t * 32; pa1 = L.a1 + t * 32; pb0 = L.b0 + t * 32; pb1 = L.b1 + t * 32; }
    else { const int t2 = t - L.nt1; pa0 = L.c0 + t2 * 32; pa1 = L.c1 + t2 * 32; pb0 = L.d0 + t2 * 32; pb1 = L.d1 + t2 * 32; }
    glds16(pa0, sa); glds16(pa1, sa + 4096); glds16(pb0, sb); glds16(pb1, sb + 4096);
  };
  if (nt > 0) stage(0, 0);
  for (int t = 0; t < nt_max; ++t) {
    asm volatile("s_waitcnt vmcnt(0)" ::: "memory");
    __syncthreads();
    if (t + 1 < nt) stage(t + 1, (t + 1) & 1);
    if (t < nt) {
      const char* sa = lds + (t & 1) * 16384; const char* sb = sa + 8192;
      bf16x8 af[4], bfv[4];
#pragma unroll
      for (int m = 0; m < 4; ++m) af[m] = *reinterpret_cast<const bf16x8*>(sa + (wr * 64 + m * 16 + fr) * 64 + fq * 16);
#pragma unroll
      for (int n = 0; n < 4; ++n) bfv[n] = *reinterpret_cast<const bf16x8*>(sb + (wc * 64 + n * 16 + fr) * 64 + fq * 16);
#pragma unroll
      for (int m = 0; m < 4; ++m)
#pragma unroll
        for (int n = 0; n < 4; ++n) acc[m][n] = __builtin_amdgcn_mfma_f32_16x16x32_bf16(af[m], bfv[n], acc[m][n], 0, 0, 0);
    }
  }
  __syncthreads();
  epi(acc, wr, wc, fr, fq);
}
template <class TF>
DEVI void run_tiles(int ntiles, int vb, int nvb, TF&& f) {
  const int niter = (ntiles + nvb - 1) / nvb;
  for (int it = 0; it < niter; ++it) { const int tile = it * nvb + vb; const bool valid = tile < ntiles; f(valid ? tile : 0, valid); }
}
DEVI void set_seg1(GemmLoad& L, const u16* A, size_t lda, const u16* B, size_t ldb, int nt, int tid) {
  const int r = tid >> 2, kc = (tid & 3) * 8;
  L.a0 = A + (size_t)r * lda + kc; L.a1 = A + (size_t)(r + 64) * lda + kc;
  L.b0 = B + (size_t)r * ldb + kc; L.b1 = B + (size_t)(r + 64) * ldb + kc;
  L.c0 = L.a0; L.c1 = L.a1; L.d0 = L.b0; L.d1 = L.b1; L.nt1 = nt; L.nt2 = 0;
}

DEVI int rowmap(int mode, int n) {
  if (mode == 0) return n;
  if (mode == 1 || mode == 2) { const int tile = n >> 6, w = n & 63, wc = w >> 5, rr = w & 31; return tile * 128 + wc * 64 + (mode == 2 ? 32 : 0) + rr; }
  const int hh = n >> 8, ip = n & 255, comp = ip >> 7, i = ip & 127, th = i >> 6, w = i & 63, wc = w >> 5, rr = w & 31;
  return hh * 256 + th * 128 + wc * 64 + comp * 32 + rr;
}
DEVI void tconv(const float* __restrict__ src, size_t sbs, int ldsrc, int K, int N, int nbatch, u16* __restrict__ dst, size_t dbs, int mode, float* tl) {
  const int tid = threadIdx.x; const int tk = K >> 6, tn = N >> 6; const int per = tk * tn, nt = per * nbatch;
  for (int tile = blockIdx.x; tile < nt; tile += gridDim.x) {
    const int b = tile / per, tt = tile % per; const int k0 = (tt / tn) << 6, n0 = (tt % tn) << 6;
    const float* s = src + (size_t)b * sbs; u16* d = dst + (size_t)b * dbs;
    { const int ty = tid >> 6, tx = tid & 63;
#pragma unroll
      for (int r = 0; r < 8; ++r) { const int k = ty * 8 + r; tl[k * 65 + tx] = s[(size_t)(k0 + k) * ldsrc + n0 + tx]; } }
    __syncthreads();
    { const int n = tid >> 3, kc = tid & 7;
      const unsigned w0 = pack2(tl[(kc * 8 + 0) * 65 + n], tl[(kc * 8 + 1) * 65 + n]);
      const unsigned w1 = pack2(tl[(kc * 8 + 2) * 65 + n], tl[(kc * 8 + 3) * 65 + n]);
      const unsigned w2 = pack2(tl[(kc * 8 + 4) * 65 + n], tl[(kc * 8 + 5) * 65 + n]);
      const unsigned w3 = pack2(tl[(kc * 8 + 6) * 65 + n], tl[(kc * 8 + 7) * 65 + n]);
      const int nr = rowmap(mode, n0 + n);
      *reinterpret_cast<uint4*>(d + (size_t)nr * K + k0 + kc * 8) = make_uint4(w0, w1, w2, w3); }
    __syncthreads();
  }
}
DEVI void econv(const float* __restrict__ src, u16* __restrict__ dst, size_t n) {
  const size_t gt = (size_t)blockIdx.x * 512 + threadIdx.x, gn = (size_t)gridDim.x * 512;
  for (size_t i = gt * 4; i < n; i += gn * 4) {
    const float4 v = *reinterpret_cast<const float4*>(src + i);
    *reinterpret_cast<uint2*>(dst + i) = make_uint2(pack2(v.x, v.y), pack2(v.z, v.w));
  }
}

DEVI float gamma_log2(int h) { return log2f(1.0f - exp2f(-5.0f - (float)h)); }

DEVI int moe_ntiles(const int* cnt, int ntn) { int s = 0; for (int i = 0; i < 16; ++i) s += ((cnt[i] + 127) >> 7) * ntn; return s; }
DEVI void moe_tile(const int* cnt, int tile, int ntn, int& e, int& mt, int& nt, int& base, int& ce) {
  int at = 0, b = 0; e = 0; mt = 0; nt = 0; base = 0; ce = 0;
  for (int i = 0; i < 16; ++i) {
    const int c = cnt[i]; const int tl = ((c + 127) >> 7) * ntn;
    if (tile >= at && tile < at + tl) { const int r = tile - at; e = i; mt = r / ntn; nt = r % ntn; base = b; ce = c; }
    at += tl; b += c;
  }
}


namespace fa {
using s16x4 = __attribute__((ext_vector_type(4))) short;
using f32x16 = __attribute__((ext_vector_type(16))) float;
using u32x4 = __attribute__((ext_vector_type(4))) unsigned;
constexpr int D = 64, DMQ = 3072, DMO = 1024, NW = 8, QBLK = 32, QB = 256, KVBLK = 64, NQB = SEQ / QB, THR = 8;
constexpr float C2 = 0.125f * 1.4426950408889634f;
constexpr int SLOTB = 8192, LDS_K = 0, LDS_V = 3 * SLOTB, LDS_WS = 6 * SLOTB, LDS_OST = LDS_WS + NW * 256, LDS_C8 = LDS_OST + NW * 4096, LDS_TOTAL = LDS_C8 + 16384;
#define SBAR() __builtin_amdgcn_sched_barrier(0)
#define PIN(x) asm volatile("" : "+v"(x))
#define MFMA(a, b, c) __builtin_amdgcn_mfma_f32_32x32x16_bf16(a, b, c, 0, 0, 0)
#define WAIT_BAR(N) asm volatile("s_waitcnt vmcnt(" #N ") lgkmcnt(0)\n\ts_barrier" ::: "memory")
DEVI int crow(int r, int hi) { return (r & 3) + 8 * (r >> 2) + 4 * hi; }
DEVI unsigned cvtpk(float lo, float hi) { unsigned r; asm("v_cvt_pk_bf16_f32 %0, %1, %2" : "=v"(r) : "v"(lo), "v"(hi)); return r; }
DEVI void glds16a(const void* g, unsigned lds_base) {
  unsigned sv; asm volatile("s_mov_b32 %0, m0\n\ts_mov_b32 m0, %2\n\ts_nop 0\n\tglobal_load_lds_dwordx4 %1, off\n\ts_mov_b32 m0, %0" : "=&s"(sv) : "v"(g), "s"(lds_base) : "memory"); }
typedef __attribute__((address_space(3))) const char* lds_cptr;
typedef short v4i16_t __attribute__((ext_vector_type(4)));
DEVI void kload2(bf16x8* kf, lds_cptr kp, int d0) { kf[2 * d0] = *(const __attribute__((address_space(3))) bf16x8*)(kp + d0 * 2048); kf[2 * d0 + 1] = *(const __attribute__((address_space(3))) bf16x8*)(kp + d0 * 2048 + 512); }
DEVI s16x4 vtr(lds_cptr p) { return __builtin_bit_cast(s16x4, __builtin_amdgcn_ds_read_tr16_b64_v4i16((__attribute__((address_space(3))) v4i16_t*)p)); }
#define MX3(a, b, c) __builtin_fmaxf(__builtin_fmaxf((a), (b)), (c))
DEVI float rowmax(const f32x16& p0, const f32x16& p1) {
  float a = MX3(p0[0], p0[1], p1[0]), b = MX3(p0[2], p0[3], p1[1]); a = MX3(a, p1[2], p1[3]);
#pragma unroll
  for (int r = 4; r < 16; r += 4) { a = MX3(a, p0[r], p0[r + 1]); b = MX3(b, p0[r + 2], p0[r + 3]); a = MX3(a, p1[r], p1[r + 1]); b = MX3(b, p1[r + 2], p1[r + 3]); }
  float m = __builtin_fmaxf(a, b); auto rr = __builtin_amdgcn_permlane32_swap(__float_as_uint(m), __float_as_uint(m), false, false);
  return __builtin_fmaxf(__uint_as_float(rr[0]), __uint_as_float(rr[1])); }
DEVI void cmask(f32x16& p0, f32x16& p1, int jb, int qrel, int hi) {
  const int kb = 64 * jb + 4 * hi;
#pragma unroll
  for (int r = 0; r < 16; ++r) { const int kv = kb + (r & 3) + 8 * (r >> 2); if (kv > qrel) p0[r] = -INFINITY; if (kv + 32 > qrel) p1[r] = -INFINITY; } }

DEVI void attn_unit(int b, int h, int qb, const u16* Q, const u16* __restrict__ K, const u16* __restrict__ V, u16* O, const float* __restrict__ c8g, char* lds) {
  int tid = threadIdx.x; asm volatile("" : "+v"(tid));
  const int lane = tid & 63, r32 = lane & 31, hi = lane >> 5; const int wid = __builtin_amdgcn_readfirstlane(tid >> 6);
  const long rowbase = (long)b * SEQ; const int q0 = qb * QB, NT = (q0 + QB) / KVBLK;
  const u16* Qw = Q + (rowbase + q0 + wid * QBLK) * DMQ + h * D;
  const unsigned lds0 = (unsigned)(uintptr_t)lds; float* wsf = (float*)(lds + LDS_WS) + wid * 64;
  { const int nv = (q0 + QB) >> 2; float4* dstc = (float4*)(lds + LDS_C8); const float4* srcc = (const float4*)c8g;
    for (int i = tid; i < nv; i += 512) dstc[i] = srcc[i]; }
  const float cq8 = c8g[q0 + wid * QBLK + r32];
  const lds_cptr c8p = (lds_cptr)lds + LDS_C8 + 16 * hi;
  const u16* ksrc = K + rowbase * DMQ + h * D + (long)lane * DMQ + wid * 8;
  const u16* vsrc = V + rowbase * DMQ + h * D + (long)(16 * (wid & 3) + (lane >> 2)) * DMQ + (wid >> 2) * 32 + (lane & 3) * 8;
  const unsigned kdst = lds0 + LDS_K + wid * 1024, vdst = lds0 + LDS_V + wid * 1024;
#define DMA_K(t, slot) glds16a(ksrc + (long)(t) * KVBLK * DMQ, (unsigned)__builtin_amdgcn_readfirstlane(kdst + (slot)))
#define DMA_V(t, slot) glds16a(vsrc + (long)(t) * KVBLK * DMQ, (unsigned)__builtin_amdgcn_readfirstlane(vdst + (slot)))
  const lds_cptr vp0 = (lds_cptr)lds + LDS_V + ((lane >> 4) & 1) * 32 + (lane & 3) * 8 + (4 * hi + ((lane & 15) >> 2)) * 64;
  const lds_cptr kp0 = (lds_cptr)lds + LDS_K + hi * 1024 + r32 * 16;
  DMA_K(0, 0); DMA_V(0, 0); DMA_K(1, SLOTB);
  bf16x8 qr[4];
#pragma unroll
  for (int d0 = 0; d0 < 4; ++d0) qr[d0] = *reinterpret_cast<const bf16x8*>(&Qw[(long)r32 * DMQ + d0 * 16 + hi * 8]);
  float mhat = 0.f, l_reg = 0.f; f32x16 o[2]; o[0] = f32x16{}; o[1] = f32x16{};
  const int qrel = wid * QBLK + r32; bool resc = false;
  f32x16 pA0, pA1, pB0, pB1; bf16x8 kf[8]; s16x4 vlo[8], vhi[8]; u32x4 pw0, pw1, pw2, pw3;
  int sl_prev = 0, sl_cur = 0, sl_next = SLOTB;
#define ROT() do { sl_prev = sl_cur; sl_cur = sl_next; sl_next = (sl_next == 2 * SLOTB) ? 0 : sl_next + SLOTB; } while (0)
#define EX(v) __builtin_amdgcn_exp2f(__builtin_fmaf((v), C2, nmh))
#define RESC() do { if (resc) { _Pragma("unroll") for (int d_ = 0; d_ < 2; ++d_) _Pragma("unroll") for (int r = 0; r < 16; ++r) o[d_][r] *= wsf[crow(r, hi)]; } } while (0)
#define BIAS(C0, C1, t) do { const lds_cptr cb_ = c8p + (t) * 256; \
    _Pragma("unroll") for (int g_ = 0; g_ < 4; ++g_) { \
      const f32x4 u_ = *(const __attribute__((address_space(3))) f32x4*)(cb_ + g_ * 32); \
      const f32x4 w_ = *(const __attribute__((address_space(3))) f32x4*)(cb_ + 128 + g_ * 32); \
      C0[4 * g_ + 0] = cq8 - u_[0]; C0[4 * g_ + 1] = cq8 - u_[1]; C0[4 * g_ + 2] = cq8 - u_[2]; C0[4 * g_ + 3] = cq8 - u_[3]; \
      C1[4 * g_ + 0] = cq8 - w_[0]; C1[4 * g_ + 1] = cq8 - w_[1]; C1[4 * g_ + 2] = cq8 - w_[2]; C1[4 * g_ + 3] = cq8 - w_[3]; } } while (0)
  DMA_K(2, 2 * SLOTB);
  WAIT_BAR(3);
  _Pragma("unroll") for (int d0 = 0; d0 < 4; ++d0) kload2(kf, kp0, d0);
  BIAS(pA0, pA1, 0);
  pA0 = MFMA(kf[0], qr[0], pA0); pA1 = MFMA(kf[1], qr[0], pA1); pA0 = MFMA(kf[2], qr[1], pA0); pA1 = MFMA(kf[3], qr[1], pA1);
  pA0 = MFMA(kf[4], qr[2], pA0); pA1 = MFMA(kf[5], qr[2], pA1); pA0 = MFMA(kf[6], qr[3], pA0); pA1 = MFMA(kf[7], qr[3], pA1);
  if (NT == 4) cmask(pA0, pA1, 0, qrel, hi);
  { const float rm = rowmax(pA0, pA1); mhat = rm * C2; const float nmh = -mhat;
#pragma unroll
    for (int r = 0; r < 16; ++r) { pA0[r] = EX(pA0[r]); pA1[r] = EX(pA1[r]); } }
  WAIT_BAR(0);
  DMA_K(3, 0); DMA_V(1, SLOTB); ROT();
  _Pragma("unroll") for (int d0 = 0; d0 < 4; ++d0) kload2(kf, kp0 + sl_cur, d0);
  WAIT_BAR(2);
#define PKW(P, i) cvtpk(P[i], P[i + 1])
#define PAF(k) __builtin_bit_cast(bf16x8, pw##k)
#define VFR(i) (bf16x8){vlo[i][0], vlo[i][1], vlo[i][2], vlo[i][3], vhi[i][0], vhi[i][1], vhi[i][2], vhi[i][3]}
#define VRD(i) do { vlo[i] = vtr(vp_ + (((i) >> 2) * 4096 + ((i) & 3) * 1024)); vhi[i] = vtr(vp_ + (((i) >> 2) * 4096 + ((i) & 3) * 1024 + 512)); } while (0)
#define KRD(G, d0) do { if (G) { kload2(kf, kp0 + sl_next, d0); SBAR(); } } while (0)
#define GAPA(MF, a0, a1, a2, a3, W0, W1, PW) do { MF; sacc += a0; sacc += a1; sacc += a2; sacc += a3; W0; W1; PIN(PW); PIN(sacc); SBAR(); } while (0)
#define GAPB(MF, X, i) do { MF; X[i] = EX(X[i]); X[i + 1] = EX(X[i + 1]); X[i + 2] = EX(X[i + 2]); X[i + 3] = EX(X[i + 3]); PIN(X); SBAR(); } while (0)
#define STEP(C0, C1, P0, P1, t, MASK, GK, GV, GL) do { BIAS(C0, C1, t); SBAR(); \
    const lds_cptr vp_ = vp0 + sl_prev; \
    VRD(0); SBAR(); float sacc = P0[0] + P0[1]; \
                    GAPA(C0 = MFMA(kf[0], qr[0], C0), P0[2], P0[3], P0[4], P0[5],     pw0[0] = PKW(P0, 0),  pw0[1] = PKW(P0, 2),  pw0); \
    VRD(4); SBAR(); GAPA(C1 = MFMA(kf[1], qr[0], C1), P0[6], P0[7], P0[8], P0[9],     pw0[2] = PKW(P0, 4),  pw0[3] = PKW(P0, 6),  pw0); \
    VRD(1); SBAR(); GAPA(C0 = MFMA(kf[2], qr[1], C0),    P0[10], P0[11], P0[12], P0[13], pw1[0] = PKW(P0, 8),  pw1[1] = PKW(P0, 10), pw1); \
    VRD(5); SBAR(); GAPA(C1 = MFMA(kf[3], qr[1], C1),    P0[14], P0[15], P1[0], P1[1],   pw1[2] = PKW(P0, 12), pw1[3] = PKW(P0, 14), pw1); \
    VRD(2); SBAR(); GAPA(C0 = MFMA(kf[4], qr[2], C0),    P1[2], P1[3], P1[4], P1[5],     pw2[0] = PKW(P1, 0),  pw2[1] = PKW(P1, 2),  pw2); \
    VRD(6); SBAR(); GAPA(C1 = MFMA(kf[5], qr[2], C1),    P1[6], P1[7], P1[8], P1[9],     pw2[2] = PKW(P1, 4),  pw2[3] = PKW(P1, 6),  pw2); \
    VRD(3); SBAR(); GAPA(C0 = MFMA(kf[6], qr[3], C0),    P1[10], P1[11], P1[12], P1[13], pw3[0] = PKW(P1, 8),  pw3[1] = PKW(P1, 10), pw3); \
    VRD(7); SBAR(); GAPA(C1 = MFMA(kf[7], qr[3], C1),    P1[14], P1[15], 0.f, 0.f,       pw3[2] = PKW(P1, 12), pw3[3] = PKW(P1, 14), pw3); \
    l_reg += sacc; \
    if (GK) DMA_K((t) + 3, sl_cur); if (GV) DMA_V((t) + 1, sl_next); \
    if (MASK) cmask(C0, C1, (t) - (NT - 4), qrel, hi); \
    { const float rm = __builtin_fmaf(rowmax(C0, C1), C2, -mhat); resc = false; \
      if (__builtin_expect(__any(rm > (float)THR), 0)) { const float dl = __builtin_fmaxf(rm, 0.f); mhat += dl; \
          const float f = __builtin_amdgcn_exp2f(-dl); l_reg *= f; if (hi == 0) wsf[r32] = f; resc = true; } } \
    const float nmh = -mhat; SBAR(); \
    GAPB(o[0] = MFMA(PAF(0), VFR(0), o[0]), C0, 0);              GAPB(o[1] = MFMA(PAF(0), VFR(4), o[1]), C0, 4); \
    KRD(GL, 0); GAPB(o[0] = MFMA(PAF(1), VFR(1), o[0]), C0, 8);  KRD(GL, 1); GAPB(o[1] = MFMA(PAF(1), VFR(5), o[1]), C0, 12); \
    KRD(GL, 2); GAPB(o[0] = MFMA(PAF(2), VFR(2), o[0]), C1, 0);  KRD(GL, 3); GAPB(o[1] = MFMA(PAF(2), VFR(6), o[1]), C1, 4); \
    GAPB(o[0] = MFMA(PAF(3), VFR(3), o[0]), C1, 8);              GAPB(o[1] = MFMA(PAF(3), VFR(7), o[1]), C1, 12); \
    } while (0)
  int t = 1;
  for (; t + 5 < NT; t += 2) {
    STEP(pB0, pB1, pA0, pA1, t, false, true, true, true);     WAIT_BAR(2); RESC(); ROT();
    STEP(pA0, pA1, pB0, pB1, t + 1, false, true, true, true); WAIT_BAR(2); RESC(); ROT();
  }
#define ENDW(tt) do { if ((tt) + 3 < NT) { WAIT_BAR(2); } else if ((tt) + 2 < NT) { WAIT_BAR(1); } else { WAIT_BAR(0); } } while (0)
  for (; t + 1 < NT; t += 2) {
    STEP(pB0, pB1, pA0, pA1, t, true, (t + 3 < NT), (t + 1 < NT), (t + 1 < NT));         ENDW(t);     RESC(); ROT();
    STEP(pA0, pA1, pB0, pB1, t + 1, true, (t + 4 < NT), (t + 2 < NT), (t + 2 < NT));     ENDW(t + 1); RESC(); ROT();
  }
  STEP(pB0, pB1, pA0, pA1, NT - 1, true, false, false, false); RESC();
  { float sacc = pB0[0] + pB0[1];
#pragma unroll
    for (int r = 2; r < 16; ++r) sacc += pB0[r];
#pragma unroll
    for (int r = 0; r < 16; ++r) sacc += pB1[r];
    l_reg += sacc;
    pw0 = (u32x4){PKW(pB0, 0), PKW(pB0, 2), PKW(pB0, 4), PKW(pB0, 6)}; pw1 = (u32x4){PKW(pB0, 8), PKW(pB0, 10), PKW(pB0, 12), PKW(pB0, 14)};
    pw2 = (u32x4){PKW(pB1, 0), PKW(pB1, 2), PKW(pB1, 4), PKW(pB1, 6)}; pw3 = (u32x4){PKW(pB1, 8), PKW(pB1, 10), PKW(pB1, 12), PKW(pB1, 14)};
    const lds_cptr vp_ = vp0 + sl_cur; _Pragma("unroll") for (int i = 0; i < 8; ++i) VRD(i);
    o[0] = MFMA(PAF(0), VFR(0), o[0]); o[1] = MFMA(PAF(0), VFR(4), o[1]); o[0] = MFMA(PAF(1), VFR(1), o[0]); o[1] = MFMA(PAF(1), VFR(5), o[1]);
    o[0] = MFMA(PAF(2), VFR(2), o[0]); o[1] = MFMA(PAF(2), VFR(6), o[1]); o[0] = MFMA(PAF(3), VFR(3), o[0]); o[1] = MFMA(PAF(3), VFR(7), o[1]); }
  { auto rr = __builtin_amdgcn_permlane32_swap(__float_as_uint(l_reg), __float_as_uint(l_reg), false, false); l_reg = __uint_as_float(rr[0]) + __uint_as_float(rr[1]); }
  if (hi == 0) wsf[32 + r32] = l_reg; asm volatile("s_waitcnt lgkmcnt(0)" ::: "memory");
  float rli[16];
#pragma unroll
  for (int r = 0; r < 16; ++r) rli[r] = __builtin_amdgcn_rcpf(wsf[32 + crow(r, hi)]);
  u16* Ow = O + (rowbase + q0 + wid * QBLK) * DMO + h * D; u16* stg = (u16*)(lds + LDS_OST) + wid * 2048;
#pragma unroll
  for (int r = 0; r < 16; ++r) { const int orow = crow(r, hi);
#pragma unroll
    for (int d0 = 0; d0 < 2; ++d0) stg[orow * 64 + d0 * 32 + r32] = f2bf(o[d0][r] * rli[r]); }
  asm volatile("s_waitcnt lgkmcnt(0)" ::: "memory");
#pragma unroll
  for (int i = 0; i < 4; ++i) { const int row = i * 8 + (lane >> 3), ch = lane & 7; *(u32x4*)(Ow + (long)row * DMO + ch * 8) = *(const u32x4*)(stg + row * 64 + ch * 8); }
  asm volatile("s_waitcnt lgkmcnt(0)\n\ts_barrier" ::: "memory");
#undef DMA_K
#undef DMA_V
#undef ROT
#undef EX
#undef RESC
#undef BIAS
#undef PKW
#undef PAF
#undef VFR
#undef VRD
#undef KRD
#undef ENDW
#undef GAPA
#undef GAPB
#undef STEP
}
}

template <int ph>
DEVI void run_phase(const P& p, char* smem) {
  const int half = threadIdx.x >> 8, tid = threadIdx.x & 255;
  const int vb = blockIdx.x * 2 + half, nvb = gridDim.x * 2;
  char* hl = smem + half * 32768;
  const int lane = threadIdx.x & 63;
  const int gw = blockIdx.x * 8 + (threadIdx.x >> 6), nw = gridDim.x * 8;
  char* ws = p.ws;
  (void)hl; (void)lane; (void)gw; (void)nw; (void)vb; (void)nvb; (void)tid;
  {
    constexpr int layer = (ph >= 10) ? 1 : 0;
    switch (ph) {
    case 0: {
      float* tl = (float*)smem;
      if (blockIdx.x == 0 && threadIdx.x < 32) ((int*)(ws + CNT))[threadIdx.x] = 0;
      econv(p.x, (u16*)(ws + XB0), (size_t)T * 1024);
      econv(p.p, (u16*)(ws + PB), (size_t)T * 256);
      tconv(p.fox_w_in, 0, 3088, 1024, 3072, 1, (u16*)(ws + W0_QKV), 0, 0, tl);
      {
        const int gt = blockIdx.x * 512 + threadIdx.x;
        if (gt < 16384) { const int n = gt >> 10, k = gt & 1023; ((u16*)(ws + W0_QKV))[(size_t)(3072 + n) * 1024 + k] = f2bf(p.fox_w_in[(size_t)k * 3088 + 3072 + n]); }
      }
      tconv(p.fox_w_out, 0, 1024, 1024, 1024, 1, (u16*)(ws + W0_OUT), 0, 0, tl);
      tconv(p.w_gate, 1024 * 512, 512, 1024, 512, 16, (u16*)(ws + W0_GU), 1024 * 1024, 1, tl);
      tconv(p.w_up, 1024 * 512, 512, 1024, 512, 16, (u16*)(ws + W0_GU), 1024 * 1024, 2, tl);
      tconv(p.w_down, 512 * 1024, 1024, 512, 1024, 16, (u16*)(ws + W0_D), 1024 * 512, 0, tl);
      tconv(p.ple_gate, 0, 1024, 1024, 1024, 1, (u16*)(ws + W0_PG), 0, 0, tl);
      tconv(p.ple_proj, 0, 1024, 256, 1024, 1, (u16*)(ws + W0_PP), 0, 0, tl);
    } break;
    case 1: {
      const u16* xb = (const u16*)(ws + XB0); const u16* w = (const u16*)(ws + W0_QKV);
      u16* qkv = (u16*)(ws + QKV0); float* logf_ = (float*)(ws + LOGF);
      run_tiles(128 * 25, vb, nvb, [&](int tile, bool valid) {
        const int mt = tile / 25, ntile = tile % 25;
        GemmLoad L; set_seg1(L, xb + (size_t)mt * 128 * 1024, 1024, w + (size_t)ntile * 128 * 1024, 1024, valid ? 32 : 0, tid);
        gemm_tile(L, 32, hl, tid, [&](f32x4 (&acc)[4][4], int wr, int wc, int fr, int fq) {
          if (!valid) return;
          if (ntile < 24) {
#pragma unroll
            for (int m = 0; m < 4; ++m)
#pragma unroll
              for (int n = 0; n < 4; ++n)
#pragma unroll
                for (int j = 0; j < 4; ++j) {
                  const int row = mt * 128 + wr * 64 + m * 16 + fq * 4 + j, col = ntile * 128 + wc * 64 + n * 16 + fr;
                  qkv[(size_t)row * 3072 + col] = f2bf(acc[m][n][j]);
                }
          } else if (wc == 0) {
            const float bf_ = p.fox_b_f[fr];
#pragma unroll
            for (int m = 0; m < 4; ++m)
#pragma unroll
              for (int j = 0; j < 4; ++j) {
                const int row = mt * 128 + wr * 64 + m * 16 + fq * 4 + j;
                logf_[row * 16 + fr] = logsig(acc[m][0][j] + bf_);
              }
          }
        });
      });
    } break;
    case 2: {
      const float* logf_ = (const float*)(ws + LOGF); float* c8 = (float*)(ws + C8);
      for (int bh = gw; bh < 64; bh += nw) {
        const int b = bh >> 4, h = bh & 15;
        const float* src = logf_ + (size_t)(b * SEQ + lane * 64) * 16 + h;
        float s = 0.f;
        for (int i = 0; i < 64; ++i) s += src[i * 16];
        float incl = s;
#pragma unroll
        for (int o = 1; o < 64; o <<= 1) { const float t2 = __shfl_up(incl, o); if (lane >= o) incl += t2; }
        float run = incl - s;
        float* dst = c8 + (size_t)bh * SEQ + lane * 64;
        for (int i = 0; i < 64; ++i) { run += src[i * 16]; dst[i] = 8.f * run; }
      }
    } break;
    case 3: {
      const u16* qkv = (const u16*)(ws + QKV0); const float* c8 = (const float*)(ws + C8); u16* O = (u16*)(ws + O0);
      for (int item = blockIdx.x; item < 512; item += gridDim.x) {
        const int x = item & 7, kk = item >> 3, bh = x + 8 * (kk >> 3), j = kk & 7;
        fa::attn_unit(bh >> 4, bh & 15, j, qkv, qkv + 1024, qkv + 2048, O, c8 + (size_t)bh * SEQ, smem);
        fa::attn_unit(bh >> 4, bh & 15, fa::NQB - 1 - j, qkv, qkv + 1024, qkv + 2048, O, c8 + (size_t)bh * SEQ, smem);
      }
    } break;
    case 4: case 17: {
      const u16* A = (const u16*)(ws + (layer ? O1 : O0)); const u16* W = (const u16*)(ws + (layer ? WROUT : W0_OUT));
      const int K = layer ? 2048 : 1024;
      const float* xres = layer ? p.out : p.x; float* vr = (float*)(ws + (layer ? VR1 : VR0));
      run_tiles(128 * 8, vb, nvb, [&](int tile, bool valid) {
        const int mt = tile >> 3, ntile = tile & 7;
        GemmLoad L; set_seg1(L, A + (size_t)mt * 128 * K, K, W + (size_t)ntile * 128 * K, K, valid ? K / 32 : 0, tid);
        gemm_tile(L, K / 32, hl, tid, [&](f32x4 (&acc)[4][4], int wr, int wc, int fr, int fq) {
          if (!valid) return;
#pragma unroll
          for (int m = 0; m < 4; ++m)
#pragma unroll
            for (int n = 0; n < 4; ++n)
#pragma unroll
              for (int j = 0; j < 4; ++j) {
                const size_t idx = (size_t)(mt * 128 + wr * 64 + m * 16 + fq * 4 + j) * 1024 + ntile * 128 + wc * 64 + n * 16 + fr;
                vr[idx] = ALPHA * xres[idx] + acc[m][n][j];
              }
        });
      });
      const u16* pb = (const u16*)(ws + PB); const u16* wpp = (const u16*)(ws + (layer ? W1_PP : W0_PP)); float* pp = (float*)(ws + (layer ? PP1 : PP0));
      run_tiles(128 * 8, vb, nvb, [&](int tile, bool valid) {
        const int mt = tile >> 3, ntile = tile & 7;
        GemmLoad L; set_seg1(L, pb + (size_t)mt * 128 * 256, 256, wpp + (size_t)ntile * 128 * 256, 256, valid ? 8 : 0, tid);
        gemm_tile(L, 8, hl, tid, [&](f32x4 (&acc)[4][4], int wr, int wc, int fr, int fq) {
          if (!valid) return;
#pragma unroll
          for (int m = 0; m < 4; ++m)
#pragma unroll
            for (int n = 0; n < 4; ++n)
#pragma unroll
              for (int j = 0; j < 4; ++j) {
                const size_t idx = (size_t)(mt * 128 + wr * 64 + m * 16 + fq * 4 + j) * 1024 + ntile * 128 + wc * 64 + n * 16 + fr;
                pp[idx] = acc[m][n][j];
              }
        });
      });
    } break;
    case 5: case 18: {
      float* vr = (float*)(ws + (layer ? VR1 : VR0)); u16* x1b = (u16*)(ws + (layer ? X1B1 : X1B0));
      const float* g = p.ln1_g + layer * 1024; const float* bb = p.ln1_b + layer * 1024;
      const float* wg = p.w_group + (size_t)layer * 1024 * 4; const float* wrt = p.w_router + (size_t)layer * 1024 * 16;
      const float* bg = p.b_group + layer * 4; const float* br = p.b_router + layer * 16;
      int* cnt = (int*)(ws + CNT) + layer * 16; int* lists = (int*)(ws + LISTS); float* tokw = (float*)(ws + TOKW);
      for (int tok = gw; tok < T; tok += nw) {
        float* row = vr + (size_t)tok * 1024;
        float4 v[4];
#pragma unroll
        for (int i = 0; i < 4; ++i) v[i] = *reinterpret_cast<const float4*>(row + i * 256 + lane * 4);
        float s = 0.f;
#pragma unroll
        for (int i = 0; i < 4; ++i) s += v[i].x + v[i].y + v[i].z + v[i].w;
        const float mu = wsum(s) * (1.f / 1024.f);
        float sq = 0.f;
#pragma unroll
        for (int i = 0; i < 4; ++i) { v[i].x -= mu; v[i].y -= mu; v[i].z -= mu; v[i].w -= mu; sq += v[i].x * v[i].x + v[i].y * v[i].y + v[i].z * v[i].z + v[i].w * v[i].w; }
        const float rstd = rsqrtf(wsum(sq) * (1.f / 1024.f) + LN_EPS);
        float lg[20];
#pragma unroll
        for (int o = 0; o < 20; ++o) lg[o] = 0.f;
#pragma unroll
        for (int i = 0; i < 4; ++i) {
          const int c0 = i * 256 + lane * 4;
          const float4 gg = *reinterpret_cast<const float4*>(g + c0), be = *reinterpret_cast<const float4*>(bb + c0);
          v[i].x = v[i].x * rstd * gg.x + be.x; v[i].y = v[i].y * rstd * gg.y + be.y; v[i].z = v[i].z * rstd * gg.z + be.z; v[i].w = v[i].w * rstd * gg.w + be.w;
          *reinterpret_cast<float4*>(row + c0) = v[i];
          *reinterpret_cast<uint2*>(x1b + (size_t)tok * 1024 + c0) = make_uint2(pack2(v[i].x, v[i].y), pack2(v[i].z, v[i].w));
          const float xe[4] = {v[i].x, v[i].y, v[i].z, v[i].w};
#pragma unroll
          for (int e = 0; e < 4; ++e) {
            const float4 w4 = *reinterpret_cast<const float4*>(wg + (size_t)(c0 + e) * 4);
            lg[0] += xe[e] * w4.x; lg[1] += xe[e] * w4.y; lg[2] += xe[e] * w4.z; lg[3] += xe[e] * w4.w;
#pragma unroll
            for (int q4 = 0; q4 < 4; ++q4) {
              const float4 r4 = *reinterpret_cast<const float4*>(wrt + (size_t)(c0 + e) * 16 + q4 * 4);
              lg[4 + q4 * 4 + 0] += xe[e] * r4.x; lg[4 + q4 * 4 + 1] += xe[e] * r4.y; lg[4 + q4 * 4 + 2] += xe[e] * r4.z; lg[4 + q4 * 4 + 3] += xe[e] * r4.w;
            }
          }
        }
#pragma unroll
        for (int o = 0; o < 20; ++o) lg[o] = wsum(lg[o]);
        if (lane == 0) {
          float gl[4];
#pragma unroll
          for (int i = 0; i < 4; ++i) gl[i] = lg[i] + bg[i];
          int gi = 0; float gm = gl[0];
#pragma unroll
          for (int i = 1; i < 4; ++i) if (gl[i] > gm) { gm = gl[i]; gi = i; }
          float gs = 0.f;
#pragma unroll
          for (int i = 0; i < 4; ++i) gs += __expf(gl[i] - gm);
          const float gval = 1.f / gs;
          float el[4];
#pragma unroll
          for (int i = 0; i < 4; ++i) {
            float t0 = lg[4 + i] + br[i], t1 = lg[8 + i] + br[4 + i], t2 = lg[12 + i] + br[8 + i], t3 = lg[16 + i] + br[12 + i];
            el[i] = gi == 0 ? t0 : (gi == 1 ? t1 : (gi == 2 ? t2 : t3));
          }
          int i0 = 0; float m0 = el[0];
#pragma unroll
          for (int i = 1; i < 4; ++i) if (el[i] > m0) { m0 = el[i]; i0 = i; }
          int i1 = -1; float m1 = -INFINITY;
#pragma unroll
          for (int i = 0; i < 4; ++i) if (i != i0 && el[i] > m1) { m1 = el[i]; i1 = i; }
          const float e1 = __expf(m1 - m0); const float w0 = gval / (1.f + e1), w1 = gval * e1 / (1.f + e1);
          const int ex0 = gi * 4 + i0, ex1 = gi * 4 + i1;
          const int s0 = atomicAdd(&cnt[ex0], 1); lists[ex0 * T + s0] = tok * 2;
          const int s1 = atomicAdd(&cnt[ex1], 1); lists[ex1 * T + s1] = tok * 2 + 1;
          tokw[tok * 2] = w0; tokw[tok * 2 + 1] = w1;
        }
      }
    } break;
    case 6: case 19: {
      const u16* x1b = (const u16*)(ws + (layer ? X1B1 : X1B0)); const u16* wgu = (const u16*)(ws + (layer ? W1_GU : W0_GU));
      u16* hb = (u16*)(ws + (layer ? HBUF1 : HBUF0));
      const int* cnt = (const int*)(ws + CNT) + layer * 16; const int* lists = (const int*)(ws + LISTS);
      const int ntiles = moe_ntiles(cnt, 8);
      run_tiles(ntiles, vb, nvb, [&](int tile, bool valid) {
        int e, mt, ntile, base, ce; moe_tile(cnt, tile, 8, e, mt, ntile, base, ce);
        if (ce == 0) valid = false;
        GemmLoad L; const int r = tid >> 2, kc = (tid & 3) * 8;
        int s0 = mt * 128 + r, s1 = s0 + 64; if (s0 >= ce) s0 = ce > 0 ? ce - 1 : 0; if (s1 >= ce) s1 = ce > 0 ? ce - 1 : 0;
        const int t0 = valid ? (lists[e * T + s0] >> 1) : 0, t1 = valid ? (lists[e * T + s1] >> 1) : 0;
        L.a0 = x1b + (size_t)t0 * 1024 + kc; L.a1 = x1b + (size_t)t1 * 1024 + kc;
        const u16* B = wgu + (size_t)e * 1024 * 1024 + (size_t)ntile * 128 * 1024;
        L.b0 = B + (size_t)r * 1024 + kc; L.b1 = B + (size_t)(r + 64) * 1024 + kc;
        L.c0 = L.a0; L.c1 = L.a1; L.d0 = L.b0; L.d1 = L.b1; L.nt1 = valid ? 32 : 0; L.nt2 = 0;
        gemm_tile(L, 32, hl, tid, [&](f32x4 (&acc)[4][4], int wr, int wc, int fr, int fq) {
          if (!valid) return;
#pragma unroll
          for (int m = 0; m < 4; ++m)
#pragma unroll
            for (int j = 0; j < 4; ++j) {
              const int slot = mt * 128 + wr * 64 + m * 16 + fq * 4 + j;
              if (slot < ce) {
#pragma unroll
                for (int n = 0; n < 2; ++n) {
                  const float hv = siluf(acc[m][n][j]) * acc[m][n + 2][j];
                  hb[(size_t)(base + slot) * 512 + ntile * 64 + wc * 32 + n * 16 + fr] = f2bf(hv);
                }
              }
            }
        });
      });
    } break;
    case 7: case 20: {
      const u16* hb = (const u16*)(ws + (layer ? HBUF1 : HBUF0)); const u16* wd = (const u16*)(ws + (layer ? W1_D : W0_D));
      u16* yb = (u16*)(ws + (layer ? YBUF1 : YBUF0));
      const int* cnt = (const int*)(ws + CNT) + layer * 16; const int* lists = (const int*)(ws + LISTS); const float* tokw = (const float*)(ws + TOKW);
      const int ntiles = moe_ntiles(cnt, 8);
      run_tiles(ntiles, vb, nvb, [&](int tile, bool valid) {
        int e, mt, ntile, base, ce; moe_tile(cnt, tile, 8, e, mt, ntile, base, ce);
        if (ce == 0) valid = false;
        GemmLoad L; const int r = tid >> 2, kc = (tid & 3) * 8;
        int s0 = mt * 128 + r, s1 = s0 + 64; if (s0 >= ce) s0 = ce > 0 ? ce - 1 : 0; if (s1 >= ce) s1 = ce > 0 ? ce - 1 : 0;
        L.a0 = hb + (size_t)(base + s0) * 512 + kc; L.a1 = hb + (size_t)(base + s1) * 512 + kc;
        const u16* B = wd + (size_t)e * 1024 * 512 + (size_t)ntile * 128 * 512;
        L.b0 = B + (size_t)r * 512 + kc; L.b1 = B + (size_t)(r + 64) * 512 + kc;
        L.c0 = L.a0; L.c1 = L.a1; L.d0 = L.b0; L.d1 = L.b1; L.nt1 = valid ? 16 : 0; L.nt2 = 0;
        gemm_tile(L, 16, hl, tid, [&](f32x4 (&acc)[4][4], int wr, int wc, int fr, int fq) {
          if (!valid) return;
#pragma unroll
          for (int m = 0; m < 4; ++m)
#pragma unroll
            for (int j = 0; j < 4; ++j) {
              const int slot = mt * 128 + wr * 64 + m * 16 + fq * 4 + j;
              if (slot < ce) {
                const int tk = lists[e * T + slot]; const float wgt = tokw[tk];
#pragma unroll
                for (int n = 0; n < 4; ++n) yb[(size_t)tk * 1024 + ntile * 128 + wc * 64 + n * 16 + fr] = f2bf(wgt * acc[m][n][j]);
              }
            }
        });
      });
    } break;
    case 8: case 21: {
      float* vr = (float*)(ws + (layer ? VR1 : VR0)); const u16* yb = (const u16*)(ws + (layer ? YBUF1 : YBUF0)); u16* x2b = (u16*)(ws + (layer ? X2B1 : X2B0));
      const float* g = p.ln2_g + layer * 1024; const float* bb = p.ln2_b + layer * 1024;
      for (int tok = gw; tok < T; tok += nw) {
        float* row = vr + (size_t)tok * 1024;
        float4 v[4];
#pragma unroll
        for (int i = 0; i < 4; ++i) {
          const int c0 = i * 256 + lane * 4;
          const float4 xv = *reinterpret_cast<const float4*>(row + c0);
          const uint2 ya = *reinterpret_cast<const uint2*>(yb + (size_t)(tok * 2) * 1024 + c0), yc = *reinterpret_cast<const uint2*>(yb + (size_t)(tok * 2 + 1) * 1024 + c0);
          v[i].x = ALPHA * xv.x + (__uint_as_float(ya.x << 16) + __uint_as_float(yc.x << 16));
          v[i].y = ALPHA * xv.y + (__uint_as_float(ya.x & 0xffff0000u) + __uint_as_float(yc.x & 0xffff0000u));
          v[i].z = ALPHA * xv.z + (__uint_as_float(ya.y << 16) + __uint_as_float(yc.y << 16));
          v[i].w = ALPHA * xv.w + (__uint_as_float(ya.y & 0xffff0000u) + __uint_as_float(yc.y & 0xffff0000u));
        }
        float s = 0.f;
#pragma unroll
        for (int i = 0; i < 4; ++i) s += v[i].x + v[i].y + v[i].z + v[i].w;
        const float mu = wsum(s) * (1.f / 1024.f);
        float sq = 0.f;
#pragma unroll
        for (int i = 0; i < 4; ++i) { v[i].x -= mu; v[i].y -= mu; v[i].z -= mu; v[i].w -= mu; sq += v[i].x * v[i].x + v[i].y * v[i].y + v[i].z * v[i].z + v[i].w * v[i].w; }
        const float rstd = rsqrtf(wsum(sq) * (1.f / 1024.f) + LN_EPS);
#pragma unroll
        for (int i = 0; i < 4; ++i) {
          const int c0 = i * 256 + lane * 4;
          const float4 gg = *reinterpret_cast<const float4*>(g + c0), be = *reinterpret_cast<const float4*>(bb + c0);
          v[i].x = v[i].x * rstd * gg.x + be.x; v[i].y = v[i].y * rstd * gg.y + be.y; v[i].z = v[i].z * rstd * gg.z + be.z; v[i].w = v[i].w * rstd * gg.w + be.w;
          *reinterpret_cast<float4*>(row + c0) = v[i];
          *reinterpret_cast<uint2*>(x2b + (size_t)tok * 1024 + c0) = make_uint2(pack2(v[i].x, v[i].y), pack2(v[i].z, v[i].w));
        }
      }
    } break;
    case 9: case 22: {
      const u16* A = (const u16*)(ws + (layer ? X2B1 : X2B0)); const u16* W = (const u16*)(ws + (layer ? W1_PG : W0_PG));
      const float* x2 = (const float*)(ws + (layer ? VR1 : VR0)); const float* pp = (const float*)(ws + (layer ? PP1 : PP0));
      const float* bgate = p.ple_b + layer * 1024; u16* x3b = (u16*)(ws + X3B); float* outp = p.out;
      run_tiles(128 * 8, vb, nvb, [&](int tile, bool valid) {
        const int mt = tile >> 3, ntile = tile & 7;
        GemmLoad L; set_seg1(L, A + (size_t)mt * 128 * 1024, 1024, W + (size_t)ntile * 128 * 1024, 1024, valid ? 32 : 0, tid);
        gemm_tile(L, 32, hl, tid, [&](f32x4 (&acc)[4][4], int wr, int wc, int fr, int fq) {
          if (!valid) return;
#pragma unroll
          for (int n = 0; n < 4; ++n) {
            const int col = ntile * 128 + wc * 64 + n * 16 + fr; const float bv = bgate[col];
#pragma unroll
            for (int m = 0; m < 4; ++m)
#pragma unroll
              for (int j = 0; j < 4; ++j) {
                const size_t idx = (size_t)(mt * 128 + wr * 64 + m * 16 + fq * 4 + j) * 1024 + col;
                const float gt = 1.f / (1.f + __expf(-(acc[m][n][j] + bv)));
                const float r = x2[idx] + gt * pp[idx];
                outp[idx] = r;
                if (layer == 0) x3b[idx] = f2bf(r);
              }
          }
        });
      });
    } break;
    case 10: {
      float* tl = (float*)smem;
      tconv(p.ret_w_in, 0, 6144, 1024, 2048, 1, (u16*)(ws + WRIN), 0, 3, tl);
      tconv(p.ret_w_in + 2048, 0, 6144, 1024, 4096, 1, (u16*)(ws + WRIN) + (size_t)2048 * 1024, 0, 0, tl);
      tconv(p.ret_w_out, 0, 1024, 2048, 1024, 1, (u16*)(ws + WROUT), 0, 0, tl);
      econv(p.p + (size_t)T * 256, (u16*)(ws + PB), (size_t)T * 256);
      float2* cs = (float2*)(ws + CS);
      const size_t gt = (size_t)blockIdx.x * 512 + threadIdx.x, gn = (size_t)gridDim.x * 512;
      for (size_t i = gt; i < (size_t)T * 128; i += gn) {
        const int tok = (int)(i >> 7), f = (int)(i & 127);
        const float invf = powf(10000.f, -(float)(2 * f) / 256.f);
        const float ang = (float)p.pos[tok] * invf;
        const double rev = (double)ang * 0.15915494309189535;
        const float fr_ = (float)(rev - rint(rev));
        cs[i] = make_float2(__builtin_amdgcn_cosf(fr_), __builtin_amdgcn_sinf(fr_));
      }
    } break;
    case 11: {
      const u16* A = (const u16*)(ws + X3B); const u16* W = (const u16*)(ws + WRIN);
      u16* q1 = (u16*)(ws + Q1); u16* k1 = (u16*)(ws + K1); u16* ktd = (u16*)(ws + KTD); u16* vt = (u16*)(ws + VT);
      const float2* cs = (const float2*)(ws + CS);
      run_tiles(128 * 32, vb, nvb, [&](int tile, bool valid) {
        const int mt = tile >> 5, ntile = tile & 31;
        GemmLoad L; set_seg1(L, A + (size_t)mt * 128 * 1024, 1024, W + (size_t)ntile * 128 * 1024, 1024, valid ? 32 : 0, tid);
        gemm_tile(L, 32, hl, tid, [&](f32x4 (&acc)[4][4], int wr, int wc, int fr, int fq) {
          if (!valid) return;
          if (ntile < 16) {
            const int isk = ntile >> 3, hh = (ntile & 7) >> 1, th = ntile & 1;
            const float lg2 = gamma_log2(hh);
#pragma unroll
            for (int m = 0; m < 4; ++m)
#pragma unroll
              for (int j = 0; j < 4; ++j) {
                const int tok = mt * 128 + wr * 64 + m * 16 + fq * 4 + j;
                const float kdec = exp2f((float)(255 - (tok & 255)) * lg2) * 0.0625f;
#pragma unroll
                for (int n = 0; n < 2; ++n) {
                  const int i = th * 64 + wc * 32 + n * 16 + fr;
                  const float2 c = cs[(size_t)tok * 128 + i];
                  const float x1 = acc[m][n][j], x2 = acc[m][n + 2][j];
                  const float r1 = x1 * c.x - x2 * c.y, r2 = x2 * c.x + x1 * c.y;
                  if (!isk) { q1[(size_t)tok * 1024 + hh * 256 + i] = f2bf(r1); q1[(size_t)tok * 1024 + hh * 256 + 128 + i] = f2bf(r2); }
                  else {
                    k1[(size_t)tok * 1024 + hh * 256 + i] = f2bf(r1 * 0.0625f); k1[(size_t)tok * 1024 + hh * 256 + 128 + i] = f2bf(r2 * 0.0625f);
                    ktd[(size_t)(hh * 256 + i) * T + tok] = f2bf(r1 * kdec); ktd[(size_t)(hh * 256 + 128 + i) * T + tok] = f2bf(r2 * kdec);
                  }
                }
              }
          } else {
            const int c0 = (ntile - 16) * 128;
#pragma unroll
            for (int m = 0; m < 4; ++m)
#pragma unroll
              for (int n = 0; n < 4; ++n) {
                const int tok = mt * 128 + wr * 64 + m * 16 + fq * 4, col = c0 + wc * 64 + n * 16 + fr;
                *reinterpret_cast<uint2*>(vt + (size_t)col * T + tok) = make_uint2(pack2(acc[m][n][0], acc[m][n][1]), pack2(acc[m][n][2], acc[m][n][3]));
              }
          }
        });
      });
    } break;
    case 12: {
      const u16* q1 = (const u16*)(ws + Q1); const u16* k1 = (const u16*)(ws + K1); const u16* ktd = (const u16*)(ws + KTD); const u16* vt = (const u16*)(ws + VT);
      u16* kv = (u16*)(ws + KV); u16* sp = (u16*)(ws + SP);
      run_tiles(256 * 8, vb, nvb, [&](int tile, bool valid) {
        const int item = tile >> 3, mt = (tile >> 1) & 3, ntile = tile & 1; const int b = item >> 6, h = (item >> 4) & 3, c = item & 15;
        const size_t t0 = (size_t)b * SEQ + c * 256;
        GemmLoad L; set_seg1(L, vt + (size_t)(h * 512 + mt * 128) * T + t0, T, ktd + (size_t)(h * 256 + ntile * 128) * T + t0, T, valid ? 8 : 0, tid);
        gemm_tile(L, 8, hl, tid, [&](f32x4 (&acc)[4][4], int wr, int wc, int fr, int fq) {
          if (!valid) return;
#pragma unroll
          for (int m = 0; m < 4; ++m)
#pragma unroll
            for (int n = 0; n < 4; ++n)
#pragma unroll
              for (int j = 0; j < 4; ++j)
                kv[(size_t)item * 131072 + (size_t)(mt * 128 + wr * 64 + m * 16 + fq * 4 + j) * 256 + ntile * 128 + wc * 64 + n * 16 + fr] = f2bf(acc[m][n][j]);
        });
      });
      run_tiles(256 * 3, vb, nvb, [&](int tile, bool valid) {
        const int item = tile / 3, tt = tile % 3; const int mt = tt ? 1 : 0, ntile = tt == 2 ? 1 : 0; const int b = item >> 6, h = (item >> 4) & 3, c = item & 15;
        const size_t t0 = (size_t)b * SEQ + c * 256;
        GemmLoad L; set_seg1(L, q1 + (t0 + mt * 128) * 1024 + h * 256, 1024, k1 + (t0 + ntile * 128) * 1024 + h * 256, 1024, valid ? 8 : 0, tid);
        const float lg2 = gamma_log2(h);
        gemm_tile(L, 8, hl, tid, [&](f32x4 (&acc)[4][4], int wr, int wc, int fr, int fq) {
          if (!valid) return;
#pragma unroll
          for (int n = 0; n < 4; ++n) {
            const int jj = ntile * 128 + wc * 64 + n * 16 + fr; const float sc = exp2f(-(float)(jj + 1) * lg2);
#pragma unroll
            for (int m = 0; m < 4; ++m)
#pragma unroll
              for (int j = 0; j < 4; ++j) {
                const int ii = mt * 128 + wr * 64 + m * 16 + fq * 4 + j;
                sp[(size_t)item * 65536 + (size_t)ii * 256 + jj] = f2bf(jj <= ii ? acc[m][n][j] * sc : 0.f);
              }
          }
        });
      });
    } break;
    case 13: {
      u16* kv = (u16*)(ws + KV);
      const size_t gt = (size_t)blockIdx.x * 512 + threadIdx.x, gn = (size_t)gridDim.x * 512;
      for (size_t i = gt; i < (size_t)16 * 16384; i += gn) {
        const int bh = (int)(i >> 14); const size_t el = (i & 16383) * 8; const int h = bh & 3;
        const float cd = exp2f(256.f * gamma_log2(h));
        float s[8];
#pragma unroll
        for (int e = 0; e < 8; ++e) s[e] = 0.f;
        for (int c = 0; c < 16; ++c) {
          uint4* ptr = reinterpret_cast<uint4*>(kv + (size_t)(bh * 16 + c) * 131072 + el);
          const uint4 v = *ptr;
          *ptr = make_uint4(pack2(s[0], s[1]), pack2(s[2], s[3]), pack2(s[4], s[5]), pack2(s[6], s[7]));
          s[0] = s[0] * cd + __uint_as_float(v.x << 16); s[1] = s[1] * cd + __uint_as_float(v.x & 0xffff0000u);
          s[2] = s[2] * cd + __uint_as_float(v.y << 16); s[3] = s[3] * cd + __uint_as_float(v.y & 0xffff0000u);
          s[4] = s[4] * cd + __uint_as_float(v.z << 16); s[5] = s[5] * cd + __uint_as_float(v.z & 0xffff0000u);
          s[6] = s[6] * cd + __uint_as_float(v.w << 16); s[7] = s[7] * cd + __uint_as_float(v.w & 0xffff0000u);
        }
      }
    } break;
    case 14: {
      const u16* q1 = (const u16*)(ws + Q1); const u16* vt = (const u16*)(ws + VT); const u16* kv = (const u16*)(ws + KV); const u16* sp = (const u16*)(ws + SP);
      u16* o1 = (u16*)(ws + O1);
      run_tiles(256 * 8, vb, nvb, [&](int tile, bool valid) {
        const int item = tile >> 3, mt = (tile >> 2) & 1, ntile = tile & 3; const int b = item >> 6, h = (item >> 4) & 3, c = item & 15;
        const size_t t0 = (size_t)b * SEQ + c * 256;
        GemmLoad L; set_seg1(L, sp + (size_t)item * 65536 + (size_t)mt * 128 * 256, 256, vt + (size_t)(h * 512 + ntile * 128) * T + t0, T, valid ? 4 * (mt + 1) : 0, tid);
        { const int r = tid >> 2, kc = (tid & 3) * 8;
          const u16* A2 = q1 + (t0 + mt * 128) * 1024 + h * 256; const u16* B2 = kv + (size_t)item * 131072 + (size_t)ntile * 128 * 256;
          L.c0 = A2 + (size_t)r * 1024 + kc; L.c1 = A2 + (size_t)(r + 64) * 1024 + kc; L.d0 = B2 + (size_t)r * 256 + kc; L.d1 = B2 + (size_t)(r + 64) * 256 + kc; L.nt2 = valid ? 8 : 0; }
        const float lg2 = gamma_log2(h);
        gemm_tile(L, 16, hl, tid, [&](f32x4 (&acc)[4][4], int wr, int wc, int fr, int fq) {
          if (!valid) return;
#pragma unroll
          for (int m = 0; m < 4; ++m)
#pragma unroll
            for (int j = 0; j < 4; ++j) {
              const int ii = mt * 128 + wr * 64 + m * 16 + fq * 4 + j; const float sc = exp2f((float)(ii + 1) * lg2);
#pragma unroll
              for (int n = 0; n < 4; ++n) o1[(t0 + ii) * 2048 + h * 512 + ntile * 128 + wc * 64 + n * 16 + fr] = f2bf(acc[m][n][j] * sc);
            }
        });
      });
    } break;
    case 15: {
      const u16* o1 = (const u16*)(ws + O1); float2* st = (float2*)(ws + GNST);
      for (int it = gw; it < T * 4; it += nw) {
        const uint4 v = *reinterpret_cast<const uint4*>(o1 + (size_t)it * 512 + lane * 8);
        float f[8] = {__uint_as_float(v.x << 16), __uint_as_float(v.x & 0xffff0000u), __uint_as_float(v.y << 16), __uint_as_float(v.y & 0xffff0000u),
                      __uint_as_float(v.z << 16), __uint_as_float(v.z & 0xffff0000u), __uint_as_float(v.w << 16), __uint_as_float(v.w & 0xffff0000u)};
        float s = 0.f;
#pragma unroll
        for (int e = 0; e < 8; ++e) s += f[e];
        const float mu = wsum(s) * (1.f / 512.f);
        float sq = 0.f;
#pragma unroll
        for (int e = 0; e < 8; ++e) { const float d = f[e] - mu; sq += d * d; }
        const float rstd = rsqrtf(wsum(sq) * (1.f / 512.f) + LN_EPS);
        if (lane == 0) st[it] = make_float2(mu, rstd);
      }
      float* tl = (float*)smem;
      const size_t lo = (size_t)16 * 1024 * 512;
      tconv(p.w_gate + lo, 1024 * 512, 512, 1024, 512, 16, (u16*)(ws + W1_GU), 1024 * 1024, 1, tl);
      tconv(p.w_up + lo, 1024 * 512, 512, 1024, 512, 16, (u16*)(ws + W1_GU), 1024 * 1024, 2, tl);
      tconv(p.w_down + lo, 512 * 1024, 1024, 512, 1024, 16, (u16*)(ws + W1_D), 1024 * 512, 0, tl);
      tconv(p.ple_gate + (size_t)1024 * 1024, 0, 1024, 1024, 1024, 1, (u16*)(ws + W1_PG), 0, 0, tl);
      tconv(p.ple_proj + (size_t)256 * 1024, 0, 1024, 256, 1024, 1, (u16*)(ws + W1_PP), 0, 0, tl);
    } break;
    case 16: {
      const u16* A = (const u16*)(ws + X3B); const u16* W = (const u16*)(ws + WRIN) + (size_t)4096 * 1024;
      u16* o1 = (u16*)(ws + O1); const float2* st = (const float2*)(ws + GNST);
      run_tiles(128 * 16, vb, nvb, [&](int tile, bool valid) {
        const int mt = tile >> 4, ntile = tile & 15;
        GemmLoad L; set_seg1(L, A + (size_t)mt * 128 * 1024, 1024, W + (size_t)ntile * 128 * 1024, 1024, valid ? 32 : 0, tid);
        gemm_tile(L, 32, hl, tid, [&](f32x4 (&acc)[4][4], int wr, int wc, int fr, int fq) {
          if (!valid) return;
          const int hh = ntile >> 2;
#pragma unroll
          for (int m = 0; m < 4; ++m)
#pragma unroll
            for (int j = 0; j < 4; ++j) {
              const int tok = mt * 128 + wr * 64 + m * 16 + fq * 4 + j; const float2 ms = st[tok * 4 + hh];
#pragma unroll
              for (int n = 0; n < 4; ++n) {
                const size_t idx = (size_t)tok * 2048 + ntile * 128 + wc * 64 + n * 16 + fr;
                o1[idx] = f2bf(siluf(acc[m][n][j]) * ((bf2f(o1[idx]) - ms.x) * ms.y));
              }
            }
        });
      });
    } break;
    default: break;
    }
  }
}

#define PHASE(n) if (ph0 <= n && n < ph1) { run_phase<n>(p, smem); if (n + 1 < ph1) grid.sync(); }
__global__ void __launch_bounds__(512) mega(P p, int ph0, int ph1) {
  extern __shared__ __attribute__((aligned(16))) char smem[];
  cg::grid_group grid = cg::this_grid();
  PHASE(0) PHASE(1) PHASE(2) PHASE(3) PHASE(4) PHASE(5) PHASE(6) PHASE(7) PHASE(8) PHASE(9) PHASE(10) PHASE(11)
  PHASE(12) PHASE(13) PHASE(14) PHASE(15) PHASE(16) PHASE(17) PHASE(18) PHASE(19) PHASE(20) PHASE(21) PHASE(22)
}

extern "C" void kernel_launch(void* const* d_in, const int* in_sizes, int n_in, void* d_out, int out_size, void* d_ws, size_t ws_size, hipStream_t stream) {
  static int grid_blocks = 0;
  if (!grid_blocks) {
    int dev = 0, cus = 0, per_cu = 0;
    hipGetDevice(&dev);
    hipDeviceGetAttribute(&cus, hipDeviceAttributeMultiprocessorCount, dev);
    hipFuncSetAttribute((const void*)mega, hipFuncAttributeMaxDynamicSharedMemorySize, LDS_BYTES);
    hipOccupancyMaxActiveBlocksPerMultiprocessor(&per_cu, (const void*)mega, 512, LDS_BYTES);
    if (per_cu < 1) { fprintf(stderr, "occupancy query returned %d\n", per_cu); per_cu = 1; }
    grid_blocks = cus * 1;
    if (ws_size < 345 * MiB) fprintf(stderr, "workspace too small: %zu\n", ws_size);
  }
  P p{};
  p.x = (const float*)d_in[0]; p.p = (const float*)d_in[1]; p.pos = (const int*)d_in[2];
  p.fox_w_in = (const float*)d_in[3]; p.fox_b_f = (const float*)d_in[4]; p.fox_w_out = (const float*)d_in[5];
  p.ret_w_in = (const float*)d_in[6]; p.ret_w_out = (const float*)d_in[7];
  p.ln1_g = (const float*)d_in[8]; p.ln1_b = (const float*)d_in[9]; p.ln2_g = (const float*)d_in[10]; p.ln2_b = (const float*)d_in[11];
  p.w_group = (const float*)d_in[12]; p.b_group = (const float*)d_in[13]; p.w_router = (const float*)d_in[14]; p.b_router = (const float*)d_in[15];
  p.w_gate = (const float*)d_in[16]; p.w_up = (const float*)d_in[17]; p.w_down = (const float*)d_in[18];
  p.ple_proj = (const float*)d_in[19]; p.ple_gate = (const float*)d_in[20]; p.ple_b = (const float*)d_in[21];
  p.out = (float*)d_out; p.ws = (char*)d_ws;
#if MEGA
  int ph0 = 0, ph1 = NPH;
  void* args[] = {&p, &ph0, &ph1};
  hipError_t e = hipLaunchCooperativeKernel((const void*)mega, dim3(grid_blocks), dim3(512), args, LDS_BYTES, stream);
  if (e != hipSuccess) fprintf(stderr, "cooperative launch failed: %s (grid %d)\n", hipGetErrorString(e), grid_blocks);
#else
  for (int ph = 0; ph < NPH; ++ph) hipLaunchKernelGGL(mega, dim3(grid_blocks), dim3(512), LDS_BYTES, stream, p, ph, ph + 1);
#endif
}
```

```cpp
#include <hip/hip_runtime.h>
#include <hip/hip_cooperative_groups.h>
#include <cstdio>
#include <cstdint>
namespace cg = cooperative_groups;

#ifndef MEGA
#define MEGA 1
#endif

typedef unsigned short u16;
using bf16x8 = __attribute__((ext_vector_type(8))) short;
using f32x4 = __attribute__((ext_vector_type(4))) float;
#define DEVI __device__ __forceinline__

constexpr int T = 16384, SEQ = 4096;
constexpr size_t MiB = 1ull << 20;
constexpr float ALPHA = 1.4142135623730951f;
constexpr float LN_EPS = 1e-5f;
constexpr int NPH = 23;
constexpr int LDS_BYTES = 100352 + 16;

constexpr size_t W0_QKV = 0, W0_OUT = 7 * MiB, W0_GU = 9 * MiB, W0_D = 41 * MiB, W0_PG = 57 * MiB, W0_PP = 59 * MiB;
constexpr size_t QKV0 = 60 * MiB, X1B0 = 60 * MiB, YBUF0 = 60 * MiB, HBUF0 = 124 * MiB, X2B0 = 124 * MiB;
constexpr size_t VR0 = 156 * MiB, PP0 = 220 * MiB, XB0 = 284 * MiB, O0 = 284 * MiB, X3B = 284 * MiB;
constexpr size_t PB = 316 * MiB, CS = 324 * MiB, LOGF = 340 * MiB, C8 = 341 * MiB, LISTS = 342 * MiB, TOKW = 343 * MiB;
constexpr size_t GNST = 343 * MiB + 512 * 1024, CNT = 344 * MiB, BARW = 344 * MiB + 4096;
constexpr size_t WRIN = 0, WROUT = 12 * MiB, Q1 = 16 * MiB, K1 = 48 * MiB, KTD = 80 * MiB, VT = 112 * MiB, O1 = 48 * MiB;
constexpr size_t KV = 176 * MiB, SP = 240 * MiB, W1_GU = 176 * MiB, W1_D = 208 * MiB, W1_PG = 224 * MiB, W1_PP = 226 * MiB;
constexpr size_t VR1 = 112 * MiB, PP1 = 240 * MiB, X1B1 = 16 * MiB, HBUF1 = 80 * MiB, YBUF1 = 0, X2B1 = 80 * MiB;

struct P {
  const float *x, *p; const int* pos;
  const float *fox_w_in, *fox_b_f, *fox_w_out, *ret_w_in, *ret_w_out, *ln1_g, *ln1_b, *ln2_g, *ln2_b;
  const float *w_group, *b_group, *w_router, *b_router, *w_gate, *w_up, *w_down, *ple_proj, *ple_gate, *ple_b;
  float* out; char* ws;
};

DEVI float bf2f(u16 b) { return __uint_as_float(((unsigned)b) << 16); }
DEVI u16 f2bf(float f) { unsigned u = __float_as_uint(f); u += 0x7FFFu + ((u >> 16) & 1u); return (u16)(u >> 16); }
DEVI unsigned pack2(float a, float b) { return (unsigned)f2bf(a) | ((unsigned)f2bf(b) << 16); }
DEVI float wsum(float v) {
#pragma unroll
  for (int o = 32; o >= 1; o >>= 1) v += __shfl_xor(v, o);
  return v;
}
DEVI float siluf(float v) { return v / (1.f + __expf(-v)); }
DEVI float logsig(float z) { return fminf(z, 0.f) - log1pf(__expf(-fabsf(z))); }

struct GemmLoad {
  const u16 *a0, *a1, *b0, *b1;
  const u16 *c0, *c1, *d0, *d1;
  int nt1, nt2;
};
DEVI void glds16(const u16* g, char* l) {
  __builtin_amdgcn_global_load_lds((const __attribute__((address_space(1))) void*)g, (__attribute__((address_space(3))) void*)l, 16, 0, 0);
}
template <class Epi>
DEVI void gemm_tile(const GemmLoad& L, int nt_max, char* lds, int tid, Epi&& epi) {
  const int wid = tid >> 6, lane = tid & 63, wr = wid >> 1, wc = wid & 1, fr = lane & 15, fq = lane >> 4;
  f32x4 acc[4][4];
#pragma unroll
  for (int m = 0; m < 4; ++m)
#pragma unroll
    for (int n = 0; n < 4; ++n) acc[m][n] = f32x4{0.f, 0.f, 0.f, 0.f};
  const int nt = L.nt1 + L.nt2;
  auto stage = [&](int t, int buf) {
    char* sa = lds + buf * 16384 + tid * 16; char* sb = sa + 8192;
    const u16 *pa0, *pa1, *pb0, *pb1;
    if (t < L.nt1) { pa0 = L.a0 + t * 32; pa1 = L.a1 + t * 32; pb0 = L.b0 + t * 32; pb1 = L.b1 + t * 32; }
    else { const int t2 = t - L.nt1; pa0 = L.c0 + t2 * 32; pa1 = L.c1 + t2 * 32; pb0 = L.d0 + t2 * 32; pb1 = L.d1 + t2 * 32; }
    glds16(pa0, sa); glds16(pa1, sa + 4096); glds16(pb0, sb); glds16(pb1, sb + 4096);
  };
  if (nt > 0) stage(0, 0);
  for (int t = 0; t < nt_max; ++t) {
    asm volatile("s_waitcnt vmcnt(0)" ::: "memory");
    __syncthreads();
    if (t + 1 < nt) stage(t + 1, (t + 1) & 1);
    if (t < nt) {
      const char* sa = lds + (t & 1) * 16384; const char* sb = sa + 8192;
      bf16x8 af[4], bfv[4];
#pragma unroll
      for (int m = 0; m < 4; ++m) af[m] = *reinterpret_cast<const bf16x8*>(sa + (wr * 64 + m * 16 + fr) * 64 + fq * 16);
#pragma unroll
      for (int n = 0; n < 4; ++n) bfv[n] = *reinterpret_cast<const bf16x8*>(sb + (wc * 64 + n * 16 + fr) * 64 + fq * 16);
#pragma unroll
      for (int m = 0; m < 4; ++m)
#pragma unroll
        for (int n = 0; n < 4; ++n) acc[m][n] = __builtin_amdgcn_mfma_f32_16x16x32_bf16(af[m], bfv[n], acc[m][n], 0, 0, 0);
    }
  }
  __syncthreads();
  epi(acc, wr, wc, fr, fq);
}
template <class TF>
DEVI void run_tiles(int ntiles, int vb, int nvb, TF&& f) {
  const int niter = (ntiles + nvb - 1) / nvb;
  for (int it = 0; it < niter; ++it) { const int tile = it * nvb + vb; const bool valid = tile < ntiles; f(valid ? tile : 0, valid); }
}
DEVI void set_seg1(GemmLoad& L, const u16* A, size_t lda, const u16* B, size_t ldb, int nt, int tid) {
  const int r = tid >> 2, kc = (tid & 3) * 8;
  L.a0 = A + (size_t)r * lda + kc; L.a1 = A + (size_t)(r + 64) * lda + kc;
  L.b0 = B + (size_t)r * ldb + kc; L.b1 = B + (size_t)(r + 64) * ldb + kc;
  L.c0 = L.a0; L.c1 = L.a1; L.d0 = L.b0; L.d1 = L.b1; L.nt1 = nt; L.nt2 = 0;
}

DEVI int rowmap(int mode, int n) {
  if (mode == 0) return n;
  if (mode == 1 || mode == 2) { const int tile = n >> 6, w = n & 63, wc = w >> 5, rr = w & 31; return tile * 128 + wc * 64 + (mode == 2 ? 32 : 0) + rr; }
  const int hh = n >> 8, ip = n & 255, comp = ip >> 7, i = ip & 127, th = i >> 6, w = i & 63, wc = w >> 5, rr = w & 31;
  return hh * 256 + th * 128 + wc * 64 + comp * 32 + rr;
}
DEVI void tconv(const float* __restrict__ src, size_t sbs, int ldsrc, int K, int N, int nbatch, u16* __restrict__ dst, size_t dbs, int mode, float* tl) {
  const int tid = threadIdx.x; const int tk = K >> 6, tn = N >> 6; const int per = tk * tn, nt = per * nbatch;
  for (int tile = blockIdx.x; tile < nt; tile += gridDim.x) {
    const int b = tile / per, tt = tile % per; const int k0 = (tt / tn) << 6, n0 = (tt % tn) << 6;
    const float* s = src + (size_t)b * sbs; u16* d = dst + (size_t)b * dbs;
    { const int ty = tid >> 6, tx = tid & 63;
#pragma unroll
      for (int r = 0; r < 8; ++r) { const int k = ty * 8 + r; tl[k * 65 + tx] = s[(size_t)(k0 + k) * ldsrc + n0 + tx]; } }
    __syncthreads();
    { const int n = tid >> 3, kc = tid & 7;
      const unsigned w0 = pack2(tl[(kc * 8 + 0) * 65 + n], tl[(kc * 8 + 1) * 65 + n]);
      const unsigned w1 = pack2(tl[(kc * 8 + 2) * 65 + n], tl[(kc * 8 + 3) * 65 + n]);
      const unsigned w2 = pack2(tl[(kc * 8 + 4) * 65 + n], tl[(kc * 8 + 5) * 65 + n]);
      const unsigned w3 = pack2(tl[(kc * 8 + 6) * 65 + n], tl[(kc * 8 + 7) * 65 + n]);
      const int nr = rowmap(mode, n0 + n);
      *reinterpret_cast<uint4*>(d + (size_t)nr * K + k0 + kc * 8) = make_uint4(w0, w1, w2, w3); }
    __syncthreads();
  }
}
DEVI void econv(const float* __restrict__ src, u16* __restrict__ dst, size_t n) {
  const size_t gt = (size_t)blockIdx.x * 512 + threadIdx.x, gn = (size_t)gridDim.x * 512;
  for (size_t i = gt * 4; i < n; i += gn * 4) {
    const float4 v = *reinterpret_cast<const float4*>(src + i);
    *reinterpret_cast<uint2*>(dst + i) = make_uint2(pack2(v.x, v.y), pack2(v.z, v.w));
  }
}

DEVI float gamma_log2(int h) { return log2f(1.0f - exp2f(-5.0f - (float)h)); }

DEVI int moe_ntiles(const int* cnt, int ntn) { int s = 0; for (int i = 0; i < 16; ++i) s += ((cnt[i] + 127) >> 7) * ntn; return s; }
DEVI void moe_tile(const int* cnt, int tile, int ntn, int& e, int& mt, int& nt, int& base, int& ce) {
  int at = 0, b = 0; e = 0; mt = 0; nt = 0; base = 0; ce = 0;
  for (int i = 0; i < 16; ++i) {
    const int c = cnt[i]; const int tl = ((c + 127) >> 7) * ntn;
    if (tile >= at && tile < at + tl) { const int r = tile - at; e = i; mt = r / ntn; nt = r % ntn; base = b; ce = c; }
    at += tl; b += c;
  }
}


namespace fa {
using s16x4 = __attribute__((ext_vector_type(4))) short;
using f32x16 = __attribute__((ext_vector_type(16))) float;
using u32x4 = __attribute__((ext_vector_type(4))) unsigned;
constexpr int D = 64, DMQ = 3072, DMO = 1024, NW = 8, QBLK = 32, QB = 256, KVBLK = 64, NQB = SEQ / QB, THR = 8;
constexpr float C2 = 0.125f * 1.4426950408889634f;
constexpr int SLOTB = 8192, LDS_K = 0, LDS_V = 3 * SLOTB, LDS_WS = 6 * SLOTB, LDS_OST = LDS_WS + NW * 256, LDS_C8 = LDS_OST + NW * 4096, LDS_TOTAL = LDS_C8 + 16384;
#define SBAR() __builtin_amdgcn_sched_barrier(0)
#define PIN(x) asm volatile("" : "+v"(x))
#define MFMA(a, b, c) __builtin_amdgcn_mfma_f32_32x32x16_bf16(a, b, c, 0, 0, 0)
#define WAIT_BAR(N) asm volatile("s_waitcnt vmcnt(" #N ") lgkmcnt(0)\n\ts_barrier" ::: "memory")
DEVI int crow(int r, int hi) { return (r & 3) + 8 * (r >> 2) + 4 * hi; }
DEVI unsigned cvtpk(float lo, float hi) { unsigned r; asm("v_cvt_pk_bf16_f32 %0, %1, %2" : "=v"(r) : "v"(lo), "v"(hi)); return r; }
DEVI void glds16a(const void* g, unsigned lds_base) {
  unsigned sv; asm volatile("s_mov_b32 %0, m0\n\ts_mov_b32 m0, %2\n\ts_nop 0\n\tglobal_load_lds_dwordx4 %1, off\n\ts_mov_b32 m0, %0" : "=&s"(sv) : "v"(g), "s"(lds_base) : "memory"); }
typedef __attribute__((address_space(3))) const char* lds_cptr;
typedef short v4i16_t __attribute__((ext_vector_type(4)));
DEVI void kload2(bf16x8* kf, lds_cptr kp, int d0) { kf[2 * d0] = *(const __attribute__((address_space(3))) bf16x8*)(kp + d0 * 2048); kf[2 * d0 + 1] = *(const __attribute__((address_space(3))) bf16x8*)(kp + d0 * 2048 + 512); }
DEVI s16x4 vtr(lds_cptr p) { return __builtin_bit_cast(s16x4, __builtin_amdgcn_ds_read_tr16_b64_v4i16((__attribute__((address_space(3))) v4i16_t*)p)); }
#define MX3(a, b, c) __builtin_fmaxf(__builtin_fmaxf((a), (b)), (c))
DEVI float rowmax(const f32x16& p0, const f32x16& p1) {
  float a = MX3(p0[0], p0[1], p1[0]), b = MX3(p0[2], p0[3], p1[1]); a = MX3(a, p1[2], p1[3]);
#pragma unroll
  for (int r = 4; r < 16; r += 4) { a = MX3(a, p0[r], p0[r + 1]); b = MX3(b, p0[r + 2], p0[r + 3]); a = MX3(a, p1[r], p1[r + 1]); b = MX3(b, p1[r + 2], p1[r + 3]); }
  float m = __builtin_fmaxf(a, b); auto rr = __builtin_amdgcn_permlane32_swap(__float_as_uint(m), __float_as_uint(m), false, false);
  return __builtin_fmaxf(__uint_as_float(rr[0]), __uint_as_float(rr[1])); }
DEVI void cmask(f32x16& p0, f32x16& p1, int jb, int qrel, int hi) {
  const int kb = 64 * jb + 4 * hi;
#pragma unroll
  for (int r = 0; r < 16; ++r) { const int kv = kb + (r & 3) + 8 * (r >> 2); if (kv > qrel) p0[r] = -INFINITY; if (kv + 32 > qrel) p1[r] = -INFINITY; } }

DEVI void attn_unit(int b, int h, int qb, const u16* Q, const u16* __restrict__ K, const u16* __restrict__ V, u16* O, const float* __restrict__ c8g, char* lds) {
  int tid = threadIdx.x; asm volatile("" : "+v"(tid));
  const int lane = tid & 63, r32 = lane & 31, hi = lane >> 5; const int wid = __builtin_amdgcn_readfirstlane(tid >> 6);
  const long rowbase = (long)b * SEQ; const int q0 = qb * QB, NT = (q0 + QB) / KVBLK;
  const u16* Qw = Q + (rowbase + q0 + wid * QBLK) * DMQ + h * D;
  const unsigned lds0 = (unsigned)(uintptr_t)lds; float* wsf = (float*)(lds + LDS_WS) + wid * 64;
  { const int nv = (q0 + QB) >> 2; float4* dstc = (float4*)(lds + LDS_C8); const float4* srcc = (const float4*)c8g;
    for (int i = tid; i < nv; i += 512) dstc[i] = srcc[i]; }
  const float cq8 = c8g[q0 + wid * QBLK + r32];
  const lds_cptr c8p = (lds_cptr)lds + LDS_C8 + 16 * hi;
  const u16* ksrc = K + rowbase * DMQ + h * D + (long)lane * DMQ + wid * 8;
  const u16* vsrc = V + rowbase * DMQ + h * D + (long)(16 * (wid & 3) + (lane >> 2)) * DMQ + (wid >> 2) * 32 + (lane & 3) * 8;
  const unsigned kdst = lds0 + LDS_K + wid * 1024, vdst = lds0 + LDS_V + wid * 1024;
#define DMA_K(t, slot) glds16a(ksrc + (long)(t) * KVBLK * DMQ, (unsigned)__builtin_amdgcn_readfirstlane(kdst + (slot)))
#define DMA_V(t, slot) glds16a(vsrc + (long)(t) * KVBLK * DMQ, (unsigned)__builtin_amdgcn_readfirstlane(vdst + (slot)))
  const lds_cptr vp0 = (lds_cptr)lds + LDS_V + ((lane >> 4) & 1) * 32 + (lane & 3) * 8 + (4 * hi + ((lane & 15) >> 2)) * 64;
  const lds_cptr kp0 = (lds_cptr)lds + LDS_K + hi * 1024 + r32 * 16;
  DMA_K(0, 0); DMA_V(0, 0); DMA_K(1, SLOTB);
  bf16x8 qr[4];
#pragma unroll
  for (int d0 = 0; d0 < 4; ++d0) qr[d0] = *reinterpret_cast<const bf16x8*>(&Qw[(long)r32 * DMQ + d0 * 16 + hi * 8]);
  float mhat = 0.f, l_reg = 0.f; f32x16 o[2]; o[0] = f32x16{}; o[1] = f32x16{};
  const int qrel = wid * QBLK + r32; bool resc = false;
  f32x16 pA0, pA1, pB0, pB1; bf16x8 kf[8]; s16x4 vlo[8], vhi[8]; u32x4 pw0, pw1, pw2, pw3;
  int sl_prev = 0, sl_cur = 0, sl_next = SLOTB;
#define ROT() do { sl_prev = sl_cur; sl_cur = sl_next; sl_next = (sl_next == 2 * SLOTB) ? 0 : sl_next + SLOTB; } while (0)
#define EX(v) __builtin_amdgcn_exp2f(__builtin_fmaf((v), C2, nmh))
#define RESC() do { if (resc) { _Pragma("unroll") for (int d_ = 0; d_ < 2; ++d_) _Pragma("unroll") for (int r = 0; r < 16; ++r) o[d_][r] *= wsf[crow(r, hi)]; } } while (0)
#define BIAS(C0, C1, t) do { const lds_cptr cb_ = c8p + (t) * 256; \
    _Pragma("unroll") for (int g_ = 0; g_ < 4; ++g_) { \
      const f32x4 u_ = *(const __attribute__((address_space(3))) f32x4*)(cb_ + g_ * 32); \
      const f32x4 w_ = *(const __attribute__((address_space(3))) f32x4*)(cb_ + 128 + g_ * 32); \
      C0[4 * g_ + 0] = cq8 - u_[0]; C0[4 * g_ + 1] = cq8 - u_[1]; C0[4 * g_ + 2] = cq8 - u_[2]; C0[4 * g_ + 3] = cq8 - u_[3]; \
      C1[4 * g_ + 0] = cq8 - w_[0]; C1[4 * g_ + 1] = cq8 - w_[1]; C1[4 * g_ + 2] = cq8 - w_[2]; C1[4 * g_ + 3] = cq8 - w_[3]; } } while (0)
  DMA_K(2, 2 * SLOTB);
  WAIT_BAR(3);
  _Pragma("unroll") for (int d0 = 0; d0 < 4; ++d0) kload2(kf, kp0, d0);
  BIAS(pA0, pA1, 0);
  pA0 = MFMA(kf[0], qr[0], pA0); pA1 = MFMA(kf[1], qr[0], pA1); pA0 = MFMA(kf[2], qr[1], pA0); pA1 = MFMA(kf[3], qr[1], pA1);
  pA0 = MFMA(kf[4], qr[2], pA0); pA1 = MFMA(kf[5], qr[2], pA1); pA0 = MFMA(kf[6], qr[3], pA0); pA1 = MFMA(kf[7], qr[3], pA1);
  if (NT == 4) cmask(pA0, pA1, 0, qrel, hi);
  { const float rm = rowmax(pA0, pA1); mhat = rm * C2; const float nmh = -mhat;
#pragma unroll
    for (int r = 0; r < 16; ++r) { pA0[r] = EX(pA0[r]); pA1[r] = EX(pA1[r]); } }
  WAIT_BAR(0);
  DMA_K(3, 0); DMA_V(1, SLOTB); ROT();
  _Pragma("unroll") for (int d0 = 0; d0 < 4; ++d0) kload2(kf, kp0 + sl_cur, d0);
  WAIT_BAR(2);
#define PKW(P, i) cvtpk(P[i], P[i + 1])
#define PAF(k) __builtin_bit_cast(bf16x8, pw##k)
#define VFR(i) (bf16x8){vlo[i][0], vlo[i][1], vlo[i][2], vlo[i][3], vhi[i][0], vhi[i][1], vhi[i][2], vhi[i][3]}
#define VRD(i) do { vlo[i] = vtr(vp_ + (((i) >> 2) * 4096 + ((i) & 3) * 1024)); vhi[i] = vtr(vp_ + (((i) >> 2) * 4096 + ((i) & 3) * 1024 + 512)); } while (0)
#define KRD(G, d0) do { if (G) { kload2(kf, kp0 + sl_next, d0); SBAR(); } } while (0)
#define GAPA(MF, a0, a1, a2, a3, W0, W1, PW) do { MF; sacc += a0; sacc += a1; sacc += a2; sacc += a3; W0; W1; PIN(PW); PIN(sacc); SBAR(); } while (0)
#define GAPB(MF, X, i) do { MF; X[i] = EX(X[i]); X[i + 1] = EX(X[i + 1]); X[i + 2] = EX(X[i + 2]); X[i + 3] = EX(X[i + 3]); PIN(X); SBAR(); } while (0)
#define STEP(C0, C1, P0, P1, t, MASK, GK, GV, GL) do { BIAS(C0, C1, t); SBAR(); \
    const lds_cptr vp_ = vp0 + sl_prev; \
    VRD(0); SBAR(); float sacc = P0[0] + P0[1]; \
                    GAPA(C0 = MFMA(kf[0], qr[0], C0), P0[2], P0[3], P0[4], P0[5],     pw0[0] = PKW(P0, 0),  pw0[1] = PKW(P0, 2),  pw0); \
    VRD(4); SBAR(); GAPA(C1 = MFMA(kf[1], qr[0], C1), P0[6], P0[7], P0[8], P0[9],     pw0[2] = PKW(P0, 4),  pw0[3] = PKW(P0, 6),  pw0); \
    VRD(1); SBAR(); GAPA(C0 = MFMA(kf[2], qr[1], C0),    P0[10], P0[11], P0[12], P0[13], pw1[0] = PKW(P0, 8),  pw1[1] = PKW(P0, 10), pw1); \
    VRD(5); SBAR(); GAPA(C1 = MFMA(kf[3], qr[1], C1),    P0[14], P0[15], P1[0], P1[1],   pw1[2] = PKW(P0, 12), pw1[3] = PKW(P0, 14), pw1); \
    VRD(2); SBAR(); GAPA(C0 = MFMA(kf[4], qr[2], C0),    P1[2], P1[3], P1[4], P1[5],     pw2[0] = PKW(P1, 0),  pw2[1] = PKW(P1, 2),  pw2); \
    VRD(6); SBAR(); GAPA(C1 = MFMA(kf[5], qr[2], C1),    P1[6], P1[7], P1[8], P1[9],     pw2[2] = PKW(P1, 4),  pw2[3] = PKW(P1, 6),  pw2); \
    VRD(3); SBAR(); GAPA(C0 = MFMA(kf[6], qr[3], C0),    P1[10], P1[11], P1[12], P1[13], pw3[0] = PKW(P1, 8),  pw3[1] = PKW(P1, 10), pw3); \
    VRD(7); SBAR(); GAPA(C1 = MFMA(kf[7], qr[3], C1),    P1[14], P1[15], 0.f, 0.f,       pw3[2] = PKW(P1, 12), pw3[3] = PKW(P1, 14), pw3); \
    l_reg += sacc; \
    if (GK) DMA_K((t) + 3, sl_cur); if (GV) DMA_V((t) + 1, sl_next); \
    if (MASK) cmask(C0, C1, (t) - (NT - 4), qrel, hi); \
    { const float rm = __builtin_fmaf(rowmax(C0, C1), C2, -mhat); resc = false; \
      if (__builtin_expect(__any(rm > (float)THR), 0)) { const float dl = __builtin_fmaxf(rm, 0.f); mhat += dl; \
          const float f = __builtin_amdgcn_exp2f(-dl); l_reg *= f; if (hi == 0) wsf[r32] = f; resc = true; } } \
    const float nmh = -mhat; SBAR(); \
    GAPB(o[0] = MFMA(PAF(0), VFR(0), o[0]), C0, 0);              GAPB(o[1] = MFMA(PAF(0), VFR(4), o[1]), C0, 4); \
    KRD(GL, 0); GAPB(o[0] = MFMA(PAF(1), VFR(1), o[0]), C0, 8);  KRD(GL, 1); GAPB(o[1] = MFMA(PAF(1), VFR(5), o[1]), C0, 12); \
    KRD(GL, 2); GAPB(o[0] = MFMA(PAF(2), VFR(2), o[0]), C1, 0);  KRD(GL, 3); GAPB(o[1] = MFMA(PAF(2), VFR(6), o[1]), C1, 4); \
    GAPB(o[0] = MFMA(PAF(3), VFR(3), o[0]), C1, 8);              GAPB(o[1] = MFMA(PAF(3), VFR(7), o[1]), C1, 12); \
    } while (0)
  int t = 1;
  for (; t + 5 < NT; t += 2) {
    STEP(pB0, pB1, pA0, pA1, t, false, true, true, true);     WAIT_BAR(2); RESC(); ROT();
    STEP(pA0, pA1, pB0, pB1, t + 1, false, true, true, true); WAIT_BAR(2); RESC(); ROT();
  }
#define ENDW(tt) do { if ((tt) + 3 < NT) { WAIT_BAR(2); } else if ((tt) + 2 < NT) { WAIT_BAR(1); } else { WAIT_BAR(0); } } while (0)
  for (; t + 1 < NT; t += 2) {
    STEP(pB0, pB1, pA0, pA1, t, true, (t + 3 < NT), (t + 1 < NT), (t + 1 < NT));         ENDW(t);     RESC(); ROT();
    STEP(pA0, pA1, pB0, pB1, t + 1, true, (t + 4 < NT), (t + 2 < NT), (t + 2 < NT));     ENDW(t + 1); RESC(); ROT();
  }
  STEP(pB0, pB1, pA0, pA1, NT - 1, true, false, false, false); RESC();
  { float sacc = pB0[0] + pB0[1];
#pragma unroll
    for (int r = 2; r < 16; ++r) sacc += pB0[r];
#pragma unroll
    for (int r = 0; r < 16; ++r) sacc += pB1[r];
    l_reg += sacc;
    pw0 = (u32x4){PKW(pB0, 0), PKW(pB0, 2), PKW(pB0, 4), PKW(pB0, 6)}; pw1 = (u32x4){PKW(pB0, 8), PKW(pB0, 10), PKW(pB0, 12), PKW(pB0, 14)};
    pw2 = (u32x4){PKW(pB1, 0), PKW(pB1, 2), PKW(pB1, 4), PKW(pB1, 6)}; pw3 = (u32x4){PKW(pB1, 8), PKW(pB1, 10), PKW(pB1, 12), PKW(pB1, 14)};
    const lds_cptr vp_ = vp0 + sl_cur; _Pragma("unroll") for (int i = 0; i < 8; ++i) VRD(i);
    o[0] = MFMA(PAF(0), VFR(0), o[0]); o[1] = MFMA(PAF(0), VFR(4), o[1]); o[0] = MFMA(PAF(1), VFR(1), o[0]); o[1] = MFMA(PAF(1), VFR(5), o[1]);
    o[0] = MFMA(PAF(2), VFR(2), o[0]); o[1] = MFMA(PAF(2), VFR(6), o[1]); o[0] = MFMA(PAF(3), VFR(3), o[0]); o[1] = MFMA(PAF(3), VFR(7), o[1]); }
  { auto rr = __builtin_amdgcn_permlane32_swap(__float_as_uint(l_reg), __float_as_uint(l_reg), false, false); l_reg = __uint_as_float(rr[0]) + __uint_as_float(rr[1]); }
  if (hi == 0) wsf[32 + r32] = l_reg; asm volatile("s_waitcnt lgkmcnt(0)" ::: "memory");
  float rli[16];
#pragma unroll
  for (int r = 0; r < 16; ++r) rli[r] = __builtin_amdgcn_rcpf(wsf[32 + crow(r, hi)]);
  u16* Ow = O + (rowbase + q0 + wid * QBLK) * DMO + h * D; u16* stg = (u16*)(lds + LDS_OST) + wid * 2048;
#pragma unroll
  for (int r = 0; r < 16; ++r) { const int orow = crow(r, hi);
#pragma unroll
    for (int d0 = 0; d0 < 2; ++d0) stg[orow * 64 + d0 * 32 + r32] = f2bf(o[d0][r] * rli[r]); }
  asm volatile("s_waitcnt lgkmcnt(0)" ::: "memory");
#pragma unroll
  for (int i = 0; i < 4; ++i) { const int row = i * 8 + (lane >> 3), ch = lane & 7; *(u32x4*)(Ow + (long)row * DMO + ch * 8) = *(const u32x4*)(stg + row * 64 + ch * 8); }
  asm volatile("s_waitcnt lgkmcnt(0)\n\ts_barrier" ::: "memory");
#undef DMA_K
#undef DMA_V
#undef ROT
#undef EX
#undef RESC
#undef BIAS
#undef PKW
#undef PAF
#undef VFR
#undef VRD
#undef KRD
#undef ENDW
#undef GAPA
#undef GAPB
#undef STEP
}
}

#define XB_TMO      128
#define XB_XCNT(j)  (256  + 64 * (j))
#define XB_XSUB(j)  (1280 + 64 * (j))
#define XB_XGEN(j)  (2304 + 64 * (j))
#define XB_TOP      3328
#define XB_TOPGEN   3392
#define XCD_BAR_WORDS 3456
#define XB_SPIN_CAP (1u << 18)
#define LAS __attribute__((address_space(3)))

__device__ __forceinline__ unsigned xb_ld(unsigned* p)              { return __hip_atomic_load(p, __ATOMIC_RELAXED, __HIP_MEMORY_SCOPE_AGENT); }
__device__ __forceinline__ unsigned xb_add(unsigned* p, unsigned v) { return __hip_atomic_fetch_add(p, v, __ATOMIC_RELAXED, __HIP_MEMORY_SCOPE_AGENT); }
__device__ __forceinline__ unsigned xb_xcc_id() { return (unsigned)__builtin_amdgcn_s_getreg((3 << 11) | 20) & 0xFu; }
#define XB_SPIN(cond, bar) do { unsigned _sp = 0; while (cond) { __builtin_amdgcn_s_sleep(1); \
    if ((++_sp & 255u) == 0u) { if (xb_ld(&(bar)[XB_TMO])) break; if (_sp > XB_SPIN_CAP) { atomicAdd(&(bar)[XB_TMO], 1u); break; } } } } while (0)

struct XcdBarrier {
    unsigned* bar; unsigned x;
    volatile LAS unsigned* st;
};

__device__ __forceinline__ XcdBarrier xcd_barrier_post(unsigned* bar, volatile LAS unsigned* st) {
    XcdBarrier b; b.bar = bar; b.x = xb_xcc_id(); b.st = st;
    if (threadIdx.x == 0) (void)xb_add(&bar[XB_XCNT(b.x)], 1u);
    return b;
}
__device__ __forceinline__ void xcd_barrier_complete(unsigned* bar, unsigned x, unsigned& nloc, unsigned& nx) {
    const unsigned G = gridDim.x * gridDim.y * gridDim.z;
    unsigned sum, cnt, mine, sp = 0u;
    for (;;) {
        sum = 0u; cnt = 0u; mine = 0u;
#pragma unroll
        for (unsigned j = 0; j < 16; ++j) { const unsigned c = xb_ld(&bar[XB_XCNT(j)]); sum += c; cnt += (c > 0u) ? 1u : 0u; mine = (j == x) ? c : mine; }
        if (sum == G) break;
        __builtin_amdgcn_s_sleep(1);
        if ((++sp & 255u) == 0u) { if (xb_ld(&bar[XB_TMO])) break; if (sp > XB_SPIN_CAP) { atomicAdd(&bar[XB_TMO], 1u); break; } }
    }
    nloc = mine > 0u ? mine : 1u; nx = cnt > 0u ? cnt : 1u;
}

__device__ __forceinline__ void xcd_barrier(const XcdBarrier& b) {
    asm volatile("s_waitcnt vmcnt(0)" ::: "memory");
    __syncthreads();
    if (threadIdx.x == 0) {
        unsigned* bar = b.bar;
        __builtin_amdgcn_s_waitcnt(0);
        unsigned nloc = b.st[0], nx = b.st[1];
        if (nloc == 0u) { xcd_barrier_complete(bar, b.x, nloc, nx); b.st[0] = nloc; b.st[1] = nx; }
        const unsigned old = xb_add(&bar[XB_XSUB(b.x)], 1u);
        const unsigned gen = old / nloc;
        if (old + 1u == (gen + 1u) * nloc) {
            __builtin_amdgcn_fence(__ATOMIC_RELEASE, "agent");
            asm volatile("s_waitcnt vmcnt(0)" ::: "memory");
            const unsigned og = xb_add(&bar[XB_TOP], 1u);
            const unsigned tg = og / nx;
            if (og + 1u == (tg + 1u) * nx) xb_add(&bar[XB_TOPGEN], 1u);
            else XB_SPIN(xb_ld(&bar[XB_TOPGEN]) == tg, bar);
            __builtin_amdgcn_fence(__ATOMIC_ACQUIRE, "agent");
            xb_add(&bar[XB_XGEN(b.x)], 1u);
            asm volatile("s_waitcnt vmcnt(0)" ::: "memory");
        } else {
            XB_SPIN(xb_ld(&bar[XB_XGEN(b.x)]) == gen, bar);
            __builtin_amdgcn_fence(__ATOMIC_ACQUIRE, "agent");
            asm volatile("s_waitcnt vmcnt(0)" ::: "memory");
        }
    }
    __syncthreads();
}


template <int ph>
DEVI void run_phase(const P& p, char* smem) {
  const int half = threadIdx.x >> 8, tid = threadIdx.x & 255;
  const int vb = blockIdx.x * 2 + half, nvb = gridDim.x * 2;
  char* hl = smem + half * 32768;
  const int lane = threadIdx.x & 63;
  const int gw = blockIdx.x * 8 + (threadIdx.x >> 6), nw = gridDim.x * 8;
  char* ws = p.ws;
  (void)hl; (void)lane; (void)gw; (void)nw; (void)vb; (void)nvb; (void)tid;
  {
    constexpr int layer = (ph >= 10) ? 1 : 0;
    switch (ph) {
    case 0: {
      float* tl = (float*)smem;
      if (blockIdx.x == 0 && threadIdx.x < 32) ((int*)(ws + CNT))[threadIdx.x] = 0;
      econv(p.x, (u16*)(ws + XB0), (size_t)T * 1024);
      econv(p.p, (u16*)(ws + PB), (size_t)T * 256);
      tconv(p.fox_w_in, 0, 3088, 1024, 3072, 1, (u16*)(ws + W0_QKV), 0, 0, tl);
      {
        const int gt = blockIdx.x * 512 + threadIdx.x;
        if (gt < 16384) { const int n = gt >> 10, k = gt & 1023; ((u16*)(ws + W0_QKV))[(size_t)(3072 + n) * 1024 + k] = f2bf(p.fox_w_in[(size_t)k * 3088 + 3072 + n]); }
      }
      tconv(p.fox_w_out, 0, 1024, 1024, 1024, 1, (u16*)(ws + W0_OUT), 0, 0, tl);
      tconv(p.w_gate, 1024 * 512, 512, 1024, 512, 16, (u16*)(ws + W0_GU), 1024 * 1024, 1, tl);
      tconv(p.w_up, 1024 * 512, 512, 1024, 512, 16, (u16*)(ws + W0_GU), 1024 * 1024, 2, tl);
      tconv(p.w_down, 512 * 1024, 1024, 512, 1024, 16, (u16*)(ws + W0_D), 1024 * 512, 0, tl);
      tconv(p.ple_gate, 0, 1024, 1024, 1024, 1, (u16*)(ws + W0_PG), 0, 0, tl);
      tconv(p.ple_proj, 0, 1024, 256, 1024, 1, (u16*)(ws + W0_PP), 0, 0, tl);
    } break;
    case 1: {
      const u16* xb = (const u16*)(ws + XB0); const u16* w = (const u16*)(ws + W0_QKV);
      u16* qkv = (u16*)(ws + QKV0); float* logf_ = (float*)(ws + LOGF);
      run_tiles(128 * 25, vb, nvb, [&](int tile, bool valid) {
        const int mt = tile / 25, ntile = tile % 25;
        GemmLoad L; set_seg1(L, xb + (size_t)mt * 128 * 1024, 1024, w + (size_t)ntile * 128 * 1024, 1024, valid ? 32 : 0, tid);
        gemm_tile(L, 32, hl, tid, [&](f32x4 (&acc)[4][4], int wr, int wc, int fr, int fq) {
          if (!valid) return;
          if (ntile < 24) {
#pragma unroll
            for (int m = 0; m < 4; ++m)
#pragma unroll
              for (int n = 0; n < 4; ++n)
#pragma unroll
                for (int j = 0; j < 4; ++j) {
                  const int row = mt * 128 + wr * 64 + m * 16 + fq * 4 + j, col = ntile * 128 + wc * 64 + n * 16 + fr;
                  qkv[(size_t)row * 3072 + col] = f2bf(acc[m][n][j]);
                }
          } else if (wc == 0) {
            const float bf_ = p.fox_b_f[fr];
#pragma unroll
            for (int m = 0; m < 4; ++m)
#pragma unroll
              for (int j = 0; j < 4; ++j) {
                const int row = mt * 128 + wr * 64 + m * 16 + fq * 4 + j;
                logf_[row * 16 + fr] = logsig(acc[m][0][j] + bf_);
              }
          }
        });
      });
    } break;
    case 2: {
      const float* logf_ = (const float*)(ws + LOGF); float* c8 = (float*)(ws + C8);
      for (int bh = gw; bh < 64; bh += nw) {
        const int b = bh >> 4, h = bh & 15;
        const float* src = logf_ + (size_t)(b * SEQ + lane * 64) * 16 + h;
        float s = 0.f;
        for (int i = 0; i < 64; ++i) s += src[i * 16];
        float incl = s;
#pragma unroll
        for (int o = 1; o < 64; o <<= 1) { const float t2 = __shfl_up(incl, o); if (lane >= o) incl += t2; }
        float run = incl - s;
        float* dst = c8 + (size_t)bh * SEQ + lane * 64;
        for (int i = 0; i < 64; ++i) { run += src[i * 16]; dst[i] = 8.f * run; }
      }
    } break;
    case 3: {
      const u16* qkv = (const u16*)(ws + QKV0); const float* c8 = (const float*)(ws + C8); u16* O = (u16*)(ws + O0);
      for (int item = blockIdx.x; item < 512; item += gridDim.x) {
        const int x = item & 7, kk = item >> 3, bh = x + 8 * (kk >> 3), j = kk & 7;
        fa::attn_unit(bh >> 4, bh & 15, j, qkv, qkv + 1024, qkv + 2048, O, c8 + (size_t)bh * SEQ, smem);
        fa::attn_unit(bh >> 4, bh & 15, fa::NQB - 1 - j, qkv, qkv + 1024, qkv + 2048, O, c8 + (size_t)bh * SEQ, smem);
      }
    } break;
    case 4: case 17: {
      const u16* A = (const u16*)(ws + (layer ? O1 : O0)); const u16* W = (const u16*)(ws + (layer ? WROUT : W0_OUT));
      const int K = layer ? 2048 : 1024;
      const float* xres = layer ? p.out : p.x; float* vr = (float*)(ws + (layer ? VR1 : VR0));
      run_tiles(128 * 8, vb, nvb, [&](int tile, bool valid) {
        const int mt = tile >> 3, ntile = tile & 7;
        GemmLoad L; set_seg1(L, A + (size_t)mt * 128 * K, K, W + (size_t)ntile * 128 * K, K, valid ? K / 32 : 0, tid);
        gemm_tile(L, K / 32, hl, tid, [&](f32x4 (&acc)[4][4], int wr, int wc, int fr, int fq) {
          if (!valid) return;
#pragma unroll
          for (int m = 0; m < 4; ++m)
#pragma unroll
            for (int n = 0; n < 4; ++n)
#pragma unroll
              for (int j = 0; j < 4; ++j) {
                const size_t idx = (size_t)(mt * 128 + wr * 64 + m * 16 + fq * 4 + j) * 1024 + ntile * 128 + wc * 64 + n * 16 + fr;
                vr[idx] = ALPHA * xres[idx] + acc[m][n][j];
              }
        });
      });
      const u16* pb = (const u16*)(ws + PB); const u16* wpp = (const u16*)(ws + (layer ? W1_PP : W0_PP)); float* pp = (float*)(ws + (layer ? PP1 : PP0));
      run_tiles(128 * 8, vb, nvb, [&](int tile, bool valid) {
        const int mt = tile >> 3, ntile = tile & 7;
        GemmLoad L; set_seg1(L, pb + (size_t)mt * 128 * 256, 256, wpp + (size_t)ntile * 128 * 256, 256, valid ? 8 : 0, tid);
        gemm_tile(L, 8, hl, tid, [&](f32x4 (&acc)[4][4], int wr, int wc, int fr, int fq) {
          if (!valid) return;
#pragma unroll
          for (int m = 0; m < 4; ++m)
#pragma unroll
            for (int n = 0; n < 4; ++n)
#pragma unroll
              for (int j = 0; j < 4; ++j) {
                const size_t idx = (size_t)(mt * 128 + wr * 64 + m * 16 + fq * 4 + j) * 1024 + ntile * 128 + wc * 64 + n * 16 + fr;
                pp[idx] = acc[m][n][j];
              }
        });
      });
    } break;
    case 5: case 18: {
      float* vr = (float*)(ws + (layer ? VR1 : VR0)); u16* x1b = (u16*)(ws + (layer ? X1B1 : X1B0));
      const float* g = p.ln1_g + layer * 1024; const float* bb = p.ln1_b + layer * 1024;
      const float* wg = p.w_group + (size_t)layer * 1024 * 4; const float* wrt = p.w_router + (size_t)layer * 1024 * 16;
      const float* bg = p.b_group + layer * 4; const float* br = p.b_router + layer * 16;
      int* cnt = (int*)(ws + CNT) + layer * 16; int* lists = (int*)(ws + LISTS); float* tokw = (float*)(ws + TOKW);
      for (int tok = gw; tok < T; tok += nw) {
        float* row = vr + (size_t)tok * 1024;
        float4 v[4];
#pragma unroll
        for (int i = 0; i < 4; ++i) v[i] = *reinterpret_cast<const float4*>(row + i * 256 + lane * 4);
        float s = 0.f;
#pragma unroll
        for (int i = 0; i < 4; ++i) s += v[i].x + v[i].y + v[i].z + v[i].w;
        const float mu = wsum(s) * (1.f / 1024.f);
        float sq = 0.f;
#pragma unroll
        for (int i = 0; i < 4; ++i) { v[i].x -= mu; v[i].y -= mu; v[i].z -= mu; v[i].w -= mu; sq += v[i].x * v[i].x + v[i].y * v[i].y + v[i].z * v[i].z + v[i].w * v[i].w; }
        const float rstd = rsqrtf(wsum(sq) * (1.f / 1024.f) + LN_EPS);
        float lg[20];
#pragma unroll
        for (int o = 0; o < 20; ++o) lg[o] = 0.f;
#pragma unroll
        for (int i = 0; i < 4; ++i) {
          const int c0 = i * 256 + lane * 4;
          const float4 gg = *reinterpret_cast<const float4*>(g + c0), be = *reinterpret_cast<const float4*>(bb + c0);
          v[i].x = v[i].x * rstd * gg.x + be.x; v[i].y = v[i].y * rstd * gg.y + be.y; v[i].z = v[i].z * rstd * gg.z + be.z; v[i].w = v[i].w * rstd * gg.w + be.w;
          *reinterpret_cast<float4*>(row + c0) = v[i];
          *reinterpret_cast<uint2*>(x1b + (size_t)tok * 1024 + c0) = make_uint2(pack2(v[i].x, v[i].y), pack2(v[i].z, v[i].w));
          const float xe[4] = {v[i].x, v[i].y, v[i].z, v[i].w};
#pragma unroll
          for (int e = 0; e < 4; ++e) {
            const float4 w4 = *reinterpret_cast<const float4*>(wg + (size_t)(c0 + e) * 4);
            lg[0] += xe[e] * w4.x; lg[1] += xe[e] * w4.y; lg[2] += xe[e] * w4.z; lg[3] += xe[e] * w4.w;
#pragma unroll
            for (int q4 = 0; q4 < 4; ++q4) {
              const float4 r4 = *reinterpret_cast<const float4*>(wrt + (size_t)(c0 + e) * 16 + q4 * 4);
              lg[4 + q4 * 4 + 0] += xe[e] * r4.x; lg[4 + q4 * 4 + 1] += xe[e] * r4.y; lg[4 + q4 * 4 + 2] += xe[e] * r4.z; lg[4 + q4 * 4 + 3] += xe[e] * r4.w;
            }
          }
        }
#pragma unroll
        for (int o = 0; o < 20; ++o) lg[o] = wsum(lg[o]);
        if (lane == 0) {
          float gl[4];
#pragma unroll
          for (int i = 0; i < 4; ++i) gl[i] = lg[i] + bg[i];
          int gi = 0; float gm = gl[0];
#pragma unroll
          for (int i = 1; i < 4; ++i) if (gl[i] > gm) { gm = gl[i]; gi = i; }
          float gs = 0.f;
#pragma unroll
          for (int i = 0; i < 4; ++i) gs += __expf(gl[i] - gm);
          const float gval = 1.f / gs;
          float el[4];
#pragma unroll
          for (int i = 0; i < 4; ++i) {
            float t0 = lg[4 + i] + br[i], t1 = lg[8 + i] + br[4 + i], t2 = lg[12 + i] + br[8 + i], t3 = lg[16 + i] + br[12 + i];
            el[i] = gi == 0 ? t0 : (gi == 1 ? t1 : (gi == 2 ? t2 : t3));
          }
          int i0 = 0; float m0 = el[0];
#pragma unroll
          for (int i = 1; i < 4; ++i) if (el[i] > m0) { m0 = el[i]; i0 = i; }
          int i1 = -1; float m1 = -INFINITY;
#pragma unroll
          for (int i = 0; i < 4; ++i) if (i != i0 && el[i] > m1) { m1 = el[i]; i1 = i; }
          const float e1 = __expf(m1 - m0); const float w0 = gval / (1.f + e1), w1 = gval * e1 / (1.f + e1);
          const int ex0 = gi * 4 + i0, ex1 = gi * 4 + i1;
          const int s0 = atomicAdd(&cnt[ex0], 1); lists[ex0 * T + s0] = tok * 2;
          const int s1 = atomicAdd(&cnt[ex1], 1); lists[ex1 * T + s1] = tok * 2 + 1;
          tokw[tok * 2] = w0; tokw[tok * 2 + 1] = w1;
        }
      }
    } break;
    case 6: case 19: {
      const u16* x1b = (const u16*)(ws + (layer ? X1B1 : X1B0)); const u16* wgu = (const u16*)(ws + (layer ? W1_GU : W0_GU));
      u16* hb = (u16*)(ws + (layer ? HBUF1 : HBUF0));
      const int* cnt = (const int*)(ws + CNT) + layer * 16; const int* lists = (const int*)(ws + LISTS);
      const int ntiles = moe_ntiles(cnt, 8);
      run_tiles(ntiles, vb, nvb, [&](int tile, bool valid) {
        int e, mt, ntile, base, ce; moe_tile(cnt, tile, 8, e, mt, ntile, base, ce);
        if (ce == 0) valid = false;
        GemmLoad L; const int r = tid >> 2, kc = (tid & 3) * 8;
        int s0 = mt * 128 + r, s1 = s0 + 64; if (s0 >= ce) s0 = ce > 0 ? ce - 1 : 0; if (s1 >= ce) s1 = ce > 0 ? ce - 1 : 0;
        const int t0 = valid ? (lists[e * T + s0] >> 1) : 0, t1 = valid ? (lists[e * T + s1] >> 1) : 0;
        L.a0 = x1b + (size_t)t0 * 1024 + kc; L.a1 = x1b + (size_t)t1 * 1024 + kc;
        const u16* B = wgu + (size_t)e * 1024 * 1024 + (size_t)ntile * 128 * 1024;
        L.b0 = B + (size_t)r * 1024 + kc; L.b1 = B + (size_t)(r + 64) * 1024 + kc;
        L.c0 = L.a0; L.c1 = L.a1; L.d0 = L.b0; L.d1 = L.b1; L.nt1 = valid ? 32 : 0; L.nt2 = 0;
        gemm_tile(L, 32, hl, tid, [&](f32x4 (&acc)[4][4], int wr, int wc, int fr, int fq) {
          if (!valid) return;
#pragma unroll
          for (int m = 0; m < 4; ++m)
#pragma unroll
            for (int j = 0; j < 4; ++j) {
              const int slot = mt * 128 + wr * 64 + m * 16 + fq * 4 + j;
              if (slot < ce) {
#pragma unroll
                for (int n = 0; n < 2; ++n) {
                  const float hv = siluf(acc[m][n][j]) * acc[m][n + 2][j];
                  hb[(size_t)(base + slot) * 512 + ntile * 64 + wc * 32 + n * 16 + fr] = f2bf(hv);
                }
              }
            }
        });
      });
    } break;
    case 7: case 20: {
      const u16* hb = (const u16*)(ws + (layer ? HBUF1 : HBUF0)); const u16* wd = (const u16*)(ws + (layer ? W1_D : W0_D));
      u16* yb = (u16*)(ws + (layer ? YBUF1 : YBUF0));
      const int* cnt = (const int*)(ws + CNT) + layer * 16; const int* lists = (const int*)(ws + LISTS); const float* tokw = (const float*)(ws + TOKW);
      const int ntiles = moe_ntiles(cnt, 8);
      run_tiles(ntiles, vb, nvb, [&](int tile, bool valid) {
        int e, mt, ntile, base, ce; moe_tile(cnt, tile, 8, e, mt, ntile, base, ce);
        if (ce == 0) valid = false;
        GemmLoad L; const int r = tid >> 2, kc = (tid & 3) * 8;
        int s0 = mt * 128 + r, s1 = s0 + 64; if (s0 >= ce) s0 = ce > 0 ? ce - 1 : 0; if (s1 >= ce) s1 = ce > 0 ? ce - 1 : 0;
        L.a0 = hb + (size_t)(base + s0) * 512 + kc; L.a1 = hb + (size_t)(base + s1) * 512 + kc;
        const u16* B = wd + (size_t)e * 1024 * 512 + (size_t)ntile * 128 * 512;
        L.b0 = B + (size_t)r * 512 + kc; L.b1 = B + (size_t)(r + 64) * 512 + kc;
        L.c0 = L.a0; L.c1 = L.a1; L.d0 = L.b0; L.d1 = L.b1; L.nt1 = valid ? 16 : 0; L.nt2 = 0;
        gemm_tile(L, 16, hl, tid, [&](f32x4 (&acc)[4][4], int wr, int wc, int fr, int fq) {
          if (!valid) return;
#pragma unroll
          for (int m = 0; m < 4; ++m)
#pragma unroll
            for (int j = 0; j < 4; ++j) {
              const int slot = mt * 128 + wr * 64 + m * 16 + fq * 4 + j;
              if (slot < ce) {
                const int tk = lists[e * T + slot]; const float wgt = tokw[tk];
#pragma unroll
                for (int n = 0; n < 4; ++n) yb[(size_t)tk * 1024 + ntile * 128 + wc * 64 + n * 16 + fr] = f2bf(wgt * acc[m][n][j]);
              }
            }
        });
      });
    } break;
    case 8: case 21: {
      float* vr = (float*)(ws + (layer ? VR1 : VR0)); const u16* yb = (const u16*)(ws + (layer ? YBUF1 : YBUF0)); u16* x2b = (u16*)(ws + (layer ? X2B1 : X2B0));
      const float* g = p.ln2_g + layer * 1024; const float* bb = p.ln2_b + layer * 1024;
      for (int tok = gw; tok < T; tok += nw) {
        float* row = vr + (size_t)tok * 1024;
        float4 v[4];
#pragma unroll
        for (int i = 0; i < 4; ++i) {
          const int c0 = i * 256 + lane * 4;
          const float4 xv = *reinterpret_cast<const float4*>(row + c0);
          const uint2 ya = *reinterpret_cast<const uint2*>(yb + (size_t)(tok * 2) * 1024 + c0), yc = *reinterpret_cast<const uint2*>(yb + (size_t)(tok * 2 + 1) * 1024 + c0);
          v[i].x = ALPHA * xv.x + (__uint_as_float(ya.x << 16) + __uint_as_float(yc.x << 16));
          v[i].y = ALPHA * xv.y + (__uint_as_float(ya.x & 0xffff0000u) + __uint_as_float(yc.x & 0xffff0000u));
          v[i].z = ALPHA * xv.z + (__uint_as_float(ya.y << 16) + __uint_as_float(yc.y << 16));
          v[i].w = ALPHA * xv.w + (__uint_as_float(ya.y & 0xffff0000u) + __uint_as_float(yc.y & 0xffff0000u));
        }
        float s = 0.f;
#pragma unroll
        for (int i = 0; i < 4; ++i) s += v[i].x + v[i].y + v[i].z + v[i].w;
        const float mu = wsum(s) * (1.f / 1024.f);
        float sq = 0.f;
#pragma unroll
        for (int i = 0; i < 4; ++i) { v[i].x -= mu; v[i].y -= mu; v[i].z -= mu; v[i].w -= mu; sq += v[i].x * v[i].x + v[i].y * v[i].y + v[i].z * v[i].z + v[i].w * v[i].w; }
        const float rstd = rsqrtf(wsum(sq) * (1.f / 1024.f) + LN_EPS);
#pragma unroll
        for (int i = 0; i < 4; ++i) {
          const int c0 = i * 256 + lane * 4;
          const float4 gg = *reinterpret_cast<const float4*>(g + c0), be = *reinterpret_cast<const float4*>(bb + c0);
          v[i].x = v[i].x * rstd * gg.x + be.x; v[i].y = v[i].y * rstd * gg.y + be.y; v[i].z = v[i].z * rstd * gg.z + be.z; v[i].w = v[i].w * rstd * gg.w + be.w;
          *reinterpret_cast<float4*>(row + c0) = v[i];
          *reinterpret_cast<uint2*>(x2b + (size_t)tok * 1024 + c0) = make_uint2(pack2(v[i].x, v[i].y), pack2(v[i].z, v[i].w));
        }
      }
    } break;
    case 9: case 22: {
      const u16* A = (const u16*)(ws + (layer ? X2B1 : X2B0)); const u16* W = (const u16*)(ws + (layer ? W1_PG : W0_PG));
      const float* x2 = (const float*)(ws + (layer ? VR1 : VR0)); const float* pp = (const float*)(ws + (layer ? PP1 : PP0));
      const float* bgate = p.ple_b + layer * 1024; u16* x3b = (u16*)(ws + X3B); float* outp = p.out;
      run_tiles(128 * 8, vb, nvb, [&](int tile, bool valid) {
        const int mt = tile >> 3, ntile = tile & 7;
        GemmLoad L; set_seg1(L, A + (size_t)mt * 128 * 1024, 1024, W + (size_t)ntile * 128 * 1024, 1024, valid ? 32 : 0, tid);
        gemm_tile(L, 32, hl, tid, [&](f32x4 (&acc)[4][4], int wr, int wc, int fr, int fq) {
          if (!valid) return;
#pragma unroll
          for (int n = 0; n < 4; ++n) {
            const int col = ntile * 128 + wc * 64 + n * 16 + fr; const float bv = bgate[col];
#pragma unroll
            for (int m = 0; m < 4; ++m)
#pragma unroll
              for (int j = 0; j < 4; ++j) {
                const size_t idx = (size_t)(mt * 128 + wr * 64 + m * 16 + fq * 4 + j) * 1024 + col;
                const float gt = 1.f / (1.f + __expf(-(acc[m][n][j] + bv)));
                const float r = x2[idx] + gt * pp[idx];
                outp[idx] = r;
                if (layer == 0) x3b[idx] = f2bf(r);
              }
          }
        });
      });
    } break;
    case 10: {
      float* tl = (float*)smem;
      tconv(p.ret_w_in, 0, 6144, 1024, 2048, 1, (u16*)(ws + WRIN), 0, 3, tl);
      tconv(p.ret_w_in + 2048, 0, 6144, 1024, 4096, 1, (u16*)(ws + WRIN) + (size_t)2048 * 1024, 0, 0, tl);
      tconv(p.ret_w_out, 0, 1024, 2048, 1024, 1, (u16*)(ws + WROUT), 0, 0, tl);
      econv(p.p + (size_t)T * 256, (u16*)(ws + PB), (size_t)T * 256);
      float2* cs = (float2*)(ws + CS);
      const size_t gt = (size_t)blockIdx.x * 512 + threadIdx.x, gn = (size_t)gridDim.x * 512;
      for (size_t i = gt; i < (size_t)T * 128; i += gn) {
        const int tok = (int)(i >> 7), f = (int)(i & 127);
        const float invf = powf(10000.f, -(float)(2 * f) / 256.f);
        const float ang = (float)p.pos[tok] * invf;
        const double rev = (double)ang * 0.15915494309189535;
        const float fr_ = (float)(rev - rint(rev));
        cs[i] = make_float2(__builtin_amdgcn_cosf(fr_), __builtin_amdgcn_sinf(fr_));
      }
    } break;
    case 11: {
      const u16* A = (const u16*)(ws + X3B); const u16* W = (const u16*)(ws + WRIN);
      u16* q1 = (u16*)(ws + Q1); u16* k1 = (u16*)(ws + K1); u16* ktd = (u16*)(ws + KTD); u16* vt = (u16*)(ws + VT);
      const float2* cs = (const float2*)(ws + CS);
      run_tiles(128 * 32, vb, nvb, [&](int tile, bool valid) {
        const int mt = tile >> 5, ntile = tile & 31;
        GemmLoad L; set_seg1(L, A + (size_t)mt * 128 * 1024, 1024, W + (size_t)ntile * 128 * 1024, 1024, valid ? 32 : 0, tid);
        gemm_tile(L, 32, hl, tid, [&](f32x4 (&acc)[4][4], int wr, int wc, int fr, int fq) {
          if (!valid) return;
          if (ntile < 16) {
            const int isk = ntile >> 3, hh = (ntile & 7) >> 1, th = ntile & 1;
            const float lg2 = gamma_log2(hh);
#pragma unroll
            for (int m = 0; m < 4; ++m)
#pragma unroll
              for (int j = 0; j < 4; ++j) {
                const int tok = mt * 128 + wr * 64 + m * 16 + fq * 4 + j;
                const float kdec = exp2f((float)(255 - (tok & 255)) * lg2) * 0.0625f;
#pragma unroll
                for (int n = 0; n < 2; ++n) {
                  const int i = th * 64 + wc * 32 + n * 16 + fr;
                  const float2 c = cs[(size_t)tok * 128 + i];
                  const float x1 = acc[m][n][j], x2 = acc[m][n + 2][j];
                  const float r1 = x1 * c.x - x2 * c.y, r2 = x2 * c.x + x1 * c.y;
                  if (!isk) { q1[(size_t)tok * 1024 + hh * 256 + i] = f2bf(r1); q1[(size_t)tok * 1024 + hh * 256 + 128 + i] = f2bf(r2); }
                  else {
                    k1[(size_t)tok * 1024 + hh * 256 + i] = f2bf(r1 * 0.0625f); k1[(size_t)tok * 1024 + hh * 256 + 128 + i] = f2bf(r2 * 0.0625f);
                    ktd[(size_t)(hh * 256 + i) * T + tok] = f2bf(r1 * kdec); ktd[(size_t)(hh * 256 + 128 + i) * T + tok] = f2bf(r2 * kdec);
                  }
                }
              }
          } else {
            const int c0 = (ntile - 16) * 128;
#pragma unroll
            for (int m = 0; m < 4; ++m)
#pragma unroll
              for (int n = 0; n < 4; ++n) {
                const int tok = mt * 128 + wr * 64 + m * 16 + fq * 4, col = c0 + wc * 64 + n * 16 + fr;
                *reinterpret_cast<uint2*>(vt + (size_t)col * T + tok) = make_uint2(pack2(acc[m][n][0], acc[m][n][1]), pack2(acc[m][n][2], acc[m][n][3]));
              }
          }
        });
      });
    } break;
    case 12: {
      const u16* q1 = (const u16*)(ws + Q1); const u16* k1 = (const u16*)(ws + K1); const u16* ktd = (const u16*)(ws + KTD); const u16* vt = (const u16*)(ws + VT);
      u16* kv = (u16*)(ws + KV); u16* sp = (u16*)(ws + SP);
      run_tiles(256 * 8, vb, nvb, [&](int tile, bool valid) {
        const int item = tile >> 3, mt = (tile >> 1) & 3, ntile = tile & 1; const int b = item >> 6, h = (item >> 4) & 3, c = item & 15;
        const size_t t0 = (size_t)b * SEQ + c * 256;
        GemmLoad L; set_seg1(L, vt + (size_t)(h * 512 + mt * 128) * T + t0, T, ktd + (size_t)(h * 256 + ntile * 128) * T + t0, T, valid ? 8 : 0, tid);
        gemm_tile(L, 8, hl, tid, [&](f32x4 (&acc)[4][4], int wr, int wc, int fr, int fq) {
          if (!valid) return;
#pragma unroll
          for (int m = 0; m < 4; ++m)
#pragma unroll
            for (int n = 0; n < 4; ++n)
#pragma unroll
              for (int j = 0; j < 4; ++j)
                kv[(size_t)item * 131072 + (size_t)(mt * 128 + wr * 64 + m * 16 + fq * 4 + j) * 256 + ntile * 128 + wc * 64 + n * 16 + fr] = f2bf(acc[m][n][j]);
        });
      });
      run_tiles(256 * 3, vb, nvb, [&](int tile, bool valid) {
        const int item = tile / 3, tt = tile % 3; const int mt = tt ? 1 : 0, ntile = tt == 2 ? 1 : 0; const int b = item >> 6, h = (item >> 4) & 3, c = item & 15;
        const size_t t0 = (size_t)b * SEQ + c * 256;
        GemmLoad L; set_seg1(L, q1 + (t0 + mt * 128) * 1024 + h * 256, 1024, k1 + (t0 + ntile * 128) * 1024 + h * 256, 1024, valid ? 8 : 0, tid);
        const float lg2 = gamma_log2(h);
        gemm_tile(L, 8, hl, tid, [&](f32x4 (&acc)[4][4], int wr, int wc, int fr, int fq) {
          if (!valid) return;
#pragma unroll
          for (int n = 0; n < 4; ++n) {
            const int jj = ntile * 128 + wc * 64 + n * 16 + fr; const float sc = exp2f(-(float)(jj + 1) * lg2);
#pragma unroll
            for (int m = 0; m < 4; ++m)
#pragma unroll
              for (int j = 0; j < 4; ++j) {
                const int ii = mt * 128 + wr * 64 + m * 16 + fq * 4 + j;
                sp[(size_t)item * 65536 + (size_t)ii * 256 + jj] = f2bf(jj <= ii ? acc[m][n][j] * sc : 0.f);
              }
          }
        });
      });
    } break;
    case 13: {
      u16* kv = (u16*)(ws + KV);
      const size_t gt = (size_t)blockIdx.x * 512 + threadIdx.x, gn = (size_t)gridDim.x * 512;
      for (size_t i = gt; i < (size_t)16 * 16384; i += gn) {
        const int bh = (int)(i >> 14); const size_t el = (i & 16383) * 8; const int h = bh & 3;
        const float cd = exp2f(256.f * gamma_log2(h));
        float s[8];
#pragma unroll
        for (int e = 0; e < 8; ++e) s[e] = 0.f;
        for (int c = 0; c < 16; ++c) {
          uint4* ptr = reinterpret_cast<uint4*>(kv + (size_t)(bh * 16 + c) * 131072 + el);
          const uint4 v = *ptr;
          *ptr = make_uint4(pack2(s[0], s[1]), pack2(s[2], s[3]), pack2(s[4], s[5]), pack2(s[6], s[7]));
          s[0] = s[0] * cd + __uint_as_float(v.x << 16); s[1] = s[1] * cd + __uint_as_float(v.x & 0xffff0000u);
          s[2] = s[2] * cd + __uint_as_float(v.y << 16); s[3] = s[3] * cd + __uint_as_float(v.y & 0xffff0000u);
          s[4] = s[4] * cd + __uint_as_float(v.z << 16); s[5] = s[5] * cd + __uint_as_float(v.z & 0xffff0000u);
          s[6] = s[6] * cd + __uint_as_float(v.w << 16); s[7] = s[7] * cd + __uint_as_float(v.w & 0xffff0000u);
        }
      }
    } break;
    case 14: {
      const u16* q1 = (const u16*)(ws + Q1); const u16* vt = (const u16*)(ws + VT); const u16* kv = (const u16*)(ws + KV); const u16* sp = (const u16*)(ws + SP);
      u16* o1 = (u16*)(ws + O1);
      run_tiles(256 * 8, vb, nvb, [&](int tile, bool valid) {
        const int item = tile >> 3, mt = (tile >> 2) & 1, ntile = tile & 3; const int b = item >> 6, h = (item >> 4) & 3, c = item & 15;
        const size_t t0 = (size_t)b * SEQ + c * 256;
        GemmLoad L; set_seg1(L, sp + (size_t)item * 65536 + (size_t)mt * 128 * 256, 256, vt + (size_t)(h * 512 + ntile * 128) * T + t0, T, valid ? 4 * (mt + 1) : 0, tid);
        { const int r = tid >> 2, kc = (tid & 3) * 8;
          const u16* A2 = q1 + (t0 + mt * 128) * 1024 + h * 256; const u16* B2 = kv + (size_t)item * 131072 + (size_t)ntile * 128 * 256;
          L.c0 = A2 + (size_t)r * 1024 + kc; L.c1 = A2 + (size_t)(r + 64) * 1024 + kc; L.d0 = B2 + (size_t)r * 256 + kc; L.d1 = B2 + (size_t)(r + 64) * 256 + kc; L.nt2 = valid ? 8 : 0; }
        const float lg2 = gamma_log2(h);
        gemm_tile(L, 16, hl, tid, [&](f32x4 (&acc)[4][4], int wr, int wc, int fr, int fq) {
          if (!valid) return;
#pragma unroll
          for (int m = 0; m < 4; ++m)
#pragma unroll
            for (int j = 0; j < 4; ++j) {
              const int ii = mt * 128 + wr * 64 + m * 16 + fq * 4 + j; const float sc = exp2f((float)(ii + 1) * lg2);
#pragma unroll
              for (int n = 0; n < 4; ++n) o1[(t0 + ii) * 2048 + h * 512 + ntile * 128 + wc * 64 + n * 16 + fr] = f2bf(acc[m][n][j] * sc);
            }
        });
      });
    } break;
    case 15: {
      const u16* o1 = (const u16*)(ws + O1); float2* st = (float2*)(ws + GNST);
      for (int it = gw; it < T * 4; it += nw) {
        const uint4 v = *reinterpret_cast<const uint4*>(o1 + (size_t)it * 512 + lane * 8);
        float f[8] = {__uint_as_float(v.x << 16), __uint_as_float(v.x & 0xffff0000u), __uint_as_float(v.y << 16), __uint_as_float(v.y & 0xffff0000u),
                      __uint_as_float(v.z << 16), __uint_as_float(v.z & 0xffff0000u), __uint_as_float(v.w << 16), __uint_as_float(v.w & 0xffff0000u)};
        float s = 0.f;
#pragma unroll
        for (int e = 0; e < 8; ++e) s += f[e];
        const float mu = wsum(s) * (1.f / 512.f);
        float sq = 0.f;
#pragma unroll
        for (int e = 0; e < 8; ++e) { const float d = f[e] - mu; sq += d * d; }
        const float rstd = rsqrtf(wsum(sq) * (1.f / 512.f) + LN_EPS);
        if (lane == 0) st[it] = make_float2(mu, rstd);
      }
      float* tl = (float*)smem;
      const size_t lo = (size_t)16 * 1024 * 512;
      tconv(p.w_gate + lo, 1024 * 512, 512, 1024, 512, 16, (u16*)(ws + W1_GU), 1024 * 1024, 1, tl);
      tconv(p.w_up + lo, 1024 * 512, 512, 1024, 512, 16, (u16*)(ws + W1_GU), 1024 * 1024, 2, tl);
      tconv(p.w_down + lo, 512 * 1024, 1024, 512, 1024, 16, (u16*)(ws + W1_D), 1024 * 512, 0, tl);
      tconv(p.ple_gate + (size_t)1024 * 1024, 0, 1024, 1024, 1024, 1, (u16*)(ws + W1_PG), 0, 0, tl);
      tconv(p.ple_proj + (size_t)256 * 1024, 0, 1024, 256, 1024, 1, (u16*)(ws + W1_PP), 0, 0, tl);
    } break;
    case 16: {
      const u16* A = (const u16*)(ws + X3B); const u16* W = (const u16*)(ws + WRIN) + (size_t)4096 * 1024;
      u16* o1 = (u16*)(ws + O1); const float2* st = (const float2*)(ws + GNST);
      run_tiles(128 * 16, vb, nvb, [&](int tile, bool valid) {
        const int mt = tile >> 4, ntile = tile & 15;
        GemmLoad L; set_seg1(L, A + (size_t)mt * 128 * 1024, 1024, W + (size_t)ntile * 128 * 1024, 1024, valid ? 32 : 0, tid);
        gemm_tile(L, 32, hl, tid, [&](f32x4 (&acc)[4][4], int wr, int wc, int fr, int fq) {
          if (!valid) return;
          const int hh = ntile >> 2;
#pragma unroll
          for (int m = 0; m < 4; ++m)
#pragma unroll
            for (int j = 0; j < 4; ++j) {
              const int tok = mt * 128 + wr * 64 + m * 16 + fq * 4 + j; const float2 ms = st[tok * 4 + hh];
#pragma unroll
              for (int n = 0; n < 4; ++n) {
                const size_t idx = (size_t)tok * 2048 + ntile * 128 + wc * 64 + n * 16 + fr;
                o1[idx] = f2bf(siluf(acc[m][n][j]) * ((bf2f(o1[idx]) - ms.x) * ms.y));
              }
            }
        });
      });
    } break;
    default: break;
    }
  }
}

#ifndef DBL
#define DBL 0u
#endif
#define GSYNC() xcd_barrier(xb)
#define PHASE(n) if (ph0 <= n && n < ph1) { run_phase<n>(p, smem); if ((DBL >> n) & 1u) { GSYNC(); run_phase<n>(p, smem); } if (n + 1 < ph1) GSYNC(); }
__global__ void __launch_bounds__(512) mega(P p, int ph0, int ph1) {
  extern __shared__ __attribute__((aligned(16))) char smem[];
  cg::grid_group grid = cg::this_grid();
  if (ph0 < 0) grid.sync();
  volatile LAS unsigned* xst = (volatile LAS unsigned*)(smem + LDS_BYTES - 16);
  if (threadIdx.x == 0) { xst[0] = 0u; xst[1] = 0u; }
  __syncthreads();
  XcdBarrier xb = xcd_barrier_post((unsigned*)(p.ws + BARW), xst);
  PHASE(0) PHASE(1) PHASE(2) PHASE(3) PHASE(4) PHASE(5) PHASE(6) PHASE(7) PHASE(8) PHASE(9) PHASE(10) PHASE(11)
  PHASE(12) PHASE(13) PHASE(14) PHASE(15) PHASE(16) PHASE(17) PHASE(18) PHASE(19) PHASE(20) PHASE(21) PHASE(22)
}

extern "C" void kernel_launch(void* const* d_in, const int* in_sizes, int n_in, void* d_out, int out_size, void* d_ws, size_t ws_size, hipStream_t stream) {
  static int grid_blocks = 0;
  if (!grid_blocks) {
    int dev = 0, cus = 0, per_cu = 0;
    hipGetDevice(&dev);
    hipDeviceGetAttribute(&cus, hipDeviceAttributeMultiprocessorCount, dev);
    hipFuncSetAttribute((const void*)mega, hipFuncAttributeMaxDynamicSharedMemorySize, LDS_BYTES);
    hipOccupancyMaxActiveBlocksPerMultiprocessor(&per_cu, (const void*)mega, 512, LDS_BYTES);
    if (per_cu < 1) { fprintf(stderr, "occupancy query returned %d\n", per_cu); per_cu = 1; }
    grid_blocks = cus * 1;
    if (ws_size < 345 * MiB) fprintf(stderr, "workspace too small: %zu\n", ws_size);
  }
  P p{};
  p.x = (const float*)d_in[0]; p.p = (const float*)d_in[1]; p.pos = (const int*)d_in[2];
  p.fox_w_in = (const float*)d_in[3]; p.fox_b_f = (const float*)d_in[4]; p.fox_w_out = (const float*)d_in[5];
  p.ret_w_in = (const float*)d_in[6]; p.ret_w_out = (const float*)d_in[7];
  p.ln1_g = (const float*)d_in[8]; p.ln1_b = (const float*)d_in[9]; p.ln2_g = (const float*)d_in[10]; p.ln2_b = (const float*)d_in[11];
  p.w_group = (const float*)d_in[12]; p.b_group = (const float*)d_in[13]; p.w_router = (const float*)d_in[14]; p.b_router = (const float*)d_in[15];
  p.w_gate = (const float*)d_in[16]; p.w_up = (const float*)d_in[17]; p.w_down = (const float*)d_in[18];
  p.ple_proj = (const float*)d_in[19]; p.ple_gate = (const float*)d_in[20]; p.ple_b = (const float*)d_in[21];
  p.out = (float*)d_out; p.ws = (char*)d_ws;
#if MEGA
  hipMemsetAsync((char*)d_ws + BARW, 0, XCD_BAR_WORDS * 4, stream);
  int ph0 = 0, ph1 = NPH;
  void* args[] = {&p, &ph0, &ph1};
  hipError_t e = hipLaunchCooperativeKernel((const void*)mega, dim3(grid_blocks), dim3(512), args, LDS_BYTES, stream);
  if (e != hipSuccess) fprintf(stderr, "cooperative launch failed: %s (grid %d)\n", hipGetErrorString(e), grid_blocks);
#else
  for (int ph = 0; ph < NPH; ++ph) hipLaunchKernelGGL(mega, dim3(grid_blocks), dim3(512), LDS_BYTES, stream, p, ph, ph + 1);
#endif
}
```

```cpp
#include <hip/hip_runtime.h>
#include <hip/hip_cooperative_groups.h>
#include <cstdio>
#include <cstdint>
namespace cg = cooperative_groups;

#ifndef MEGA
#define MEGA 1
#endif

typedef unsigned short u16;
using bf16x8 = __attribute__((ext_vector_type(8))) short;
using f32x4 = __attribute__((ext_vector_type(4))) float;
#define DEVI __device__ __forceinline__

constexpr int T = 16384, SEQ = 4096;
constexpr size_t MiB = 1ull << 20;
constexpr float ALPHA = 1.4142135623730951f;
constexpr float LN_EPS = 1e-5f;
constexpr int NPH = 23;
constexpr int LDS_BYTES = 131072 + 16;

constexpr size_t W0_QKV = 0, W0_OUT = 7 * MiB, W0_GU = 9 * MiB, W0_D = 41 * MiB, W0_PG = 57 * MiB, W0_PP = 59 * MiB;
constexpr size_t QKV0 = 60 * MiB, X1B0 = 156 * MiB, YBUF0 = 60 * MiB, HBUF0 = 124 * MiB, X2B0 = 156 * MiB;
constexpr size_t VR0 = 156 * MiB, PP0 = 220 * MiB, XB0 = 284 * MiB, O0 = 284 * MiB, X3B = 284 * MiB;
constexpr size_t PB = 316 * MiB, CS = 324 * MiB, LOGF = 340 * MiB, C8 = 341 * MiB, LISTS = 342 * MiB, TOKW = 343 * MiB;
constexpr size_t GNST = 343 * MiB + 512 * 1024, CNT = 344 * MiB, BARW = 344 * MiB + 4096, SLOTMAP = 343 * MiB + 256 * 1024;
constexpr size_t WRIN = 0, WROUT = 12 * MiB, Q1 = 16 * MiB, K1 = 48 * MiB, KTD = 80 * MiB, VT = 112 * MiB, O1 = 48 * MiB;
constexpr size_t KV = 176 * MiB, SP = 240 * MiB, W1_GU = 176 * MiB, W1_D = 208 * MiB, W1_PG = 224 * MiB, W1_PP = 226 * MiB;
constexpr size_t VR1 = 112 * MiB, PP1 = 240 * MiB, X1B1 = 112 * MiB, HBUF1 = 80 * MiB, YBUF1 = 0, X2B1 = 112 * MiB;

struct P {
  const float *x, *p; const int* pos;
  const float *fox_w_in, *fox_b_f, *fox_w_out, *ret_w_in, *ret_w_out, *ln1_g, *ln1_b, *ln2_g, *ln2_b;
  const float *w_group, *b_group, *w_router, *b_router, *w_gate, *w_up, *w_down, *ple_proj, *ple_gate, *ple_b;
  float* out; char* ws;
};

DEVI float bf2f(u16 b) { return __uint_as_float(((unsigned)b) << 16); }
DEVI u16 f2bf(float f) { unsigned u = __float_as_uint(f); u += 0x7FFFu + ((u >> 16) & 1u); return (u16)(u >> 16); }
DEVI unsigned pack2(float a, float b) { return (unsigned)f2bf(a) | ((unsigned)f2bf(b) << 16); }
DEVI float wsum(float v) {
#pragma unroll
  for (int o = 32; o >= 1; o >>= 1) v += __shfl_xor(v, o);
  return v;
}
DEVI float siluf(float v) { return v / (1.f + __expf(-v)); }
DEVI float logsig(float z) { return fminf(z, 0.f) - log1pf(__expf(-fabsf(z))); }

struct GemmLoad {
  const u16 *A, *B, *A2, *B2;
  unsigned ao[4], bo[4], ao2[4], bo2[4];
  int nt1, nt2;
};
DEVI void glds16(const u16* g, char* l) {
  __builtin_amdgcn_global_load_lds((const __attribute__((address_space(1))) void*)g, (__attribute__((address_space(3))) void*)l, 16, 0, 0);
}
DEVI int ld_kc(int tid) { return ((tid & 7) ^ ((tid >> 4) & 7)) * 8; }
template <class Epi>
DEVI void gemm_tile(const GemmLoad& L, int nt_max, char* lds, int tid, Epi&& epi) {
  const int wid = tid >> 6, lane = tid & 63, wr = wid >> 1, wc = wid & 1, fr = lane & 15, fq = lane >> 4;
  f32x4 acc[4][4];
#pragma unroll
  for (int m = 0; m < 4; ++m)
#pragma unroll
    for (int n = 0; n < 4; ++n) acc[m][n] = f32x4{0.f, 0.f, 0.f, 0.f};
  const int nt = L.nt1 + L.nt2;
  auto stage = [&](int t, int buf) {
    char* sa = lds + buf * 32768 + tid * 16; char* sb = sa + 16384;
    const bool s1 = t < L.nt1; const int tt = s1 ? t : t - L.nt1;
    const u16* Ab = s1 ? L.A : L.A2; const u16* Bb = s1 ? L.B : L.B2;
#pragma unroll
    for (int i = 0; i < 4; ++i) {
      const unsigned oa = s1 ? L.ao[i] : L.ao2[i], ob = s1 ? L.bo[i] : L.bo2[i];
      glds16(Ab + oa + tt * 64, sa + i * 4096); glds16(Bb + ob + tt * 64, sb + i * 4096);
    }
  };
  const int sw = fr >> 1;
  if (nt > 0) stage(0, 0);
  for (int t = 0; t < nt_max; ++t) {
    asm volatile("s_waitcnt vmcnt(0)" ::: "memory");
    __syncthreads();
    if (t + 1 < nt) stage(t + 1, (t + 1) & 1);
    if (t < nt) {
      const char* sa = lds + (t & 1) * 32768 + (wr * 64 + fr) * 128; const char* sb = lds + (t & 1) * 32768 + 16384 + (wc * 64 + fr) * 128;
#pragma unroll
      for (int kk = 0; kk < 2; ++kk) {
        const int co = ((fq + 4 * kk) ^ sw) * 16;
        bf16x8 af[4], bfv[4];
#pragma unroll
        for (int m = 0; m < 4; ++m) af[m] = *reinterpret_cast<const bf16x8*>(sa + m * 2048 + co);
#pragma unroll
        for (int n = 0; n < 4; ++n) bfv[n] = *reinterpret_cast<const bf16x8*>(sb + n * 2048 + co);
#pragma unroll
        for (int m = 0; m < 4; ++m)
#pragma unroll
          for (int n = 0; n < 4; ++n) acc[m][n] = __builtin_amdgcn_mfma_f32_16x16x32_bf16(bfv[n], af[m], acc[m][n], 0, 0, 0);
      }
    }
  }
  __syncthreads();
  epi(acc, wr, wc, fr, fq);
}
template <class TF>
DEVI void run_tiles(int ntiles, int vb, int nvb, TF&& f) {
  const int niter = (ntiles + nvb - 1) / nvb;
  for (int it = 0; it < niter; ++it) { const int tile = it * nvb + vb; const bool valid = tile < ntiles; f(valid ? tile : 0, valid); }
}
DEVI void set_seg1(GemmLoad& L, const u16* A, size_t lda, const u16* B, size_t ldb, int nt, int tid) {
  const int r = tid >> 3, kc = ld_kc(tid);
  L.A = A; L.B = B; L.A2 = A; L.B2 = B;
#pragma unroll
  for (int i = 0; i < 4; ++i) { L.ao[i] = (unsigned)((r + 32 * i) * lda + kc); L.bo[i] = (unsigned)((r + 32 * i) * ldb + kc); L.ao2[i] = L.ao[i]; L.bo2[i] = L.bo[i]; }
  L.nt1 = nt; L.nt2 = 0;
}
DEVI void set_seg2(GemmLoad& L, const u16* A, size_t lda, const u16* B, size_t ldb, int nt, int tid) {
  const int r = tid >> 3, kc = ld_kc(tid);
  L.A2 = A; L.B2 = B;
#pragma unroll
  for (int i = 0; i < 4; ++i) { L.ao2[i] = (unsigned)((r + 32 * i) * lda + kc); L.bo2[i] = (unsigned)((r + 32 * i) * ldb + kc); }
  L.nt2 = nt;
}
DEVI uint2 pk4(const f32x4& a) { unsigned lo, hi; asm("v_cvt_pk_bf16_f32 %0, %1, %2" : "=v"(lo) : "v"(a[0]), "v"(a[1])); asm("v_cvt_pk_bf16_f32 %0, %1, %2" : "=v"(hi) : "v"(a[2]), "v"(a[3])); return make_uint2(lo, hi); }

DEVI int rowmap(int mode, int n) {
  if (mode == 0) return n;
  if (mode == 1 || mode == 2) return (n >> 7) * 256 + (mode == 2 ? 128 : 0) + (n & 127);
  const int hh = n >> 8, ip = n & 255, comp = ip >> 7, i = ip & 127, th = i >> 6, w = i & 63, wc = w >> 5, rr = w & 31;
  return hh * 256 + th * 128 + wc * 64 + comp * 32 + rr;
}
DEVI void tconv(const float* __restrict__ src, size_t sbs, int ldsrc, int K, int N, int nbatch, u16* __restrict__ dst, size_t dbs, int mode, float* tl) {
  const int tid = threadIdx.x; const int tk = K >> 6, tn = N >> 8; const int per = tk * tn, nt = per * nbatch;
  const int ty = tid >> 6, tx = tid & 63;
  float r[8][4];
  auto ldtile = [&](int tile) {
    const int b = tile / per, tt = tile % per; const int k0 = (tt / tn) << 6, n0 = (tt % tn) << 8;
    const float* s = src + (size_t)b * sbs;
#pragma unroll
    for (int rr = 0; rr < 8; ++rr)
#pragma unroll
      for (int c = 0; c < 4; ++c) r[rr][c] = s[(size_t)(k0 + ty * 8 + rr) * ldsrc + n0 + c * 64 + tx];
  };
  int tile = blockIdx.x;
  if (tile < nt) ldtile(tile);
  for (; tile < nt; tile += gridDim.x) {
    const int b = tile / per, tt = tile % per; const int k0 = (tt / tn) << 6, n0 = (tt % tn) << 8;
    u16* d = dst + (size_t)b * dbs;
#pragma unroll
    for (int rr = 0; rr < 8; ++rr)
#pragma unroll
      for (int c = 0; c < 4; ++c) tl[(ty * 8 + rr) * 257 + c * 64 + tx] = r[rr][c];
    __syncthreads();
    if (tile + (int)gridDim.x < nt) ldtile(tile + (int)gridDim.x);
    { const int n = tid >> 1, kh = (tid & 1) * 32;
      const int nr = rowmap(mode, n0 + n);
#pragma unroll
      for (int q = 0; q < 4; ++q) {
        const int kb = kh + q * 8;
        const unsigned w0 = pack2(tl[(kb + 0) * 257 + n], tl[(kb + 1) * 257 + n]);
        const unsigned w1 = pack2(tl[(kb + 2) * 257 + n], tl[(kb + 3) * 257 + n]);
        const unsigned w2 = pack2(tl[(kb + 4) * 257 + n], tl[(kb + 5) * 257 + n]);
        const unsigned w3 = pack2(tl[(kb + 6) * 257 + n], tl[(kb + 7) * 257 + n]);
        *reinterpret_cast<uint4*>(d + (size_t)nr * K + k0 + kb) = make_uint4(w0, w1, w2, w3);
      } }
    __syncthreads();
  }
}
DEVI void econv(const float* __restrict__ src, u16* __restrict__ dst, size_t n) {
  const size_t gt = (size_t)blockIdx.x * 512 + threadIdx.x, gn = (size_t)gridDim.x * 512;
  for (size_t i = gt * 4; i < n; i += gn * 16) {
    float4 v[4];
#pragma unroll
    for (int u = 0; u < 4; ++u) { const size_t j = i + (size_t)u * gn * 4; v[u] = j < n ? *reinterpret_cast<const float4*>(src + j) : make_float4(0.f, 0.f, 0.f, 0.f); }
#pragma unroll
    for (int u = 0; u < 4; ++u) { const size_t j = i + (size_t)u * gn * 4; if (j < n) *reinterpret_cast<uint2*>(dst + j) = make_uint2(pack2(v[u].x, v[u].y), pack2(v[u].z, v[u].w)); }
  }
}


DEVI f32x4 bflo4(uint2 v) { return f32x4{__uint_as_float(v.x << 16), __uint_as_float(v.x & 0xffff0000u), __uint_as_float(v.y << 16), __uint_as_float(v.y & 0xffff0000u)}; }
DEVI float gamma_log2(int h) { return log2f(1.0f - exp2f(-5.0f - (float)h)); }

DEVI int moe_ntiles(const int* cnt, int ntn) { int s = 0; for (int i = 0; i < 16; ++i) s += ((cnt[i] + 127) >> 7) * ntn; return s; }
DEVI int moe_rem_ntiles(const int* cnt, int ntn) { int s = 0; for (int i = 0; i < 16; ++i) s += (((cnt[i] & 255) + 127) >> 7) * ntn; return s; }
DEVI void moe_rem_tile(const int* cnt, int tile, int ntn, int& e, int& mt, int& nt, int& base, int& ce) {
  int at = 0, b = 0; e = 0; mt = 0; nt = 0; base = 0; ce = 0;
  for (int i = 0; i < 16; ++i) {
    const int c = cnt[i]; const int tl = (((c & 255) + 127) >> 7) * ntn;
    if (tile >= at && tile < at + tl) { const int r = tile - at; e = i; mt = r / ntn; nt = r % ntn; base = b; ce = c; }
    at += tl; b += c;
  }
}
DEVI void moe_tile(const int* cnt, int tile, int ntn, int& e, int& mt, int& nt, int& base, int& ce) {
  int at = 0, b = 0; e = 0; mt = 0; nt = 0; base = 0; ce = 0;
  for (int i = 0; i < 16; ++i) {
    const int c = cnt[i]; const int tl = ((c + 127) >> 7) * ntn;
    if (tile >= at && tile < at + tl) { const int r = tile - at; e = i; mt = r / ntn; nt = r % ntn; base = b; ce = c; }
    at += tl; b += c;
  }
}


namespace fa {
using s16x4 = __attribute__((ext_vector_type(4))) short;
using f32x16 = __attribute__((ext_vector_type(16))) float;
using u32x4 = __attribute__((ext_vector_type(4))) unsigned;
constexpr int D = 64, DMQ = 3072, DMO = 1024, NW = 8, QBLK = 32, QB = 256, KVBLK = 64, NQB = SEQ / QB, THR = 64;
constexpr float C2 = 0.125f * 1.4426950408889634f;
constexpr int SLOTB = 8192, LDS_K = 0, LDS_V = 3 * SLOTB, LDS_WS = 6 * SLOTB, LDS_OST = LDS_WS + NW * 256, LDS_C8 = LDS_OST + NW * 4096, LDS_TOTAL = LDS_C8 + 16384;
#define SBAR() __builtin_amdgcn_sched_barrier(0)
#define PIN(x) asm volatile("" : "+v"(x))
#define MFMA(a, b, c) __builtin_amdgcn_mfma_f32_32x32x16_bf16(a, b, c, 0, 0, 0)
#define WAIT_BAR(N) asm volatile("s_waitcnt vmcnt(" #N ") lgkmcnt(0)\n\ts_barrier" ::: "memory")
DEVI int crow(int r, int hi) { return (r & 3) + 8 * (r >> 2) + 4 * hi; }
DEVI unsigned cvtpk(float lo, float hi) { unsigned r; asm("v_cvt_pk_bf16_f32 %0, %1, %2" : "=v"(r) : "v"(lo), "v"(hi)); return r; }
DEVI void glds16a(const void* g, unsigned lds_base) {
  unsigned sv; asm volatile("s_mov_b32 %0, m0\n\ts_mov_b32 m0, %2\n\ts_nop 0\n\tglobal_load_lds_dwordx4 %1, off\n\ts_mov_b32 m0, %0" : "=&s"(sv) : "v"(g), "s"(lds_base) : "memory"); }
typedef __attribute__((address_space(3))) const char* lds_cptr;
typedef short v4i16_t __attribute__((ext_vector_type(4)));
DEVI void kload2(bf16x8* kf, lds_cptr kp, int d0) { kf[2 * d0] = *(const __attribute__((address_space(3))) bf16x8*)(kp + d0 * 2048); kf[2 * d0 + 1] = *(const __attribute__((address_space(3))) bf16x8*)(kp + d0 * 2048 + 512); }
DEVI s16x4 vtr(lds_cptr p) { return __builtin_bit_cast(s16x4, __builtin_amdgcn_ds_read_tr16_b64_v4i16((__attribute__((address_space(3))) v4i16_t*)p)); }
#define MX3(a, b, c) __builtin_fmaxf(__builtin_fmaxf((a), (b)), (c))
DEVI float rowmax(const f32x16& p0, const f32x16& p1) {
  float a = MX3(p0[0], p0[1], p1[0]), b = MX3(p0[2], p0[3], p1[1]); a = MX3(a, p1[2], p1[3]);
#pragma unroll
  for (int r = 4; r < 16; r += 4) { a = MX3(a, p0[r], p0[r + 1]); b = MX3(b, p0[r + 2], p0[r + 3]); a = MX3(a, p1[r], p1[r + 1]); b = MX3(b, p1[r + 2], p1[r + 3]); }
  float m = __builtin_fmaxf(a, b); auto rr = __builtin_amdgcn_permlane32_swap(__float_as_uint(m), __float_as_uint(m), false, false);
  return __builtin_fmaxf(__uint_as_float(rr[0]), __uint_as_float(rr[1])); }
DEVI void cmask(f32x16& p0, f32x16& p1, int jb, int qrel, int hi) {
  const int kb = 64 * jb + 4 * hi;
#pragma unroll
  for (int r = 0; r < 16; ++r) { const int kv = kb + (r & 3) + 8 * (r >> 2); if (kv > qrel) p0[r] = -INFINITY; if (kv + 32 > qrel) p1[r] = -INFINITY; } }

DEVI void attn_unit(int b, int h, int qb, const u16* Q, const u16* __restrict__ K, const u16* __restrict__ V, u16* O, const float* __restrict__ c8g, char* lds) {
  int tid = threadIdx.x; asm volatile("" : "+v"(tid));
  const int lane = tid & 63, r32 = lane & 31, hi = lane >> 5; const int wid = __builtin_amdgcn_readfirstlane(tid >> 6);
  const long rowbase = (long)b * SEQ; const int q0 = qb * QB, NT = (q0 + QB) / KVBLK;
  const u16* Qw = Q + (rowbase + q0 + wid * QBLK) * DMQ + h * D;
  const unsigned lds0 = (unsigned)(uintptr_t)lds; float* wsf = (float*)(lds + LDS_WS) + wid * 64;
  { const int nv = (q0 + QB) >> 2; float4* dstc = (float4*)(lds + LDS_C8); const float4* srcc = (const float4*)c8g;
    for (int i = tid; i < nv; i += 512) dstc[i] = srcc[i]; }
  const float cq8 = c8g[q0 + wid * QBLK + r32];
  const lds_cptr c8p = (lds_cptr)lds + LDS_C8 + 16 * hi;
  const u16* ksrc = K + rowbase * DMQ + h * D + (long)lane * DMQ + wid * 8;
  const u16* vsrc = V + rowbase * DMQ + h * D + (long)(16 * (wid & 3) + (lane >> 2)) * DMQ + (wid >> 2) * 32 + (lane & 3) * 8;
  const unsigned kdst = lds0 + LDS_K + wid * 1024, vdst = lds0 + LDS_V + wid * 1024;
#define DMA_K(t, slot) glds16a(ksrc + (long)(t) * KVBLK * DMQ, (unsigned)__builtin_amdgcn_readfirstlane(kdst + (slot)))
#define DMA_V(t, slot) glds16a(vsrc + (long)(t) * KVBLK * DMQ, (unsigned)__builtin_amdgcn_readfirstlane(vdst + (slot)))
  const lds_cptr vp0 = (lds_cptr)lds + LDS_V + ((lane >> 4) & 1) * 32 + (lane & 3) * 8 + (4 * hi + ((lane & 15) >> 2)) * 64;
  const lds_cptr kp0 = (lds_cptr)lds + LDS_K + hi * 1024 + r32 * 16;
  DMA_K(0, 0); DMA_V(0, 0); DMA_K(1, SLOTB);
  bf16x8 qr[4];
#pragma unroll
  for (int d0 = 0; d0 < 4; ++d0) qr[d0] = *reinterpret_cast<const bf16x8*>(&Qw[(long)r32 * DMQ + d0 * 16 + hi * 8]);
  float mhat = 0.f, l_reg = 0.f; f32x16 o[2]; o[0] = f32x16{}; o[1] = f32x16{};
  const int qrel = wid * QBLK + r32; bool resc = false;
  f32x16 pA0, pA1, pB0, pB1; bf16x8 kf[8]; s16x4 vlo[8], vhi[8]; u32x4 pw0, pw1, pw2, pw3;
  int sl_prev = 0, sl_cur = 0, sl_next = SLOTB;
#define ROT() do { sl_prev = sl_cur; sl_cur = sl_next; sl_next = (sl_next == 2 * SLOTB) ? 0 : sl_next + SLOTB; } while (0)
#define EX(v) __builtin_amdgcn_exp2f(__builtin_fmaf((v), C2, nmh))
#define RESC() do { if (resc) { _Pragma("unroll") for (int d_ = 0; d_ < 2; ++d_) _Pragma("unroll") for (int r = 0; r < 16; ++r) o[d_][r] *= wsf[crow(r, hi)]; } } while (0)
#define BIAS(C0, C1, t) do { const lds_cptr cb_ = c8p + (t) * 256; \
    _Pragma("unroll") for (int g_ = 0; g_ < 4; ++g_) { \
      const f32x4 u_ = *(const __attribute__((address_space(3))) f32x4*)(cb_ + g_ * 32); \
      const f32x4 w_ = *(const __attribute__((address_space(3))) f32x4*)(cb_ + 128 + g_ * 32); \
      C0[4 * g_ + 0] = cq8 - u_[0]; C0[4 * g_ + 1] = cq8 - u_[1]; C0[4 * g_ + 2] = cq8 - u_[2]; C0[4 * g_ + 3] = cq8 - u_[3]; \
      C1[4 * g_ + 0] = cq8 - w_[0]; C1[4 * g_ + 1] = cq8 - w_[1]; C1[4 * g_ + 2] = cq8 - w_[2]; C1[4 * g_ + 3] = cq8 - w_[3]; } } while (0)
  DMA_K(2, 2 * SLOTB);
  WAIT_BAR(3);
  _Pragma("unroll") for (int d0 = 0; d0 < 4; ++d0) kload2(kf, kp0, d0);
  BIAS(pA0, pA1, 0);
  pA0 = MFMA(kf[0], qr[0], pA0); pA1 = MFMA(kf[1], qr[0], pA1); pA0 = MFMA(kf[2], qr[1], pA0); pA1 = MFMA(kf[3], qr[1], pA1);
  pA0 = MFMA(kf[4], qr[2], pA0); pA1 = MFMA(kf[5], qr[2], pA1); pA0 = MFMA(kf[6], qr[3], pA0); pA1 = MFMA(kf[7], qr[3], pA1);
  if (NT == 4) cmask(pA0, pA1, 0, qrel, hi);
  { const float rm = rowmax(pA0, pA1); mhat = rm * C2; const float nmh = -mhat;
#pragma unroll
    for (int r = 0; r < 16; ++r) { pA0[r] = EX(pA0[r]); pA1[r] = EX(pA1[r]); } }
  WAIT_BAR(0);
  DMA_K(3, 0); DMA_V(1, SLOTB); ROT();
  _Pragma("unroll") for (int d0 = 0; d0 < 4; ++d0) kload2(kf, kp0 + sl_cur, d0);
  WAIT_BAR(2);
#define PKW(P, i) cvtpk(P[i], P[i + 1])
#define PAF(k) __builtin_bit_cast(bf16x8, pw##k)
#define VFR(i) (bf16x8){vlo[i][0], vlo[i][1], vlo[i][2], vlo[i][3], vhi[i][0], vhi[i][1], vhi[i][2], vhi[i][3]}
#define VRD(i) do { vlo[i] = vtr(vp_ + (((i) >> 2) * 4096 + ((i) & 3) * 1024)); vhi[i] = vtr(vp_ + (((i) >> 2) * 4096 + ((i) & 3) * 1024 + 512)); } while (0)
#define KRD(G, d0) do { if (G) { kload2(kf, kp0 + sl_next, d0); SBAR(); } } while (0)
#define GAPA(MF, a0, a1, a2, a3, W0, W1, PW) do { MF; sacc += a0; sacc += a1; sacc += a2; sacc += a3; W0; W1; PIN(PW); PIN(sacc); SBAR(); } while (0)
#define GAPB(MF, X, i) do { MF; X[i] = EX(X[i]); X[i + 1] = EX(X[i + 1]); X[i + 2] = EX(X[i + 2]); X[i + 3] = EX(X[i + 3]); PIN(X); SBAR(); } while (0)
#define GAPBQ(MF, X, i, Q, G, tn, k) do { MF; X[i] = EX(X[i]); X[i + 1] = EX(X[i + 1]); X[i + 2] = EX(X[i + 2]); X[i + 3] = EX(X[i + 3]); \
    if (G) { const f32x4 u_ = *(const __attribute__((address_space(3))) f32x4*)(c8p + (tn) * 256 + ((k) >> 2) * 128 + ((k) & 3) * 32); \
      Q[4 * ((k) & 3) + 0] = cq8 - u_[0]; Q[4 * ((k) & 3) + 1] = cq8 - u_[1]; Q[4 * ((k) & 3) + 2] = cq8 - u_[2]; Q[4 * ((k) & 3) + 3] = cq8 - u_[3]; } \
    PIN(X); PIN(Q); SBAR(); } while (0)
#define STEP(C0, C1, P0, P1, t, MASK, GK, GV, GL) do { SBAR(); \
    const lds_cptr vp_ = vp0 + sl_prev; \
    VRD(0); SBAR(); float sacc = P0[0] + P0[1]; \
                    GAPA(C0 = MFMA(kf[0], qr[0], C0), P0[2], P0[3], P0[4], P0[5],     pw0[0] = PKW(P0, 0),  pw0[1] = PKW(P0, 2),  pw0); \
    VRD(4); SBAR(); GAPA(C1 = MFMA(kf[1], qr[0], C1), P0[6], P0[7], P0[8], P0[9],     pw0[2] = PKW(P0, 4),  pw0[3] = PKW(P0, 6),  pw0); \
    VRD(1); SBAR(); GAPA(C0 = MFMA(kf[2], qr[1], C0),    P0[10], P0[11], P0[12], P0[13], pw1[0] = PKW(P0, 8),  pw1[1] = PKW(P0, 10), pw1); \
    VRD(5); SBAR(); GAPA(C1 = MFMA(kf[3], qr[1], C1),    P0[14], P0[15], P1[0], P1[1],   pw1[2] = PKW(P0, 12), pw1[3] = PKW(P0, 14), pw1); \
    VRD(2); SBAR(); GAPA(C0 = MFMA(kf[4], qr[2], C0),    P1[2], P1[3], P1[4], P1[5],     pw2[0] = PKW(P1, 0),  pw2[1] = PKW(P1, 2),  pw2); \
    VRD(6); SBAR(); GAPA(C1 = MFMA(kf[5], qr[2], C1),    P1[6], P1[7], P1[8], P1[9],     pw2[2] = PKW(P1, 4),  pw2[3] = PKW(P1, 6),  pw2); \
    VRD(3); SBAR(); GAPA(C0 = MFMA(kf[6], qr[3], C0),    P1[10], P1[11], P1[12], P1[13], pw3[0] = PKW(P1, 8),  pw3[1] = PKW(P1, 10), pw3); \
    VRD(7); SBAR(); GAPA(C1 = MFMA(kf[7], qr[3], C1),    P1[14], P1[15], 0.f, 0.f,       pw3[2] = PKW(P1, 12), pw3[3] = PKW(P1, 14), pw3); \
    l_reg += sacc; \
    if (GK) DMA_K((t) + 3, sl_cur); if (GV) DMA_V((t) + 1, sl_next); \
    if (MASK) cmask(C0, C1, (t) - (NT - 4), qrel, hi); \
    { const float rm = __builtin_fmaf(rowmax(C0, C1), C2, -mhat); resc = false; \
      if (__builtin_expect(__any(rm > (float)THR), 0)) { const float dl = __builtin_fmaxf(rm, 0.f); mhat += dl; \
          const float f = __builtin_amdgcn_exp2f(-dl); l_reg *= f; if (hi == 0) wsf[r32] = f; resc = true; } } \
    const float nmh = -mhat; SBAR(); \
    GAPBQ(o[0] = MFMA(PAF(0), VFR(0), o[0]), C0, 0, P0, GL, (t) + 1, 0);              GAPBQ(o[1] = MFMA(PAF(0), VFR(4), o[1]), C0, 4, P0, GL, (t) + 1, 1); \
    KRD(GL, 0); GAPBQ(o[0] = MFMA(PAF(1), VFR(1), o[0]), C0, 8, P0, GL, (t) + 1, 2);  KRD(GL, 1); GAPBQ(o[1] = MFMA(PAF(1), VFR(5), o[1]), C0, 12, P0, GL, (t) + 1, 3); \
    KRD(GL, 2); GAPBQ(o[0] = MFMA(PAF(2), VFR(2), o[0]), C1, 0, P1, GL, (t) + 1, 4);  KRD(GL, 3); GAPBQ(o[1] = MFMA(PAF(2), VFR(6), o[1]), C1, 4, P1, GL, (t) + 1, 5); \
    GAPBQ(o[0] = MFMA(PAF(3), VFR(3), o[0]), C1, 8, P1, GL, (t) + 1, 6);              GAPBQ(o[1] = MFMA(PAF(3), VFR(7), o[1]), C1, 12, P1, GL, (t) + 1, 7); \
    } while (0)
  BIAS(pB0, pB1, 1);
  int t = 1;
  for (; t + 5 < NT; t += 2) {
    STEP(pB0, pB1, pA0, pA1, t, false, true, true, true);     WAIT_BAR(2); RESC(); ROT();
    STEP(pA0, pA1, pB0, pB1, t + 1, false, true, true, true); WAIT_BAR(2); RESC(); ROT();
  }
#define ENDW(tt) do { if ((tt) + 3 < NT) { WAIT_BAR(2); } else if ((tt) + 2 < NT) { WAIT_BAR(1); } else { WAIT_BAR(0); } } while (0)
  for (; t + 1 < NT; t += 2) {
    STEP(pB0, pB1, pA0, pA1, t, true, (t + 3 < NT), (t + 1 < NT), (t + 1 < NT));         ENDW(t);     RESC(); ROT();
    STEP(pA0, pA1, pB0, pB1, t + 1, true, (t + 4 < NT), (t + 2 < NT), (t + 2 < NT));     ENDW(t + 1); RESC(); ROT();
  }
  STEP(pB0, pB1, pA0, pA1, NT - 1, true, false, false, false); RESC();
  { float sacc = pB0[0] + pB0[1];
#pragma unroll
    for (int r = 2; r < 16; ++r) sacc += pB0[r];
#pragma unroll
    for (int r = 0; r < 16; ++r) sacc += pB1[r];
    l_reg += sacc;
    pw0 = (u32x4){PKW(pB0, 0), PKW(pB0, 2), PKW(pB0, 4), PKW(pB0, 6)}; pw1 = (u32x4){PKW(pB0, 8), PKW(pB0, 10), PKW(pB0, 12), PKW(pB0, 14)};
    pw2 = (u32x4){PKW(pB1, 0), PKW(pB1, 2), PKW(pB1, 4), PKW(pB1, 6)}; pw3 = (u32x4){PKW(pB1, 8), PKW(pB1, 10), PKW(pB1, 12), PKW(pB1, 14)};
    const lds_cptr vp_ = vp0 + sl_cur; _Pragma("unroll") for (int i = 0; i < 8; ++i) VRD(i);
    o[0] = MFMA(PAF(0), VFR(0), o[0]); o[1] = MFMA(PAF(0), VFR(4), o[1]); o[0] = MFMA(PAF(1), VFR(1), o[0]); o[1] = MFMA(PAF(1), VFR(5), o[1]);
    o[0] = MFMA(PAF(2), VFR(2), o[0]); o[1] = MFMA(PAF(2), VFR(6), o[1]); o[0] = MFMA(PAF(3), VFR(3), o[0]); o[1] = MFMA(PAF(3), VFR(7), o[1]); }
  { auto rr = __builtin_amdgcn_permlane32_swap(__float_as_uint(l_reg), __float_as_uint(l_reg), false, false); l_reg = __uint_as_float(rr[0]) + __uint_as_float(rr[1]); }
  if (hi == 0) wsf[32 + r32] = l_reg; asm volatile("s_waitcnt lgkmcnt(0)" ::: "memory");
  float rli[16];
#pragma unroll
  for (int r = 0; r < 16; ++r) rli[r] = __builtin_amdgcn_rcpf(wsf[32 + crow(r, hi)]);
  u16* Ow = O + (rowbase + q0 + wid * QBLK) * DMO + h * D; u16* stg = (u16*)(lds + LDS_OST) + wid * 2048;
#pragma unroll
  for (int r = 0; r < 16; ++r) { const int orow = crow(r, hi);
#pragma unroll
    for (int d0 = 0; d0 < 2; ++d0) stg[orow * 64 + d0 * 32 + r32] = f2bf(o[d0][r] * rli[r]); }
  asm volatile("s_waitcnt lgkmcnt(0)" ::: "memory");
#pragma unroll
  for (int i = 0; i < 4; ++i) { const int row = i * 8 + (lane >> 3), ch = lane & 7; *(u32x4*)(Ow + (long)row * DMO + ch * 8) = *(const u32x4*)(stg + row * 64 + ch * 8); }
  asm volatile("s_waitcnt lgkmcnt(0)\n\ts_barrier" ::: "memory");
#undef DMA_K
#undef DMA_V
#undef ROT
#undef EX
#undef RESC
#undef BIAS
#undef PKW
#undef PAF
#undef VFR
#undef VRD
#undef KRD
#undef ENDW
#undef GAPA
#undef GAPB
#undef GAPBQ
#undef STEP
}
}

namespace pg8 {
#define PG8_LAS __attribute__((address_space(3)))
typedef unsigned short bf16_t;
typedef short bf16x8 __attribute__((ext_vector_type(8)));
typedef float f32x4 __attribute__((ext_vector_type(4)));
typedef unsigned u32x4 __attribute__((ext_vector_type(4)));
constexpr int BM = 256, BK = 64, HALF = 128, HTB = HALF * BK * 2  , STAGE_BYTES = 8 * HTB, NXCD = 8, WGM = 8;

__host__ __device__ __forceinline__ int lds_byte(int r, int c) { const int st = (r >> 4) * 2 + (c >> 5), rr = r & 15, cc = c & 31, ob = rr * 64 + cc * 2; return st * 1024 + (ob ^ (((ob >> 9) & 1) << 5)); }
__host__ __device__ __forceinline__ void stage_rc(int b, int& R, int& C) { const int st = b / 1024, sb = b % 1024, swz = sb ^ (((sb >> 9) & 1) << 5); R = (st >> 1) * 16 + swz / 64; C = (st & 1) * 32 + (swz % 64) / 2; }
__host__ __device__ __forceinline__ int perm32(int rho) { const int n = rho >> 4, i = rho & 15; return 8 * (i >> 2) + 4 * n + (i & 3); }

struct Unit { int pm, pn; };
struct Gemm { const bf16_t* A; const bf16_t* Bt; int M, N, K; };

struct StaticOrder {
    int nM, nN, nwg, G, c;
    __host__ __device__ void init(int M, int N, int G_, int c_) { nM = M / BM; nN = N / BM; nwg = nM * nN; G = G_; c = c_; }
    __host__ __device__ bool next(int i, Unit& u) const {
        const long L = (long)i * G + c; if (L >= nwg) return false;
        int wgid = (int)L; { const int q = nwg / NXCD, r = nwg % NXCD, xcd = wgid % NXCD, off = wgid / NXCD; wgid = (xcd < r ? xcd * (q + 1) : r * (q + 1) + (xcd - r) * q) + off; }
        const int nig = WGM * nN, gid = wgid / nig, fm = gid * WGM, gsz = (nM - fm) < WGM ? (nM - fm) : WGM;
        u.pm = fm + ((wgid % nig) % gsz); u.pn = (wgid % nig) / gsz; return true;
    }
    __device__ __forceinline__ void a_ready(const Unit&) const {}
    __device__ __forceinline__ void done(const Unit&) const {}
};
__device__ __forceinline__ unsigned cvt_pk_bf16(float lo, float hi) { unsigned r; asm volatile("v_cvt_pk_bf16_f32 %0, %1, %2" : "=v"(r) : "v"(lo), "v"(hi)); return r; }
template <class Epi, class Sched, bool STAMP = false>
__device__ __forceinline__ void gemm_phase(PG8_LAS unsigned char* lds, const Gemm g, const Sched& S, const Epi& E, unsigned long long* stamps) {
    const int tid = threadIdx.x, wid = __builtin_amdgcn_readfirstlane(tid >> 6), lane = tid & 63, wr = wid >> 2, wc = wid & 3, fr = lane & 15, fq = lane >> 4;
    const int K = g.K, nt = K / BK;
    int ts_lo = 0, ts_hi = 0, nts = 0; const unsigned long long rt_entry = STAMP ? (unsigned long long)wall_clock64() : 0ull;
#define PG8_STAMP() do { if (STAMP && wid == 0 && nts < 64) { const unsigned long long _c = (unsigned long long)clock64(); \
        ts_lo = (lane == nts) ? (int)(unsigned)_c : ts_lo; ts_hi = (lane == nts) ? (int)(unsigned)(_c >> 32) : ts_hi; ++nts; } } while (0)
    PG8_STAMP();
    unsigned voffA[2], voffB[2];
#pragma unroll
    for (int i = 0; i < 2; ++i) { int R, C; stage_rc(tid * 16 + i * 8192, R, C); const int Rb = Epi::PERM ? ((R & ~31) + perm32(R & 31)) : R;
        voffA[i] = (unsigned)(R * K + C) * 2u; voffB[i] = (unsigned)(Rb * K + C) * 2u; }
    const size_t kstep = (size_t)(BK * 2);
    const size_t hstep = (size_t)HALF * K * 2;
    const size_t tstep = 2 * hstep;
    const unsigned ldsw = (unsigned)wid * 1024u;
    const int aoff = lds_byte(wr * 64 + fr, fq * 8), boff = lds_byte(wc * 32 + fr, fq * 8);
#define PG8_SA(b, h) (((b) * 2 + (h)) * HTB)
#define PG8_SB(b, h) ((4 + (b) * 2 + (h)) * HTB)
#define PG8_STAGE(bufoff, gbase, voff) do { _Pragma("unroll") for (int _i = 0; _i < 2; ++_i) \
        __builtin_amdgcn_global_load_lds((const unsigned*)((const char*)(gbase) + (voff)[_i]), (PG8_LAS unsigned*)(lds + (bufoff) + ldsw + _i * 8192), 16, 0, 0); } while (0)
#define PG8_LDA(dst, b, h) do { _Pragma("unroll") for (int m = 0; m < 4; ++m) _Pragma("unroll") for (int k = 0; k < 2; ++k) dst[m][k] = *(const PG8_LAS bf16x8*)(lds + PG8_SA(b, h) + aoff + m * 2048 + k * 1024); } while (0)
#define PG8_LDB(dst, b, h) do { _Pragma("unroll") for (int n = 0; n < 2; ++n) _Pragma("unroll") for (int k = 0; k < 2; ++k) dst[n][k] = *(const PG8_LAS bf16x8*)(lds + PG8_SB(b, h) + boff + n * 2048 + k * 1024); } while (0)
#define PG8_MMA(ai, bj, At, Bt) do { __builtin_amdgcn_s_setprio(1); _Pragma("unroll") for (int m = 0; m < 4; ++m) _Pragma("unroll") for (int n = 0; n < 2; ++n) _Pragma("unroll") for (int k = 0; k < 2; ++k) \
        acc[ai][bj][m][n] = __builtin_amdgcn_mfma_f32_16x16x32_bf16(Bt[n][k], At[m][k], acc[ai][bj][m][n], 0, 0, 0); __builtin_amdgcn_s_setprio(0); } while (0)
#define PG8_WAIT_V(n) asm volatile("s_waitcnt vmcnt(" #n ")" ::: "memory")
#define PG8_WAIT_L(n) asm volatile("s_waitcnt lgkmcnt(" #n ")" ::: "memory")
#define PG8_BAR __builtin_amdgcn_s_barrier()
#define PG8_SCHED __builtin_amdgcn_sched_barrier(0)
    Unit cur, nxt; int ui = 0;
    if (!S.next(0, cur)) return;
    f32x4 acc[2][2][4][2];
#pragma unroll
    for (int a = 0; a < 2; ++a)
#pragma unroll
        for (int b = 0; b < 2; ++b)
#pragma unroll
            for (int m = 0; m < 4; ++m)
#pragma unroll
                for (int n = 0; n < 2; ++n) acc[a][b][m][n] = (f32x4){0.f, 0.f, 0.f, 0.f};
    bf16x8 At[4][2], B0[2][2], B1[2][2];
    const char* cA = (const char*)g.A + (size_t)cur.pm * tstep; const char* cB = (const char*)g.Bt + (size_t)cur.pn * tstep;
    S.a_ready(cur);
    PG8_STAGE(PG8_SB(0, 0), cB, voffB); PG8_STAGE(PG8_SA(0, 0), cA, voffA); PG8_STAGE(PG8_SB(0, 1), cB + hstep, voffB); PG8_STAGE(PG8_SA(0, 1), cA + hstep, voffA);
    if (wr == 1) PG8_BAR;
    PG8_WAIT_V(4); PG8_BAR;
    PG8_STAGE(PG8_SB(1, 0), cB + kstep, voffB); PG8_STAGE(PG8_SA(1, 0), cA + kstep, voffA); PG8_STAGE(PG8_SB(1, 1), cB + hstep + kstep, voffB);
    PG8_WAIT_V(6); PG8_BAR;
    PG8_STAMP();
    for (;;) {
        const bool has_next = S.next(ui + 1, nxt);
        const char* nA = has_next ? (const char*)g.A + (size_t)nxt.pm * tstep : cA; const char* nB = has_next ? (const char*)g.Bt + (size_t)nxt.pn * tstep : cB;
        for (int t = 0; t < nt; t += 2) {
            const bool last = (t == nt - 2);
            const char* a1 = cA + (size_t)(t + 1) * kstep;
            const char* a2 = last ? nA : cA + (size_t)(t + 2) * kstep; const char* b2 = last ? nB : cB + (size_t)(t + 2) * kstep;
            const char* a3 = a2 + kstep; const char* b3 = b2 + kstep;
            if (last && has_next) S.a_ready(nxt);
            PG8_LDB(B0, 0, 0); PG8_SCHED; PG8_LDA(At, 0, 0); PG8_STAGE(PG8_SA(1, 1), a1 + hstep, voffA);
            PG8_WAIT_L(8); PG8_BAR; PG8_WAIT_L(0); PG8_MMA(0, 0, At, B0); PG8_BAR; PG8_SCHED;
            PG8_LDB(B1, 0, 1); PG8_STAGE(PG8_SB(0, 0), b2, voffB);
            PG8_BAR; PG8_WAIT_L(0); PG8_MMA(0, 1, At, B1); PG8_BAR;
            PG8_LDA(At, 0, 1); PG8_STAGE(PG8_SA(0, 0), a2, voffA);
            PG8_BAR; PG8_WAIT_L(0); PG8_MMA(1, 0, At, B0); PG8_BAR; PG8_SCHED;
            PG8_STAGE(PG8_SB(0, 1), b2 + hstep, voffB);
            PG8_WAIT_V(6); PG8_BAR; PG8_MMA(1, 1, At, B1); PG8_BAR;
            PG8_LDB(B0, 1, 0); PG8_SCHED; PG8_LDA(At, 1, 0); PG8_STAGE(PG8_SA(0, 1), a2 + hstep, voffA);
            PG8_WAIT_L(8); PG8_BAR; PG8_WAIT_L(0); PG8_MMA(0, 0, At, B0); PG8_BAR; PG8_SCHED;
            PG8_LDB(B1, 1, 1); PG8_STAGE(PG8_SB(1, 0), b3, voffB);
            PG8_BAR; PG8_WAIT_L(0); PG8_MMA(0, 1, At, B1); PG8_BAR;
            PG8_LDA(At, 1, 1); PG8_STAGE(PG8_SA(1, 0), a3, voffA);
            PG8_BAR; PG8_WAIT_L(0); PG8_MMA(1, 0, At, B0); PG8_BAR; PG8_SCHED;
            PG8_STAGE(PG8_SB(1, 1), b3 + hstep, voffB);
            PG8_WAIT_V(6); PG8_BAR; PG8_MMA(1, 1, At, B1); PG8_BAR;
        }
        PG8_STAMP();
        if constexpr (!Epi::AFTER_DRAIN) { E(acc, cur, wr, wc, fr, fq); S.done(cur); }
        PG8_STAMP();
        if (!has_next) break;
#pragma unroll
        for (int a = 0; a < 2; ++a)
#pragma unroll
            for (int b = 0; b < 2; ++b)
#pragma unroll
                for (int m = 0; m < 4; ++m)
#pragma unroll
                    for (int n = 0; n < 2; ++n) acc[a][b][m][n] = (f32x4){0.f, 0.f, 0.f, 0.f};
        cur = nxt; cA = nA; cB = nB; ++ui;
    }
    PG8_WAIT_V(0);
    if (wr == 0) PG8_BAR;
    PG8_BAR;
    if constexpr (Epi::AFTER_DRAIN) { E.fused(acc, cur, wr, wc, fr, fq, lds, wid, lane); S.done(cur); }
    PG8_STAMP();
    if (STAMP && wid == 0) { stamps[lane] = lane < nts ? (((unsigned long long)(unsigned)ts_hi << 32) | (unsigned)ts_lo) : 0ull;
        if (lane == 62) stamps[62] = rt_entry; if (lane == 63) stamps[63] = (unsigned long long)wall_clock64(); }
#undef PG8_STAMP
#undef PG8_SA
#undef PG8_SB
#undef PG8_STAGE
#undef PG8_LDA
#undef PG8_LDB
#undef PG8_MMA
#undef PG8_WAIT_V
#undef PG8_WAIT_L
#undef PG8_BAR
#undef PG8_SCHED
}
}

namespace pg8 {
struct BUnit { long aoff, boff; int id; };
template <bool PERM, int K, int lda, int ldb, class UF, class Epi>
__device__ __forceinline__ void gemm_phase_b(PG8_LAS unsigned char* lds, const bf16_t* Ab, const bf16_t* Bb, const int nunits, const UF& uf, const Epi& E) {
    constexpr bool STAMP = false; unsigned long long* stamps = nullptr; (void)stamps;
    const int Gg = (int)gridDim.x, cc_ = (int)blockIdx.x;
    auto nextu = [&](int i, BUnit& u) -> bool { const long L = (long)i * Gg + cc_; if (L >= nunits) return false; u = uf((int)L); return true; };
    const int tid = threadIdx.x, wid = __builtin_amdgcn_readfirstlane(tid >> 6), lane = tid & 63, wr = wid >> 2, wc = wid & 3, fr = lane & 15, fq = lane >> 4;
    const int nt = K / BK;
    int ts_lo = 0, ts_hi = 0, nts = 0; const unsigned long long rt_entry = STAMP ? (unsigned long long)wall_clock64() : 0ull;
#define PG8_STAMP() do { if (STAMP && wid == 0 && nts < 64) { const unsigned long long _c = (unsigned long long)clock64(); \
        ts_lo = (lane == nts) ? (int)(unsigned)_c : ts_lo; ts_hi = (lane == nts) ? (int)(unsigned)(_c >> 32) : ts_hi; ++nts; } } while (0)
    PG8_STAMP();
    unsigned voffA[2], voffB[2];
#pragma unroll
    for (int i = 0; i < 2; ++i) { int R, C; stage_rc(tid * 16 + i * 8192, R, C); const int Rb = PERM ? ((R & ~31) + perm32(R & 31)) : R;
        voffA[i] = (unsigned)(R * lda + C) * 2u; voffB[i] = (unsigned)(Rb * ldb + C) * 2u; }
    const size_t kstep = (size_t)(BK * 2);
    const size_t hstepA = (size_t)HALF * lda * 2, hstepB = (size_t)HALF * ldb * 2;
    const unsigned ldsw = (unsigned)wid * 1024u;
    const int aoff = lds_byte(wr * 64 + fr, fq * 8), boff = lds_byte(wc * 32 + fr, fq * 8);
#define PG8_SA(b, h) (((b) * 2 + (h)) * HTB)
#define PG8_SB(b, h) ((4 + (b) * 2 + (h)) * HTB)
#define PG8_STAGE(bufoff, gbase, voff) do { _Pragma("unroll") for (int _i = 0; _i < 2; ++_i) \
        __builtin_amdgcn_global_load_lds((const unsigned*)((const char*)(gbase) + (voff)[_i]), (PG8_LAS unsigned*)(lds + (bufoff) + ldsw + _i * 8192), 16, 0, 0); } while (0)
#define PG8_LDA(dst, b, h) do { _Pragma("unroll") for (int m = 0; m < 4; ++m) _Pragma("unroll") for (int k = 0; k < 2; ++k) dst[m][k] = *(const PG8_LAS bf16x8*)(lds + PG8_SA(b, h) + aoff + m * 2048 + k * 1024); } while (0)
#define PG8_LDB(dst, b, h) do { _Pragma("unroll") for (int n = 0; n < 2; ++n) _Pragma("unroll") for (int k = 0; k < 2; ++k) dst[n][k] = *(const PG8_LAS bf16x8*)(lds + PG8_SB(b, h) + boff + n * 2048 + k * 1024); } while (0)
#define PG8_MMA(ai, bj, At, Bt) do { __builtin_amdgcn_s_setprio(1); _Pragma("unroll") for (int m = 0; m < 4; ++m) _Pragma("unroll") for (int n = 0; n < 2; ++n) _Pragma("unroll") for (int k = 0; k < 2; ++k) \
        acc[ai][bj][m][n] = __builtin_amdgcn_mfma_f32_16x16x32_bf16(Bt[n][k], At[m][k], acc[ai][bj][m][n], 0, 0, 0); __builtin_amdgcn_s_setprio(0); } while (0)
#define PG8_WAIT_V(n) asm volatile("s_waitcnt vmcnt(" #n ")" ::: "memory")
#define PG8_WAIT_L(n) asm volatile("s_waitcnt lgkmcnt(" #n ")" ::: "memory")
#define PG8_BAR __builtin_amdgcn_s_barrier()
#define PG8_SCHED __builtin_amdgcn_sched_barrier(0)
    BUnit cur, nxt; int ui = 0;
    if (!nextu(0, cur)) return;
    f32x4 acc[2][2][4][2];
#pragma unroll
    for (int a = 0; a < 2; ++a)
#pragma unroll
        for (int b = 0; b < 2; ++b)
#pragma unroll
            for (int m = 0; m < 4; ++m)
#pragma unroll
                for (int n = 0; n < 2; ++n) acc[a][b][m][n] = (f32x4){0.f, 0.f, 0.f, 0.f};
    bf16x8 At[4][2], B0[2][2], B1[2][2];
    const char* cA = (const char*)Ab + cur.aoff * 2; const char* cB = (const char*)Bb + cur.boff * 2;
    PG8_STAGE(PG8_SB(0, 0), cB, voffB); PG8_STAGE(PG8_SA(0, 0), cA, voffA); PG8_STAGE(PG8_SB(0, 1), cB + hstepB, voffB); PG8_STAGE(PG8_SA(0, 1), cA + hstepA, voffA);
    if (wr == 1) PG8_BAR;
    PG8_WAIT_V(4); PG8_BAR;
    PG8_STAGE(PG8_SB(1, 0), cB + kstep, voffB); PG8_STAGE(PG8_SA(1, 0), cA + kstep, voffA); PG8_STAGE(PG8_SB(1, 1), cB + hstepB + kstep, voffB);
    PG8_WAIT_V(6); PG8_BAR;
    PG8_STAMP();
    for (;;) {
        const bool has_next = nextu(ui + 1, nxt);
        const char* nA = has_next ? (const char*)Ab + nxt.aoff * 2 : cA; const char* nB = has_next ? (const char*)Bb + nxt.boff * 2 : cB;
        for (int t = 0; t < nt; t += 2) {
            const bool last = (t == nt - 2);
            const char* a1 = cA + (size_t)(t + 1) * kstep;
            const char* a2 = last ? nA : cA + (size_t)(t + 2) * kstep; const char* b2 = last ? nB : cB + (size_t)(t + 2) * kstep;
            const char* a3 = a2 + kstep; const char* b3 = b2 + kstep;
            PG8_LDB(B0, 0, 0); PG8_SCHED; PG8_LDA(At, 0, 0); PG8_STAGE(PG8_SA(1, 1), a1 + hstepA, voffA);
            PG8_WAIT_L(8); PG8_BAR; PG8_WAIT_L(0); PG8_MMA(0, 0, At, B0); PG8_BAR; PG8_SCHED;
            PG8_LDB(B1, 0, 1); PG8_STAGE(PG8_SB(0, 0), b2, voffB);
            PG8_BAR; PG8_WAIT_L(0); PG8_MMA(0, 1, At, B1); PG8_BAR;
            PG8_LDA(At, 0, 1); PG8_STAGE(PG8_SA(0, 0), a2, voffA);
            PG8_BAR; PG8_WAIT_L(0); PG8_MMA(1, 0, At, B0); PG8_BAR; PG8_SCHED;
            PG8_STAGE(PG8_SB(0, 1), b2 + hstepB, voffB);
            PG8_WAIT_V(6); PG8_BAR; PG8_MMA(1, 1, At, B1); PG8_BAR;
            PG8_LDB(B0, 1, 0); PG8_SCHED; PG8_LDA(At, 1, 0); PG8_STAGE(PG8_SA(0, 1), a2 + hstepA, voffA);
            PG8_WAIT_L(8); PG8_BAR; PG8_WAIT_L(0); PG8_MMA(0, 0, At, B0); PG8_BAR; PG8_SCHED;
            PG8_LDB(B1, 1, 1); PG8_STAGE(PG8_SB(1, 0), b3, voffB);
            PG8_BAR; PG8_WAIT_L(0); PG8_MMA(0, 1, At, B1); PG8_BAR;
            PG8_LDA(At, 1, 1); PG8_STAGE(PG8_SA(1, 0), a3, voffA);
            PG8_BAR; PG8_WAIT_L(0); PG8_MMA(1, 0, At, B0); PG8_BAR; PG8_SCHED;
            PG8_STAGE(PG8_SB(1, 1), b3 + hstepB, voffB);
            PG8_WAIT_V(6); PG8_BAR; PG8_MMA(1, 1, At, B1); PG8_BAR;
        }
        PG8_STAMP();
        E(acc, cur, wr, wc, fr, fq);
        PG8_STAMP();
        if (!has_next) break;
#pragma unroll
        for (int a = 0; a < 2; ++a)
#pragma unroll
            for (int b = 0; b < 2; ++b)
#pragma unroll
                for (int m = 0; m < 4; ++m)
#pragma unroll
                    for (int n = 0; n < 2; ++n) acc[a][b][m][n] = (f32x4){0.f, 0.f, 0.f, 0.f};
        cur = nxt; cA = nA; cB = nB; ++ui;
    }
    PG8_WAIT_V(0);
    if (wr == 0) PG8_BAR;
    PG8_BAR;
    PG8_STAMP();
    if (STAMP && wid == 0) { stamps[lane] = lane < nts ? (((unsigned long long)(unsigned)ts_hi << 32) | (unsigned)ts_lo) : 0ull;
        if (lane == 62) stamps[62] = rt_entry; if (lane == 63) stamps[63] = (unsigned long long)wall_clock64(); }
#undef PG8_STAMP
#undef PG8_SA
#undef PG8_SB
#undef PG8_STAGE
#undef PG8_LDA
#undef PG8_LDB
#undef PG8_MMA
#undef PG8_WAIT_V
#undef PG8_WAIT_L
#undef PG8_BAR
#undef PG8_SCHED
}
}

namespace pg8 {
struct MUnit { int e, mt, pn, base, ce; };
template <int MODE, bool PERM, class Epi>
__device__ __forceinline__ void gemm_phase_moe(PG8_LAS unsigned char* lds, const bf16_t* Ab, const bf16_t* Bb, const int K, const size_t bstrideE,
                                               const int* __restrict__ cnt, const int* __restrict__ lists, const int listT, const Epi& E) {
    const int tid = threadIdx.x, wid = __builtin_amdgcn_readfirstlane(tid >> 6), lane = tid & 63, wr = wid >> 2, wc = wid & 3, fr = lane & 15, fq = lane >> 4;
    const int nt = K / BK; const int G = (int)gridDim.x;
    const int c = ((G & 7) == 0) ? (int)((blockIdx.x & 7u) * (unsigned)(G >> 3) + (blockIdx.x >> 3)) : (int)blockIdx.x;
    int ce16[16];
#pragma unroll
    for (int j = 0; j < 16; ++j) ce16[j] = cnt[j];
    auto next = [&](int i, MUnit& u) -> bool {
        const int L = i * G + c; int at = 0, b = 0; bool found = false; u.e = 0; u.mt = 0; u.pn = 0; u.base = 0; u.ce = 1;
#pragma unroll
        for (int j = 0; j < 16; ++j) { const int cj = ce16[j]; const int tl = (cj >> 8) * 4;
            if (!found && L < at + tl) { const int r = L - at; u.e = j; u.mt = r >> 2; u.pn = r & 3; u.base = b; u.ce = cj; found = true; }
            at += tl; b += cj; }
        return found;
    };
    int Rl[2], Cl[2]; unsigned voffB[2];
#pragma unroll
    for (int i = 0; i < 2; ++i) { int R, C; stage_rc(tid * 16 + i * 8192, R, C); Rl[i] = R; Cl[i] = C; const int Rb = PERM ? ((R & ~31) + perm32(R & 31)) : R; voffB[i] = (unsigned)(Rb * K + C) * 2u; }
    auto aoffs = [&](const MUnit& u, unsigned (&v)[2][2]) {
#pragma unroll
        for (int h = 0; h < 2; ++h)
#pragma unroll
            for (int i = 0; i < 2; ++i) { int slot = u.mt * 256 + h * 128 + Rl[i]; slot = slot < u.ce ? slot : u.ce - 1;
                const int row = (MODE == 0) ? (lists[u.e * listT + slot] >> 1) : (u.base + slot);
                v[h][i] = (unsigned)(row * K + Cl[i]) * 2u; }
    };
    const size_t kstep = (size_t)(BK * 2); const size_t hstep = (size_t)HALF * K * 2; const size_t tstep = 2 * hstep;
    const unsigned ldsw = (unsigned)wid * 1024u;
    const int aoff = lds_byte(wr * 64 + fr, fq * 8), boff = lds_byte(wc * 32 + fr, fq * 8);
#define PG8_SA(b, h) (((b) * 2 + (h)) * HTB)
#define PG8_SB(b, h) ((4 + (b) * 2 + (h)) * HTB)
#define PG8_STAGE(bufoff, gbase, voff) do { _Pragma("unroll") for (int _i = 0; _i < 2; ++_i) \
        __builtin_amdgcn_global_load_lds((const unsigned*)((const char*)(gbase) + (voff)[_i]), (PG8_LAS unsigned*)(lds + (bufoff) + ldsw + _i * 8192), 16, 0, 0); } while (0)
#define PG8_LDA(dst, b, h) do { _Pragma("unroll") for (int m = 0; m < 4; ++m) _Pragma("unroll") for (int k = 0; k < 2; ++k) dst[m][k] = *(const PG8_LAS bf16x8*)(lds + PG8_SA(b, h) + aoff + m * 2048 + k * 1024); } while (0)
#define PG8_LDB(dst, b, h) do { _Pragma("unroll") for (int n = 0; n < 2; ++n) _Pragma("unroll") for (int k = 0; k < 2; ++k) dst[n][k] = *(const PG8_LAS bf16x8*)(lds + PG8_SB(b, h) + boff + n * 2048 + k * 1024); } while (0)
#define PG8_MMA(ai, bj, At, Bt) do { __builtin_amdgcn_s_setprio(1); _Pragma("unroll") for (int m = 0; m < 4; ++m) _Pragma("unroll") for (int n = 0; n < 2; ++n) _Pragma("unroll") for (int k = 0; k < 2; ++k) \
        acc[ai][bj][m][n] = __builtin_amdgcn_mfma_f32_16x16x32_bf16(Bt[n][k], At[m][k], acc[ai][bj][m][n], 0, 0, 0); __builtin_amdgcn_s_setprio(0); } while (0)
#define PG8_WAIT_V(n) asm volatile("s_waitcnt vmcnt(" #n ")" ::: "memory")
#define PG8_WAIT_L(n) asm volatile("s_waitcnt lgkmcnt(" #n ")" ::: "memory")
#define PG8_BAR __builtin_amdgcn_s_barrier()
#define PG8_SCHED __builtin_amdgcn_sched_barrier(0)
    MUnit cur, nxt; int ui = 0;
    if (!next(0, cur)) return;
    f32x4 acc[2][2][4][2];
#pragma unroll
    for (int a = 0; a < 2; ++a)
#pragma unroll
        for (int b = 0; b < 2; ++b)
#pragma unroll
            for (int m = 0; m < 4; ++m)
#pragma unroll
                for (int n = 0; n < 2; ++n) acc[a][b][m][n] = (f32x4){0.f, 0.f, 0.f, 0.f};
    bf16x8 At[4][2], B0[2][2], B1[2][2];
    unsigned curA[2][2], nxtA[2][2];
    aoffs(cur, curA);
    const char* gA = (const char*)Ab;
    const char* cB = (const char*)Bb + (size_t)cur.e * bstrideE + (size_t)cur.pn * tstep;
    PG8_STAGE(PG8_SB(0, 0), cB, voffB); PG8_STAGE(PG8_SA(0, 0), gA, curA[0]); PG8_STAGE(PG8_SB(0, 1), cB + hstep, voffB); PG8_STAGE(PG8_SA(0, 1), gA, curA[1]);
    if (wr == 1) PG8_BAR;
    PG8_WAIT_V(4); PG8_BAR;
    PG8_STAGE(PG8_SB(1, 0), cB + kstep, voffB); PG8_STAGE(PG8_SA(1, 0), gA + kstep, curA[0]); PG8_STAGE(PG8_SB(1, 1), cB + hstep + kstep, voffB);
    PG8_WAIT_V(6); PG8_BAR;
    for (;;) {
        const bool has_next = next(ui + 1, nxt);
        if (has_next) aoffs(nxt, nxtA);
        else {
#pragma unroll
            for (int h = 0; h < 2; ++h)
#pragma unroll
                for (int i = 0; i < 2; ++i) nxtA[h][i] = curA[h][i];
        }
        const char* nB = has_next ? (const char*)Bb + (size_t)nxt.e * bstrideE + (size_t)nxt.pn * tstep : cB;
        for (int t = 0; t < nt; t += 2) {
            const bool last = (t == nt - 2);
            const char* a1 = gA + (size_t)(t + 1) * kstep;
            const char* a2 = last ? gA : gA + (size_t)(t + 2) * kstep; const char* b2 = last ? nB : cB + (size_t)(t + 2) * kstep;
            const char* a3 = a2 + kstep; const char* b3 = b2 + kstep;
            unsigned s0[2], s1[2];
            s0[0] = last ? nxtA[0][0] : curA[0][0]; s0[1] = last ? nxtA[0][1] : curA[0][1];
            s1[0] = last ? nxtA[1][0] : curA[1][0]; s1[1] = last ? nxtA[1][1] : curA[1][1];
            PG8_LDB(B0, 0, 0); PG8_SCHED; PG8_LDA(At, 0, 0); PG8_STAGE(PG8_SA(1, 1), a1, curA[1]);
            PG8_WAIT_L(8); PG8_BAR; PG8_WAIT_L(0); PG8_MMA(0, 0, At, B0); PG8_BAR; PG8_SCHED;
            PG8_LDB(B1, 0, 1); PG8_STAGE(PG8_SB(0, 0), b2, voffB);
            PG8_BAR; PG8_WAIT_L(0); PG8_MMA(0, 1, At, B1); PG8_BAR;
            PG8_LDA(At, 0, 1); PG8_STAGE(PG8_SA(0, 0), a2, s0);
            PG8_BAR; PG8_WAIT_L(0); PG8_MMA(1, 0, At, B0); PG8_BAR; PG8_SCHED;
            PG8_STAGE(PG8_SB(0, 1), b2 + hstep, voffB);
            PG8_WAIT_V(6); PG8_BAR; PG8_MMA(1, 1, At, B1); PG8_BAR;
            PG8_LDB(B0, 1, 0); PG8_SCHED; PG8_LDA(At, 1, 0); PG8_STAGE(PG8_SA(0, 1), a2, s1);
            PG8_WAIT_L(8); PG8_BAR; PG8_WAIT_L(0); PG8_MMA(0, 0, At, B0); PG8_BAR; PG8_SCHED;
            PG8_LDB(B1, 1, 1); PG8_STAGE(PG8_SB(1, 0), b3, voffB);
            PG8_BAR; PG8_WAIT_L(0); PG8_MMA(0, 1, At, B1); PG8_BAR;
            PG8_LDA(At, 1, 1); PG8_STAGE(PG8_SA(1, 0), a3, s0);
            PG8_BAR; PG8_WAIT_L(0); PG8_MMA(1, 0, At, B0); PG8_BAR; PG8_SCHED;
            PG8_STAGE(PG8_SB(1, 1), b3 + hstep, voffB);
            PG8_WAIT_V(6); PG8_BAR; PG8_MMA(1, 1, At, B1); PG8_BAR;
        }
        E(acc, cur, wr, wc, fr, fq);
        if (!has_next) break;
#pragma unroll
        for (int a = 0; a < 2; ++a)
#pragma unroll
            for (int b = 0; b < 2; ++b)
#pragma unroll
                for (int m = 0; m < 4; ++m)
#pragma unroll
                    for (int n = 0; n < 2; ++n) acc[a][b][m][n] = (f32x4){0.f, 0.f, 0.f, 0.f};
        cur = nxt; cB = nB; ++ui;
#pragma unroll
        for (int h = 0; h < 2; ++h)
#pragma unroll
            for (int i = 0; i < 2; ++i) curA[h][i] = nxtA[h][i];
    }
    PG8_WAIT_V(0);
    if (wr == 0) PG8_BAR;
    PG8_BAR;
#undef PG8_SA
#undef PG8_SB
#undef PG8_STAGE
#undef PG8_LDA
#undef PG8_LDB
#undef PG8_MMA
#undef PG8_WAIT_V
#undef PG8_WAIT_L
#undef PG8_BAR
#undef PG8_SCHED
}
}

template <bool PERM_, class F> struct EpiL {
  static constexpr bool PERM = PERM_, AFTER_DRAIN = false; F f;
  __device__ __forceinline__ void operator()(const pg8::f32x4 (&acc)[2][2][4][2], const pg8::Unit& u, int wr, int wc, int fr, int fq) const { f(acc, u, wr, wc, fr, fq); }
};
template <bool PERM_, class F>
DEVI void big_gemm(char* smem, const u16* A, const u16* Bt, int M, int N, int K, F f) {
  pg8::Gemm g{A, Bt, M, N, K}; pg8::StaticOrder S; S.init(M, N, (int)gridDim.x, (int)blockIdx.x);
  EpiL<PERM_, F> E{f};
  pg8::gemm_phase<EpiL<PERM_, F>, pg8::StaticOrder, false>((PG8_LAS unsigned char*)smem, g, S, E, nullptr);
}
DEVI uint4 pk8(const f32x4& a, const f32x4& b) { return make_uint4(pg8::cvt_pk_bf16(a[0], a[1]), pg8::cvt_pk_bf16(a[2], a[3]), pg8::cvt_pk_bf16(b[0], b[1]), pg8::cvt_pk_bf16(b[2], b[3])); }

#define XB_TMO      128
#define XB_XCNT(j)  (256  + 64 * (j))
#define XB_XSUB(j)  (1280 + 64 * (j))
#define XB_XGEN(j)  (2304 + 64 * (j))
#define XB_TOP      3328
#define XB_TOPGEN   3392
#define XCD_BAR_WORDS 3456
#define XB_SPIN_CAP (1u << 18)
#define LAS __attribute__((address_space(3)))

__device__ __forceinline__ unsigned xb_ld(unsigned* p)              { return __hip_atomic_load(p, __ATOMIC_RELAXED, __HIP_MEMORY_SCOPE_AGENT); }
__device__ __forceinline__ unsigned xb_add(unsigned* p, unsigned v) { return __hip_atomic_fetch_add(p, v, __ATOMIC_RELAXED, __HIP_MEMORY_SCOPE_AGENT); }
__device__ __forceinline__ unsigned xb_xcc_id() { return (unsigned)__builtin_amdgcn_s_getreg((3 << 11) | 20) & 0xFu; }
#define XB_SPIN(cond, bar) do { unsigned _sp = 0; while (cond) { __builtin_amdgcn_s_sleep(1); \
    if ((++_sp & 255u) == 0u) { if (xb_ld(&(bar)[XB_TMO])) break; if (_sp > XB_SPIN_CAP) { atomicAdd(&(bar)[XB_TMO], 1u); break; } } } } while (0)

struct XcdBarrier {
    unsigned* bar; unsigned x;
    volatile LAS unsigned* st;
};

__device__ __forceinline__ XcdBarrier xcd_barrier_post(unsigned* bar, volatile LAS unsigned* st) {
    XcdBarrier b; b.bar = bar; b.x = xb_xcc_id(); b.st = st;
    if (threadIdx.x == 0) (void)xb_add(&bar[XB_XCNT(b.x)], 1u);
    return b;
}
__device__ __forceinline__ void xcd_barrier_complete(unsigned* bar, unsigned x, unsigned& nloc, unsigned& nx) {
    const unsigned G = gridDim.x * gridDim.y * gridDim.z;
    unsigned sum, cnt, mine, sp = 0u;
    for (;;) {
        sum = 0u; cnt = 0u; mine = 0u;
#pragma unroll
        for (unsigned j = 0; j < 16; ++j) { const unsigned c = xb_ld(&bar[XB_XCNT(j)]); sum += c; cnt += (c > 0u) ? 1u : 0u; mine = (j == x) ? c : mine; }
        if (sum == G) break;
        __builtin_amdgcn_s_sleep(1);
        if ((++sp & 255u) == 0u) { if (xb_ld(&bar[XB_TMO])) break; if (sp > XB_SPIN_CAP) { atomicAdd(&bar[XB_TMO], 1u); break; } }
    }
    nloc = mine > 0u ? mine : 1u; nx = cnt > 0u ? cnt : 1u;
}

__device__ __forceinline__ void xcd_barrier(const XcdBarrier& b) {
    asm volatile("s_waitcnt vmcnt(0)" ::: "memory");
    __syncthreads();
    if (threadIdx.x == 0) {
        unsigned* bar = b.bar;
        __builtin_amdgcn_s_waitcnt(0);
        unsigned nloc = b.st[0], nx = b.st[1];
        if (nloc == 0u) { xcd_barrier_complete(bar, b.x, nloc, nx); b.st[0] = nloc; b.st[1] = nx; }
        const unsigned old = xb_add(&bar[XB_XSUB(b.x)], 1u);
        const unsigned gen = old / nloc;
        if (old + 1u == (gen + 1u) * nloc) {
            __builtin_amdgcn_fence(__ATOMIC_RELEASE, "agent");
            asm volatile("s_waitcnt vmcnt(0)" ::: "memory");
            const unsigned og = xb_add(&bar[XB_TOP], 1u);
            const unsigned tg = og / nx;
            if (og + 1u == (tg + 1u) * nx) xb_add(&bar[XB_TOPGEN], 1u);
            else XB_SPIN(xb_ld(&bar[XB_TOPGEN]) == tg, bar);
            __builtin_amdgcn_fence(__ATOMIC_ACQUIRE, "agent");
            xb_add(&bar[XB_XGEN(b.x)], 1u);
            asm volatile("s_waitcnt vmcnt(0)" ::: "memory");
        } else {
            XB_SPIN(xb_ld(&bar[XB_XGEN(b.x)]) == gen, bar);
            __builtin_amdgcn_fence(__ATOMIC_ACQUIRE, "agent");
            asm volatile("s_waitcnt vmcnt(0)" ::: "memory");
        }
    }
    __syncthreads();
}


template <int ph>
DEVI void run_phase(const P& p, char* smem) {
  const int half = threadIdx.x >> 8, tid = threadIdx.x & 255;
  const int vb = blockIdx.x * 2 + half, nvb = gridDim.x * 2;
  const int vbx = ((gridDim.x & 7u) == 0u) ? (int)((blockIdx.x & 7u) * (unsigned)(nvb >> 3) + (blockIdx.x >> 3) * 2u + (unsigned)half) : vb;
  (void)vbx;
  char* hl = smem + half * 65536;
  const int lane = threadIdx.x & 63;
  const int gw = blockIdx.x * 8 + (threadIdx.x >> 6), nw = gridDim.x * 8;
  char* ws = p.ws;
  (void)hl; (void)lane; (void)gw; (void)nw; (void)vb; (void)nvb; (void)tid;
  {
    constexpr int layer = (ph >= 10) ? 1 : 0;
    switch (ph) {
    case 0: {
      float* tl = (float*)smem;
      if (blockIdx.x == 0 && threadIdx.x < 32) ((int*)(ws + CNT))[threadIdx.x] = 0;
      econv(p.x, (u16*)(ws + XB0), (size_t)T * 1024);
      econv(p.p, (u16*)(ws + PB), (size_t)T * 256);
      tconv(p.fox_w_in, 0, 3088, 1024, 3072, 1, (u16*)(ws + W0_QKV), 0, 0, tl);
      {
        const int gt = blockIdx.x * 512 + threadIdx.x;
        if (gt < 16384) { const int n = gt >> 10, k = gt & 1023; ((u16*)(ws + W0_QKV))[(size_t)(3072 + n) * 1024 + k] = f2bf(p.fox_w_in[(size_t)k * 3088 + 3072 + n]); }
      }
      tconv(p.fox_w_out, 0, 1024, 1024, 1024, 1, (u16*)(ws + W0_OUT), 0, 0, tl);
      tconv(p.w_gate, 1024 * 512, 512, 1024, 512, 16, (u16*)(ws + W0_GU), 1024 * 1024, 1, tl);
      tconv(p.w_up, 1024 * 512, 512, 1024, 512, 16, (u16*)(ws + W0_GU), 1024 * 1024, 2, tl);
      tconv(p.w_down, 512 * 1024, 1024, 512, 1024, 16, (u16*)(ws + W0_D), 1024 * 512, 0, tl);
      tconv(p.ple_gate, 0, 1024, 1024, 1024, 1, (u16*)(ws + W0_PG), 0, 0, tl);
      tconv(p.ple_proj, 0, 1024, 256, 1024, 1, (u16*)(ws + W0_PP), 0, 0, tl);
    } break;
    case 1: {
      const u16* xb = (const u16*)(ws + XB0); const u16* w = (const u16*)(ws + W0_QKV);
      u16* qkv = (u16*)(ws + QKV0); float* logf_ = (float*)(ws + LOGF);
      big_gemm<true>(smem, xb, w, T, 3072, 1024, [=](const f32x4 (&acc)[2][2][4][2], const pg8::Unit& u, int wr, int wc, int fr, int fq) {
        const int row0 = u.pm * 256 + wr * 64 + fr, col0 = u.pn * 256 + wc * 32 + 8 * fq;
#pragma unroll
        for (int ai = 0; ai < 2; ++ai)
#pragma unroll
          for (int m = 0; m < 4; ++m) { u16* rowp = qkv + (size_t)(row0 + ai * 128 + m * 16) * 3072 + col0;
#pragma unroll
            for (int bj = 0; bj < 2; ++bj) *reinterpret_cast<uint4*>(rowp + bj * 128) = pk8(acc[ai][bj][m][0], acc[ai][bj][m][1]); }
      });
      run_tiles(128, vb, nvb, [&](int tile, bool valid) {
        const int mt = tile;
        GemmLoad L; set_seg1(L, xb + (size_t)mt * 128 * 1024, 1024, w + (size_t)24 * 128 * 1024, 1024, valid ? 16 : 0, tid);
        gemm_tile(L, 16, hl, tid, [&](f32x4 (&acc)[4][4], int wr, int wc, int fr, int fq) {
          if (!valid || wc != 0) return;
#pragma unroll
          for (int m = 0; m < 4; ++m) {
            const int row = mt * 128 + wr * 64 + m * 16 + fr;
#pragma unroll
            for (int j = 0; j < 4; ++j) { const int h = fq * 4 + j;
              logf_[(size_t)((row >> 12) * 16 + h) * SEQ + (row & 4095)] = logsig(acc[m][0][j] + p.fox_b_f[h]); }
          }
        });
      });
    } break;
    case 2: {
      const float* logf_ = (const float*)(ws + LOGF); float* c8 = (float*)(ws + C8); float* red = (float*)smem;
      for (int bh = blockIdx.x; bh < 64; bh += gridDim.x) {
        const float4 a = *reinterpret_cast<const float4*>(logf_ + (size_t)bh * SEQ + threadIdx.x * 8), b4 = *reinterpret_cast<const float4*>(logf_ + (size_t)bh * SEQ + threadIdx.x * 8 + 4);
        float e0 = a.x, e1 = e0 + a.y, e2 = e1 + a.z, e3 = e2 + a.w, e4 = e3 + b4.x, e5 = e4 + b4.y, e6 = e5 + b4.z, e7 = e6 + b4.w;
        float incl = e7;
#pragma unroll
        for (int o = 1; o < 64; o <<= 1) { const float t2 = __shfl_up(incl, o); if (lane >= o) incl += t2; }
        const int wv = threadIdx.x >> 6;
        if (lane == 63) red[wv] = incl;
        __syncthreads();
        float base = incl - e7;
#pragma unroll
        for (int w2 = 0; w2 < 8; ++w2) base += (w2 < wv) ? red[w2] : 0.f;
        __syncthreads();
        float* dst = c8 + (size_t)bh * SEQ + threadIdx.x * 8;
        *reinterpret_cast<float4*>(dst) = make_float4(8.f * (base + e0), 8.f * (base + e1), 8.f * (base + e2), 8.f * (base + e3));
        *reinterpret_cast<float4*>(dst + 4) = make_float4(8.f * (base + e4), 8.f * (base + e5), 8.f * (base + e6), 8.f * (base + e7));
      }
    } break;
    case 3: {
      const u16* qkv = (const u16*)(ws + QKV0); const float* c8 = (const float*)(ws + C8); u16* O = (u16*)(ws + O0);
      for (int item = blockIdx.x; item < 512; item += gridDim.x) {
        const int x = item & 7, kk = item >> 3, bh = x + 8 * (kk >> 3), j = kk & 7;
        fa::attn_unit(bh >> 4, bh & 15, j, qkv, qkv + 1024, qkv + 2048, O, c8 + (size_t)bh * SEQ, smem);
        fa::attn_unit(bh >> 4, bh & 15, fa::NQB - 1 - j, qkv, qkv + 1024, qkv + 2048, O, c8 + (size_t)bh * SEQ, smem);
      }
    } break;
    case 4: case 17: {
      const u16* A = (const u16*)(ws + (layer ? O1 : O0)); const u16* W = (const u16*)(ws + (layer ? WROUT : W0_OUT));
      const int K = layer ? 2048 : 1024;
      const float* xf = p.x; const u16* x3b = (const u16*)(ws + X3B); u16* vr = (u16*)(ws + (layer ? VR1 : VR0));
      big_gemm<true>(smem, A, W, T, 1024, K, [=](const f32x4 (&acc)[2][2][4][2], const pg8::Unit& u, int wr, int wc, int fr, int fq) {
        const int row0 = u.pm * 256 + wr * 64 + fr, col0 = u.pn * 256 + wc * 32 + 8 * fq;
#pragma unroll
        for (int ai = 0; ai < 2; ++ai) {
          f32x4 x0[4][2], x1[4][2];
#pragma unroll
          for (int m = 0; m < 4; ++m)
#pragma unroll
            for (int bj = 0; bj < 2; ++bj) { const size_t idx = (size_t)(row0 + ai * 128 + m * 16) * 1024 + col0 + bj * 128;
              if (layer == 0) { x0[m][bj] = *reinterpret_cast<const f32x4*>(xf + idx); x1[m][bj] = *reinterpret_cast<const f32x4*>(xf + idx + 4); }
              else { const uint4 xv = *reinterpret_cast<const uint4*>(x3b + idx); x0[m][bj] = bflo4(make_uint2(xv.x, xv.y)); x1[m][bj] = bflo4(make_uint2(xv.z, xv.w)); } }
#pragma unroll
          for (int m = 0; m < 4; ++m)
#pragma unroll
            for (int bj = 0; bj < 2; ++bj) { const size_t idx = (size_t)(row0 + ai * 128 + m * 16) * 1024 + col0 + bj * 128;
              *reinterpret_cast<uint4*>(vr + idx) = pk8(x0[m][bj] * ALPHA + acc[ai][bj][m][0], x1[m][bj] * ALPHA + acc[ai][bj][m][1]); }
        }
      });
      const u16* pb = (const u16*)(ws + PB); const u16* wpp = (const u16*)(ws + (layer ? W1_PP : W0_PP)); u16* pp = (u16*)(ws + (layer ? PP1 : PP0));
      big_gemm<true>(smem, pb, wpp, T, 1024, 256, [=](const f32x4 (&acc)[2][2][4][2], const pg8::Unit& u, int wr, int wc, int fr, int fq) {
        const int row0 = u.pm * 256 + wr * 64 + fr, col0 = u.pn * 256 + wc * 32 + 8 * fq;
#pragma unroll
        for (int ai = 0; ai < 2; ++ai)
#pragma unroll
          for (int m = 0; m < 4; ++m) { const size_t off = (size_t)(row0 + ai * 128 + m * 16) * 1024 + col0;
#pragma unroll
            for (int bj = 0; bj < 2; ++bj) *reinterpret_cast<uint4*>(pp + off + bj * 128) = pk8(acc[ai][bj][m][0], acc[ai][bj][m][1]); }
      });
    } break;
    case 5: case 18: {
      u16* x1b = (u16*)(ws + (layer ? X1B1 : X1B0));
      const float* g = p.ln1_g + layer * 1024; const float* bb = p.ln1_b + layer * 1024;
      const float* wg = p.w_group + (size_t)layer * 1024 * 4; const float* wrt = p.w_router + (size_t)layer * 1024 * 16;
      const float* bg = p.b_group + layer * 4; const float* br = p.b_router + layer * 16;
      int* cnt = (int*)(ws + CNT) + layer * 16; int* lists = (int*)(ws + LISTS); float* tokw = (float*)(ws + TOKW);
      float* wl = (float*)smem;
      int* lcnt = (int*)(smem + 90112); int* gbs = lcnt + 16; int* ent_e = lcnt + 32; int* ent_r = ent_e + 512; int* ent_t = ent_r + 512;
      if (threadIdx.x < 16) lcnt[threadIdx.x] = 0;
      int itn = 0;
#pragma unroll
      for (int kk = 0; kk < 2; ++kk) {
        const int k = threadIdx.x + kk * 512;
        const float4 g4 = *reinterpret_cast<const float4*>(wg + (size_t)k * 4);
        const float4 r0 = *reinterpret_cast<const float4*>(wrt + (size_t)k * 16), r1 = *reinterpret_cast<const float4*>(wrt + (size_t)k * 16 + 4);
        const float4 r2 = *reinterpret_cast<const float4*>(wrt + (size_t)k * 16 + 8), r3 = *reinterpret_cast<const float4*>(wrt + (size_t)k * 16 + 12);
        float* dw = wl + (k >> 2) * 84 + (k & 3) * 20;
        *reinterpret_cast<float4*>(dw) = g4; *reinterpret_cast<float4*>(dw + 4) = r0; *reinterpret_cast<float4*>(dw + 8) = r1;
        *reinterpret_cast<float4*>(dw + 12) = r2; *reinterpret_cast<float4*>(dw + 16) = r3;
      }
      __syncthreads();
      uint2 cur[2][4], nxt[2][4];
#pragma unroll
      for (int tt = 0; tt < 2; ++tt)
#pragma unroll
        for (int i = 0; i < 4; ++i) { cur[tt][i] = (gw * 2 < T) ? *reinterpret_cast<const uint2*>(x1b + (size_t)(gw * 2 + tt) * 1024 + i * 256 + lane * 4) : make_uint2(0u, 0u); nxt[tt][i] = cur[tt][i]; }
      for (int tok0 = gw * 2; tok0 < T; tok0 += nw * 2) {
        float4 v[2][4]; float lg[2][20];
        const int tokn = tok0 + nw * 2;
        if (tokn < T) {
#pragma unroll
          for (int tt = 0; tt < 2; ++tt)
#pragma unroll
            for (int i = 0; i < 4; ++i) nxt[tt][i] = *reinterpret_cast<const uint2*>(x1b + (size_t)(tokn + tt) * 1024 + i * 256 + lane * 4);
        }
#pragma unroll
        for (int tt = 0; tt < 2; ++tt)
#pragma unroll
          for (int i = 0; i < 4; ++i) { const f32x4 f = bflo4(cur[tt][i]); v[tt][i] = make_float4(f[0], f[1], f[2], f[3]); }
        float mu[2], rstd[2];
#pragma unroll
        for (int tt = 0; tt < 2; ++tt) {
          float s = 0.f;
#pragma unroll
          for (int i = 0; i < 4; ++i) s += v[tt][i].x + v[tt][i].y + v[tt][i].z + v[tt][i].w;
          mu[tt] = wsum(s) * (1.f / 1024.f);
          float sq = 0.f;
#pragma unroll
          for (int i = 0; i < 4; ++i) { v[tt][i].x -= mu[tt]; v[tt][i].y -= mu[tt]; v[tt][i].z -= mu[tt]; v[tt][i].w -= mu[tt];
            sq += v[tt][i].x * v[tt][i].x + v[tt][i].y * v[tt][i].y + v[tt][i].z * v[tt][i].z + v[tt][i].w * v[tt][i].w; }
          rstd[tt] = rsqrtf(wsum(sq) * (1.f / 1024.f) + LN_EPS);
#pragma unroll
          for (int o = 0; o < 20; ++o) lg[tt][o] = 0.f;
        }
#pragma unroll
        for (int i = 0; i < 4; ++i) {
          const int c0 = i * 256 + lane * 4;
          const float4 gg = *reinterpret_cast<const float4*>(g + c0), be = *reinterpret_cast<const float4*>(bb + c0);
#pragma unroll
          for (int tt = 0; tt < 2; ++tt) {
            v[tt][i].x = v[tt][i].x * rstd[tt] * gg.x + be.x; v[tt][i].y = v[tt][i].y * rstd[tt] * gg.y + be.y;
            v[tt][i].z = v[tt][i].z * rstd[tt] * gg.z + be.z; v[tt][i].w = v[tt][i].w * rstd[tt] * gg.w + be.w;
            *reinterpret_cast<uint2*>(x1b + (size_t)(tok0 + tt) * 1024 + c0) = make_uint2(pack2(v[tt][i].x, v[tt][i].y), pack2(v[tt][i].z, v[tt][i].w));
          }
          int woff = (i * 64 + lane) * 84; asm volatile("" : "+v"(woff));
          const float* wrow = wl + woff;
#pragma unroll
          for (int e = 0; e < 4; ++e) {
            const float xa = e == 0 ? v[0][i].x : (e == 1 ? v[0][i].y : (e == 2 ? v[0][i].z : v[0][i].w));
            const float xb_ = e == 0 ? v[1][i].x : (e == 1 ? v[1][i].y : (e == 2 ? v[1][i].z : v[1][i].w));
#pragma unroll
            for (int q4 = 0; q4 < 5; ++q4) {
              const float4 w4 = *reinterpret_cast<const float4*>(wrow + e * 20 + q4 * 4);
              lg[0][q4 * 4 + 0] += xa * w4.x; lg[0][q4 * 4 + 1] += xa * w4.y; lg[0][q4 * 4 + 2] += xa * w4.z; lg[0][q4 * 4 + 3] += xa * w4.w;
              lg[1][q4 * 4 + 0] += xb_ * w4.x; lg[1][q4 * 4 + 1] += xb_ * w4.y; lg[1][q4 * 4 + 2] += xb_ * w4.z; lg[1][q4 * 4 + 3] += xb_ * w4.w;
            }
          }
        }
#pragma unroll
        for (int tt = 0; tt < 2; ++tt)
#pragma unroll
          for (int o = 0; o < 20; ++o) lg[tt][o] = wsum(lg[tt][o]);
        if (lane < 2) {
          const int tok = tok0 + lane;
          float l20[20];
#pragma unroll
          for (int o = 0; o < 20; ++o) l20[o] = lane == 0 ? lg[0][o] : lg[1][o];
          float gl[4];
#pragma unroll
          for (int i = 0; i < 4; ++i) gl[i] = l20[i] + bg[i];
          int gi = 0; float gm = gl[0];
#pragma unroll
          for (int i = 1; i < 4; ++i) if (gl[i] > gm) { gm = gl[i]; gi = i; }
          float gs = 0.f;
#pragma unroll
          for (int i = 0; i < 4; ++i) gs += __expf(gl[i] - gm);
          const float gval = 1.f / gs;
          float el[4];
#pragma unroll
          for (int i = 0; i < 4; ++i) {
            const float t0 = l20[4 + i] + br[i], t1 = l20[8 + i] + br[4 + i], t2 = l20[12 + i] + br[8 + i], t3 = l20[16 + i] + br[12 + i];
            el[i] = gi == 0 ? t0 : (gi == 1 ? t1 : (gi == 2 ? t2 : t3));
          }
          int i0 = 0; float m0 = el[0];
#pragma unroll
          for (int i = 1; i < 4; ++i) if (el[i] > m0) { m0 = el[i]; i0 = i; }
          int i1 = -1; float m1 = -INFINITY;
#pragma unroll
          for (int i = 0; i < 4; ++i) if (i != i0 && el[i] > m1) { m1 = el[i]; i1 = i; }
          const float e1 = __expf(m1 - m0); const float w0 = gval / (1.f + e1), w1 = gval * e1 / (1.f + e1);
          const int ex0 = gi * 4 + i0, ex1 = gi * 4 + i1;
          const int r0 = atomicAdd(&lcnt[ex0], 1), r1 = atomicAdd(&lcnt[ex1], 1);
          const int idx = (((threadIdx.x >> 6) * 16 + itn) * 2 + lane) * 2;
          if (idx < 511) { ent_e[idx] = ex0; ent_r[idx] = r0; ent_t[idx] = tok * 2; ent_e[idx + 1] = ex1; ent_r[idx + 1] = r1; ent_t[idx + 1] = tok * 2 + 1; }
          tokw[tok * 2] = w0; tokw[tok * 2 + 1] = w1;
        }
        ++itn;
#pragma unroll
        for (int tt = 0; tt < 2; ++tt)
#pragma unroll
          for (int i = 0; i < 4; ++i) cur[tt][i] = nxt[tt][i];
      }
      __syncthreads();
      if (threadIdx.x < 16) { const int c = lcnt[threadIdx.x]; gbs[threadIdx.x] = c ? atomicAdd(&cnt[threadIdx.x], c) : 0; }
      __syncthreads();
      {
        const int wv = threadIdx.x >> 6, l2 = threadIdx.x & 63;
        if (l2 < itn * 4) { const int idx = wv * 64 + l2; const int e = ent_e[idx]; lists[e * T + gbs[e] + ent_r[idx]] = ent_t[idx]; }
      }
    } break;
    case 6: case 19: {
      const u16* x1b = (const u16*)(ws + (layer ? X1B1 : X1B0)); const u16* wgu = (const u16*)(ws + (layer ? W1_GU : W0_GU));
      u16* hb = (u16*)(ws + (layer ? HBUF1 : HBUF0));
      const int* cnt = (const int*)(ws + CNT) + layer * 16; const int* lists = (const int*)(ws + LISTS);
      auto epi = [=](const f32x4 (&acc)[2][2][4][2], const pg8::MUnit& u, int wr, int wc, int fr, int fq) {
        const int col0 = u.pn * 128 + wc * 32 + 8 * fq;
#pragma unroll
        for (int ai = 0; ai < 2; ++ai)
#pragma unroll
          for (int m = 0; m < 4; ++m) {
            const int slot = u.mt * 256 + ai * 128 + wr * 64 + m * 16 + fr;
            if (slot < u.ce) { f32x4 h0, h1;
#pragma unroll
              for (int j = 0; j < 4; ++j) { h0[j] = siluf(acc[ai][0][m][0][j]) * acc[ai][1][m][0][j]; h1[j] = siluf(acc[ai][0][m][1][j]) * acc[ai][1][m][1][j]; }
              *reinterpret_cast<uint4*>(hb + (size_t)(u.base + slot) * 512 + col0) = pk8(h0, h1); }
          }
      };
      pg8::gemm_phase_moe<0, true>((PG8_LAS unsigned char*)smem, x1b, wgu, 1024, (size_t)1024 * 1024 * 2, cnt, lists, T, epi);
      const int ntiles = moe_rem_ntiles(cnt, 8);
      run_tiles(ntiles, vbx, nvb, [&](int tile, bool valid) {
        int e, mt, ntile, base, ce; moe_rem_tile(cnt, tile, 8, e, mt, ntile, base, ce);
        if (ce == 0) valid = false;
        const int s_first = (ce >> 8) * 256 + mt * 128;
        GemmLoad L; const int r = tid >> 3, kc = ld_kc(tid);
        set_seg1(L, x1b, 0, wgu + (size_t)e * 1024 * 1024, 0, valid ? 16 : 0, tid);
#pragma unroll
        for (int i = 0; i < 4; ++i) { int s0 = s_first + r + 32 * i; if (s0 >= ce) s0 = ce > 0 ? ce - 1 : 0;
          const int t0 = valid ? (lists[e * T + s0] >> 1) : 0; L.ao[i] = (unsigned)(t0 * 1024 + kc);
          const int rr = r + 32 * i, wq = rr >> 6, w = rr & 63, comp = w >> 5, cc = ntile * 64 + wq * 32 + (w & 31);
          L.bo[i] = (unsigned)(((cc >> 7) * 256 + comp * 128 + (cc & 127)) * 1024 + kc); }
        gemm_tile(L, 16, hl, tid, [&](f32x4 (&acc)[4][4], int wr, int wc, int fr, int fq) {
          if (!valid) return;
#pragma unroll
          for (int m = 0; m < 4; ++m) {
            const int slot = s_first + wr * 64 + m * 16 + fr;
            if (slot < ce) {
#pragma unroll
              for (int n = 0; n < 2; ++n) { f32x4 hv;
#pragma unroll
                for (int j = 0; j < 4; ++j) hv[j] = siluf(acc[m][n][j]) * acc[m][n + 2][j];
                *reinterpret_cast<uint2*>(hb + (size_t)(base + slot) * 512 + ntile * 64 + wc * 32 + n * 16 + fq * 4) = pk4(hv); }
            }
          }
        });
      });
    } break;
    case 7: case 20: {
      const u16* hb = (const u16*)(ws + (layer ? HBUF1 : HBUF0)); const u16* wd = (const u16*)(ws + (layer ? W1_D : W0_D));
      u16* yb = (u16*)(ws + (layer ? YBUF1 : YBUF0));
      const int* cnt = (const int*)(ws + CNT) + layer * 16; const int* lists = (const int*)(ws + LISTS); const float* tokw = (const float*)(ws + TOKW); int* smap = (int*)(ws + SLOTMAP);
      auto epi = [=](const f32x4 (&acc)[2][2][4][2], const pg8::MUnit& u, int wr, int wc, int fr, int fq) {
        const int col0 = u.pn * 256 + wc * 32 + 8 * fq;
        int tk[2][4]; float wgt[2][4];
#pragma unroll
        for (int ai = 0; ai < 2; ++ai)
#pragma unroll
          for (int m = 0; m < 4; ++m) { int slot = u.mt * 256 + ai * 128 + wr * 64 + m * 16 + fr; slot = slot < u.ce ? slot : u.ce - 1; tk[ai][m] = lists[u.e * T + slot]; }
#pragma unroll
        for (int ai = 0; ai < 2; ++ai)
#pragma unroll
          for (int m = 0; m < 4; ++m) wgt[ai][m] = tokw[tk[ai][m]];
#pragma unroll
        for (int ai = 0; ai < 2; ++ai)
#pragma unroll
          for (int m = 0; m < 4; ++m) {
            const int slot = u.mt * 256 + ai * 128 + wr * 64 + m * 16 + fr;
            if (slot < u.ce) {
              if (u.pn == 0 && wc == 0 && fq == 0) smap[tk[ai][m]] = u.base + slot;
#pragma unroll
              for (int bj = 0; bj < 2; ++bj) *reinterpret_cast<uint4*>(yb + (size_t)(u.base + slot) * 1024 + col0 + bj * 128) = pk8(acc[ai][bj][m][0] * wgt[ai][m], acc[ai][bj][m][1] * wgt[ai][m]); }
          }
      };
      pg8::gemm_phase_moe<1, true>((PG8_LAS unsigned char*)smem, hb, wd, 512, (size_t)1024 * 512 * 2, cnt, lists, T, epi);
      const int ntiles = moe_rem_ntiles(cnt, 8);
      run_tiles(ntiles, vbx, nvb, [&](int tile, bool valid) {
        int e, mt, ntile, base, ce; moe_rem_tile(cnt, tile, 8, e, mt, ntile, base, ce);
        if (ce == 0) valid = false;
        const int s_first = (ce >> 8) * 256 + mt * 128;
        GemmLoad L; const int r = tid >> 3, kc = ld_kc(tid);
        set_seg1(L, hb, 0, wd + (size_t)e * 1024 * 512 + (size_t)ntile * 128 * 512, 512, valid ? 8 : 0, tid);
#pragma unroll
        for (int i = 0; i < 4; ++i) { int s0 = s_first + r + 32 * i; if (s0 >= ce) s0 = ce > 0 ? ce - 1 : 0; L.ao[i] = (unsigned)((base + s0) * 512 + kc); }
        gemm_tile(L, 8, hl, tid, [&](f32x4 (&acc)[4][4], int wr, int wc, int fr, int fq) {
          if (!valid) return;
#pragma unroll
          for (int m = 0; m < 4; ++m) {
            const int slot = s_first + wr * 64 + m * 16 + fr;
            if (slot < ce) {
              const int tk = lists[e * T + slot]; const float wgt = tokw[tk];
              if (ntile == 0 && wc == 0 && fq == 0) smap[tk] = base + slot;
#pragma unroll
              for (int n = 0; n < 4; ++n) *reinterpret_cast<uint2*>(yb + (size_t)(base + slot) * 1024 + ntile * 128 + wc * 64 + n * 16 + fq * 4) = pk4(acc[m][n] * wgt);
            }
          }
        });
      });
    } break;
    case 8: case 21: {
      u16* xr = (u16*)(ws + (layer ? X2B1 : X2B0)); const u16* yb = (const u16*)(ws + (layer ? YBUF1 : YBUF0)); const int* smap = (const int*)(ws + SLOTMAP);
      const float* g = p.ln2_g + layer * 1024; const float* bb = p.ln2_b + layer * 1024;
      uint2 cx[2][4], ca[2][4], cc[2][4], nx[2][4], na[2][4], nc[2][4];
      int sn[2][2], sn2[2][2];
      const int step = nw * 2;
#pragma unroll
      for (int tt = 0; tt < 2; ++tt) {
        const int tok = gw * 2 + tt; const int s0 = smap[tok * 2], s1 = smap[tok * 2 + 1];
        const int tn = tok + step < T ? tok + step : tok; sn[tt][0] = smap[tn * 2]; sn[tt][1] = smap[tn * 2 + 1]; sn2[tt][0] = sn[tt][0]; sn2[tt][1] = sn[tt][1];
#pragma unroll
        for (int i = 0; i < 4; ++i) { const int c0 = i * 256 + lane * 4;
          cx[tt][i] = *reinterpret_cast<const uint2*>(xr + (size_t)tok * 1024 + c0);
          ca[tt][i] = *reinterpret_cast<const uint2*>(yb + (size_t)s0 * 1024 + c0); cc[tt][i] = *reinterpret_cast<const uint2*>(yb + (size_t)s1 * 1024 + c0);
          nx[tt][i] = cx[tt][i]; na[tt][i] = ca[tt][i]; nc[tt][i] = cc[tt][i]; }
      }
      for (int tok0 = gw * 2; tok0 < T; tok0 += step) {
        const int tokn = tok0 + step, tokn2 = tokn + step;
        if (tokn < T) {
#pragma unroll
          for (int tt = 0; tt < 2; ++tt)
#pragma unroll
            for (int i = 0; i < 4; ++i) { const int c0 = i * 256 + lane * 4; const int tok = tokn + tt;
              nx[tt][i] = *reinterpret_cast<const uint2*>(xr + (size_t)tok * 1024 + c0);
              na[tt][i] = *reinterpret_cast<const uint2*>(yb + (size_t)sn[tt][0] * 1024 + c0); nc[tt][i] = *reinterpret_cast<const uint2*>(yb + (size_t)sn[tt][1] * 1024 + c0); }
        }
        if (tokn2 < T) {
#pragma unroll
          for (int tt = 0; tt < 2; ++tt) { sn2[tt][0] = smap[(tokn2 + tt) * 2]; sn2[tt][1] = smap[(tokn2 + tt) * 2 + 1]; }
        }
#pragma unroll
        for (int tt = 0; tt < 2; ++tt) {
          const int tok = tok0 + tt; f32x4 v[4];
#pragma unroll
          for (int i = 0; i < 4; ++i) v[i] = bflo4(cx[tt][i]) * ALPHA + (bflo4(ca[tt][i]) + bflo4(cc[tt][i]));
          float s = 0.f;
#pragma unroll
          for (int i = 0; i < 4; ++i) s += (v[i][0] + v[i][1]) + (v[i][2] + v[i][3]);
          const float mu = wsum(s) * (1.f / 1024.f);
          float sq = 0.f;
#pragma unroll
          for (int i = 0; i < 4; ++i) { v[i] = v[i] - mu; sq += (v[i][0] * v[i][0] + v[i][1] * v[i][1]) + (v[i][2] * v[i][2] + v[i][3] * v[i][3]); }
          const float rstd = rsqrtf(wsum(sq) * (1.f / 1024.f) + LN_EPS);
#pragma unroll
          for (int i = 0; i < 4; ++i) {
            const int c0 = i * 256 + lane * 4;
            const f32x4 gg = *reinterpret_cast<const f32x4*>(g + c0), be = *reinterpret_cast<const f32x4*>(bb + c0);
            *reinterpret_cast<uint2*>(xr + (size_t)tok * 1024 + c0) = pk4(v[i] * rstd * gg + be);
          }
        }
#pragma unroll
        for (int tt = 0; tt < 2; ++tt)
#pragma unroll
          for (int i = 0; i < 4; ++i) { cx[tt][i] = nx[tt][i]; ca[tt][i] = na[tt][i]; cc[tt][i] = nc[tt][i]; }
#pragma unroll
        for (int tt = 0; tt < 2; ++tt) { sn[tt][0] = sn2[tt][0]; sn[tt][1] = sn2[tt][1]; }
      }
    } break;
    case 9: case 22: {
      const u16* A = (const u16*)(ws + (layer ? X2B1 : X2B0)); const u16* W = (const u16*)(ws + (layer ? W1_PG : W0_PG));
      const u16* pp = (const u16*)(ws + (layer ? PP1 : PP0));
      const float* bgate = p.ple_b + layer * 1024; u16* x3b = (u16*)(ws + X3B); float* outp = p.out;
      big_gemm<true>(smem, A, W, T, 1024, 1024, [=](const f32x4 (&acc)[2][2][4][2], const pg8::Unit& u, int wr, int wc, int fr, int fq) {
        const int row0 = u.pm * 256 + wr * 64 + fr, col0 = u.pn * 256 + wc * 32 + 8 * fq;
#pragma unroll
        for (int bj = 0; bj < 2; ++bj) {
          const f32x4 b0 = *reinterpret_cast<const f32x4*>(bgate + col0 + bj * 128), b1 = *reinterpret_cast<const f32x4*>(bgate + col0 + bj * 128 + 4);
#pragma unroll
          for (int ai = 0; ai < 2; ++ai) {
            uint4 xv[4], pv[4];
#pragma unroll
            for (int m = 0; m < 4; ++m) { const size_t idx = (size_t)(row0 + ai * 128 + m * 16) * 1024 + col0 + bj * 128;
              xv[m] = *reinterpret_cast<const uint4*>(A + idx); pv[m] = *reinterpret_cast<const uint4*>(pp + idx); }
#pragma unroll
            for (int m = 0; m < 4; ++m) { const size_t idx = (size_t)(row0 + ai * 128 + m * 16) * 1024 + col0 + bj * 128;
              const f32x4 x0 = bflo4(make_uint2(xv[m].x, xv[m].y)), x1 = bflo4(make_uint2(xv[m].z, xv[m].w)), p0 = bflo4(make_uint2(pv[m].x, pv[m].y)), p1 = bflo4(make_uint2(pv[m].z, pv[m].w));
              const f32x4 a0 = acc[ai][bj][m][0] + b0, a1 = acc[ai][bj][m][1] + b1; f32x4 r0, r1;
#pragma unroll
              for (int j = 0; j < 4; ++j) { r0[j] = x0[j] + p0[j] / (1.f + __expf(-a0[j])); r1[j] = x1[j] + p1[j] / (1.f + __expf(-a1[j])); }
              if (layer == 0) *reinterpret_cast<uint4*>(x3b + idx) = pk8(r0, r1);
              else { *reinterpret_cast<f32x4*>(outp + idx) = r0; *reinterpret_cast<f32x4*>(outp + idx + 4) = r1; } }
          }
        }
      });
      if (layer == 0) {

      float* tl = (float*)smem;
      tconv(p.ret_w_in, 0, 6144, 1024, 6144, 1, (u16*)(ws + WRIN), 0, 0, tl);
      tconv(p.ret_w_out, 0, 1024, 2048, 1024, 1, (u16*)(ws + WROUT), 0, 0, tl);
      econv(p.p + (size_t)T * 256, (u16*)(ws + PB), (size_t)T * 256);
      float2* cs = (float2*)(ws + CS);
      const size_t gt = (size_t)blockIdx.x * 512 + threadIdx.x, gn = (size_t)gridDim.x * 512;
      for (size_t i = gt; i < (size_t)T * 128; i += gn) {
        const int tok = (int)(i >> 7), f = (int)(i & 127);
        const float invf = powf(10000.f, -(float)(2 * f) / 256.f);
        const float ang = (float)p.pos[tok] * invf;
        const double rev = (double)ang * 0.15915494309189535;
        const float fr_ = (float)(rev - rint(rev));
        cs[i] = make_float2(__builtin_amdgcn_cosf(fr_), __builtin_amdgcn_sinf(fr_));
      }
          }
    } break;
    case 10: break;
    case 11: {
      const u16* A = (const u16*)(ws + X3B); const u16* W = (const u16*)(ws + WRIN);
      u16* q1 = (u16*)(ws + Q1); u16* k1 = (u16*)(ws + K1); u16* ktd = (u16*)(ws + KTD); u16* vt = (u16*)(ws + VT);
      const float2* cs = (const float2*)(ws + CS);
      big_gemm<true>(smem, A, W, T, 2048, 1024, [=](const f32x4 (&acc)[2][2][4][2], const pg8::Unit& u, int wr, int wc, int fr, int fq) {
        const int row0 = u.pm * 256 + wr * 64 + fr;
        {
          const int isk = u.pn >> 2, hh = u.pn & 3; const int i0 = wc * 32 + 8 * fq;
          const float lg2 = gamma_log2(hh);
#pragma unroll
          for (int ai = 0; ai < 2; ++ai) {
            float4 cta[4][2], ctb[4][2];
#pragma unroll
            for (int m = 0; m < 4; ++m)
#pragma unroll
              for (int n = 0; n < 2; ++n) { const int tok = row0 + ai * 128 + m * 16;
                cta[m][n] = *reinterpret_cast<const float4*>(cs + (size_t)tok * 128 + i0 + 4 * n); ctb[m][n] = *reinterpret_cast<const float4*>(cs + (size_t)tok * 128 + i0 + 4 * n + 2); }
#pragma unroll
            for (int m = 0; m < 4; ++m) {
              const int tok = row0 + ai * 128 + m * 16;
              f32x4 r1[2], r2[2];
#pragma unroll
              for (int n = 0; n < 2; ++n) {
                const float4 ca = cta[m][n], cb = ctb[m][n];
                const f32x4 x1 = acc[ai][0][m][n], x2 = acc[ai][1][m][n];
                r1[n][0] = x1[0] * ca.x - x2[0] * ca.y; r2[n][0] = x2[0] * ca.x + x1[0] * ca.y;
                r1[n][1] = x1[1] * ca.z - x2[1] * ca.w; r2[n][1] = x2[1] * ca.z + x1[1] * ca.w;
                r1[n][2] = x1[2] * cb.x - x2[2] * cb.y; r2[n][2] = x2[2] * cb.x + x1[2] * cb.y;
                r1[n][3] = x1[3] * cb.z - x2[3] * cb.w; r2[n][3] = x2[3] * cb.z + x1[3] * cb.w;
              }
              if (!isk) {
                *reinterpret_cast<uint4*>(q1 + (size_t)tok * 1024 + hh * 256 + i0) = pk8(r1[0], r1[1]);
                *reinterpret_cast<uint4*>(q1 + (size_t)tok * 1024 + hh * 256 + 128 + i0) = pk8(r2[0], r2[1]);
              } else {
                *reinterpret_cast<uint4*>(k1 + (size_t)tok * 1024 + hh * 256 + i0) = pk8(r1[0] * 0.0625f, r1[1] * 0.0625f);
                *reinterpret_cast<uint4*>(k1 + (size_t)tok * 1024 + hh * 256 + 128 + i0) = pk8(r2[0] * 0.0625f, r2[1] * 0.0625f);
                const float kdec = exp2f((float)(255 - (tok & 255)) * lg2) * 0.0625f;
#pragma unroll
                for (int n = 0; n < 2; ++n)
#pragma unroll
                  for (int j = 0; j < 4; ++j) {
                    ktd[(size_t)(hh * 256 + i0 + 4 * n + j) * T + tok] = f2bf(r1[n][j] * kdec);
                    ktd[(size_t)(hh * 256 + 128 + i0 + 4 * n + j) * T + tok] = f2bf(r2[n][j] * kdec);
                  }
              }
            }
          }
        }
      });
      big_gemm<true>(smem, W + (size_t)2048 * 1024, A, 2048, T, 1024, [=](const f32x4 (&acc)[2][2][4][2], const pg8::Unit& u, int wr, int wc, int fr, int fq) {
        const int row0 = u.pm * 256 + wr * 64 + fr, col0 = u.pn * 256 + wc * 32 + 8 * fq;
#pragma unroll
        for (int ai = 0; ai < 2; ++ai)
#pragma unroll
          for (int m = 0; m < 4; ++m) { u16* rowp = vt + (size_t)(row0 + ai * 128 + m * 16) * T + col0;
#pragma unroll
            for (int bj = 0; bj < 2; ++bj) *reinterpret_cast<uint4*>(rowp + bj * 128) = pk8(acc[ai][bj][m][0], acc[ai][bj][m][1]); }
      });
    } break;
    case 12: {
      const u16* q1 = (const u16*)(ws + Q1); const u16* k1 = (const u16*)(ws + K1); const u16* ktd = (const u16*)(ws + KTD); const u16* vt = (const u16*)(ws + VT);
      u16* kv = (u16*)(ws + KV); u16* sp = (u16*)(ws + SP);
      pg8::gemm_phase_b<true, 256, T, T>((PG8_LAS unsigned char*)smem, vt, ktd, 512,
        [=](int L) { const int item = L >> 1, pm = L & 1; const int b = item >> 6, h = (item >> 4) & 3, c = item & 15; const long t0 = (long)b * SEQ + c * 256;
                     pg8::BUnit u; u.aoff = (long)(h * 512 + pm * 256) * T + t0; u.boff = (long)(h * 256) * T + t0; u.id = L; return u; },
        [=](const f32x4 (&acc)[2][2][4][2], const pg8::BUnit& u, int wr, int wc, int fr, int fq) {
          const int item = u.id >> 1, pm = u.id & 1;
          u16* base = kv + (size_t)item * 131072 + (size_t)(pm * 256 + wr * 64 + fr) * 256 + wc * 32 + 8 * fq;
#pragma unroll
          for (int ai = 0; ai < 2; ++ai)
#pragma unroll
            for (int m = 0; m < 4; ++m)
#pragma unroll
              for (int bj = 0; bj < 2; ++bj) *reinterpret_cast<uint4*>(base + (size_t)(ai * 128 + m * 16) * 256 + bj * 128) = pk8(acc[ai][bj][m][0], acc[ai][bj][m][1]);
        });
      run_tiles(256 * 3, vbx, nvb, [&](int tile, bool valid) {
        const int item = tile / 3, tt = tile % 3; const int mt = tt ? 1 : 0, ntile = tt == 2 ? 1 : 0; const int b = item >> 6, h = (item >> 4) & 3, c = item & 15;
        const size_t t0 = (size_t)b * SEQ + c * 256;
        GemmLoad L; set_seg1(L, q1 + (t0 + mt * 128) * 1024 + h * 256, 1024, k1 + (t0 + ntile * 128) * 1024 + h * 256, 1024, valid ? 4 : 0, tid);
        const float lg2 = gamma_log2(h);
        gemm_tile(L, 4, hl, tid, [&](f32x4 (&acc)[4][4], int wr, int wc, int fr, int fq) {
          if (!valid) return;
#pragma unroll
          for (int n = 0; n < 4; ++n) {
            const int jj = ntile * 128 + wc * 64 + n * 16 + fq * 4;
            f32x4 sc;
#pragma unroll
            for (int j = 0; j < 4; ++j) sc[j] = exp2f(-(float)(jj + j + 1) * lg2);
#pragma unroll
            for (int m = 0; m < 4; ++m) {
              const int ii = mt * 128 + wr * 64 + m * 16 + fr; f32x4 r;
#pragma unroll
              for (int j = 0; j < 4; ++j) r[j] = (jj + j <= ii) ? acc[m][n][j] * sc[j] : 0.f;
              *reinterpret_cast<uint2*>(sp + (size_t)item * 65536 + (size_t)ii * 256 + jj) = pk4(r);
            }
          }
        });
      });
    } break;
    case 13: {
      u16* kv = (u16*)(ws + KV);
      const size_t gt = (size_t)blockIdx.x * 512 + threadIdx.x, gn = (size_t)gridDim.x * 512;
      for (size_t i = gt; i < (size_t)16 * 16384; i += gn) {
        const int bh = (int)(i >> 14); const size_t el = (i & 16383) * 8; const int h = bh & 3;
        const float cd = exp2f(256.f * gamma_log2(h));
        uint4 v[16];
#pragma unroll
        for (int c = 0; c < 16; ++c) v[c] = *reinterpret_cast<const uint4*>(kv + (size_t)(bh * 16 + c) * 131072 + el);
        float s[8];
#pragma unroll
        for (int e = 0; e < 8; ++e) s[e] = 0.f;
#pragma unroll
        for (int c = 0; c < 16; ++c) {
          *reinterpret_cast<uint4*>(kv + (size_t)(bh * 16 + c) * 131072 + el) = make_uint4(pack2(s[0], s[1]), pack2(s[2], s[3]), pack2(s[4], s[5]), pack2(s[6], s[7]));
          s[0] = s[0] * cd + __uint_as_float(v[c].x << 16); s[1] = s[1] * cd + __uint_as_float(v[c].x & 0xffff0000u);
          s[2] = s[2] * cd + __uint_as_float(v[c].y << 16); s[3] = s[3] * cd + __uint_as_float(v[c].y & 0xffff0000u);
          s[4] = s[4] * cd + __uint_as_float(v[c].z << 16); s[5] = s[5] * cd + __uint_as_float(v[c].z & 0xffff0000u);
          s[6] = s[6] * cd + __uint_as_float(v[c].w << 16); s[7] = s[7] * cd + __uint_as_float(v[c].w & 0xffff0000u);
        }
      }
    } break;
    case 14: {
      const u16* q1 = (const u16*)(ws + Q1); const u16* vt = (const u16*)(ws + VT); const u16* kv = (const u16*)(ws + KV); const u16* sp = (const u16*)(ws + SP);
      u16* o1 = (u16*)(ws + O1);
      run_tiles(256 * 8, vbx, nvb, [&](int tile, bool valid) {
        const int item = tile >> 3, mt = (tile >> 2) & 1, ntile = tile & 3; const int b = item >> 6, h = (item >> 4) & 3, c = item & 15;
        const size_t t0 = (size_t)b * SEQ + c * 256;
        GemmLoad L; set_seg1(L, sp + (size_t)item * 65536 + (size_t)mt * 128 * 256, 256, vt + (size_t)(h * 512 + ntile * 128) * T + t0, T, valid ? 2 * (mt + 1) : 0, tid);
        set_seg2(L, q1 + (t0 + mt * 128) * 1024 + h * 256, 1024, kv + (size_t)item * 131072 + (size_t)ntile * 128 * 256, 256, valid ? 4 : 0, tid);
        const float lg2 = gamma_log2(h);
        gemm_tile(L, 8, hl, tid, [&](f32x4 (&acc)[4][4], int wr, int wc, int fr, int fq) {
          if (!valid) return;
#pragma unroll
          for (int m = 0; m < 4; ++m) {
            const int ii = mt * 128 + wr * 64 + m * 16 + fr; const float sc = exp2f((float)(ii + 1) * lg2);
#pragma unroll
            for (int n = 0; n < 4; ++n) *reinterpret_cast<uint2*>(o1 + (t0 + ii) * 2048 + h * 512 + ntile * 128 + wc * 64 + n * 16 + fq * 4) = pk4(acc[m][n] * sc);
          }
        });
      });
    } break;
    case 15: {
      const u16* o1 = (const u16*)(ws + O1); float2* st = (float2*)(ws + GNST);
      for (int it0 = gw * 4; it0 < T * 4; it0 += nw * 4) {
        uint4 vv[4];
#pragma unroll
        for (int u4 = 0; u4 < 4; ++u4) vv[u4] = *reinterpret_cast<const uint4*>(o1 + (size_t)(it0 + u4) * 512 + lane * 8);
#pragma unroll
        for (int u4 = 0; u4 < 4; ++u4) {
          const uint4 v = vv[u4];
          const float f0 = __uint_as_float(v.x << 16), f1 = __uint_as_float(v.x & 0xffff0000u), f2 = __uint_as_float(v.y << 16), f3 = __uint_as_float(v.y & 0xffff0000u);
          const float f4 = __uint_as_float(v.z << 16), f5 = __uint_as_float(v.z & 0xffff0000u), f6 = __uint_as_float(v.w << 16), f7 = __uint_as_float(v.w & 0xffff0000u);
          const float mu = wsum(((f0 + f1) + (f2 + f3)) + ((f4 + f5) + (f6 + f7))) * (1.f / 512.f);
          const float d0 = f0 - mu, d1 = f1 - mu, d2 = f2 - mu, d3 = f3 - mu, d4 = f4 - mu, d5 = f5 - mu, d6 = f6 - mu, d7 = f7 - mu;
          const float rstd = rsqrtf(wsum(((d0 * d0 + d1 * d1) + (d2 * d2 + d3 * d3)) + ((d4 * d4 + d5 * d5) + (d6 * d6 + d7 * d7))) * (1.f / 512.f) + LN_EPS);
          if (lane == 0) st[it0 + u4] = make_float2(mu, rstd);
        }
      }
      float* tl = (float*)smem;
      const size_t lo = (size_t)16 * 1024 * 512;
      tconv(p.w_gate + lo, 1024 * 512, 512, 1024, 512, 16, (u16*)(ws + W1_GU), 1024 * 1024, 1, tl);
      tconv(p.w_up + lo, 1024 * 512, 512, 1024, 512, 16, (u16*)(ws + W1_GU), 1024 * 1024, 2, tl);
      tconv(p.w_down + lo, 512 * 1024, 1024, 512, 1024, 16, (u16*)(ws + W1_D), 1024 * 512, 0, tl);
      tconv(p.ple_gate + (size_t)1024 * 1024, 0, 1024, 1024, 1024, 1, (u16*)(ws + W1_PG), 0, 0, tl);
      tconv(p.ple_proj + (size_t)256 * 1024, 0, 1024, 256, 1024, 1, (u16*)(ws + W1_PP), 0, 0, tl);
    } break;
    case 16: {
      const u16* A = (const u16*)(ws + X3B); const u16* W = (const u16*)(ws + WRIN) + (size_t)4096 * 1024;
      u16* o1 = (u16*)(ws + O1); const float2* st = (const float2*)(ws + GNST);
      big_gemm<true>(smem, A, W, T, 2048, 1024, [=](const f32x4 (&acc)[2][2][4][2], const pg8::Unit& u, int wr, int wc, int fr, int fq) {
        const int row0 = u.pm * 256 + wr * 64 + fr, col0 = u.pn * 256 + wc * 32 + 8 * fq; const int hh = u.pn >> 1;
#pragma unroll
        for (int ai = 0; ai < 2; ++ai) {
          float2 ms[4]; uint4 ov[4][2];
#pragma unroll
          for (int m = 0; m < 4; ++m) { const int tok = row0 + ai * 128 + m * 16; ms[m] = st[tok * 4 + hh];
#pragma unroll
            for (int bj = 0; bj < 2; ++bj) ov[m][bj] = *reinterpret_cast<const uint4*>(o1 + (size_t)tok * 2048 + col0 + bj * 128); }
#pragma unroll
          for (int m = 0; m < 4; ++m) {
            const int tok = row0 + ai * 128 + m * 16; const float mx = ms[m].x, my = ms[m].y;
#pragma unroll
            for (int bj = 0; bj < 2; ++bj) {
              const uint4 o4 = ov[m][bj];
              const f32x4 a0 = acc[ai][bj][m][0], a1 = acc[ai][bj][m][1]; f32x4 r0, r1;
              r0[0] = siluf(a0[0]) * ((__uint_as_float(o4.x << 16) - mx) * my); r0[1] = siluf(a0[1]) * ((__uint_as_float(o4.x & 0xffff0000u) - mx) * my);
              r0[2] = siluf(a0[2]) * ((__uint_as_float(o4.y << 16) - mx) * my); r0[3] = siluf(a0[3]) * ((__uint_as_float(o4.y & 0xffff0000u) - mx) * my);
              r1[0] = siluf(a1[0]) * ((__uint_as_float(o4.z << 16) - mx) * my); r1[1] = siluf(a1[1]) * ((__uint_as_float(o4.z & 0xffff0000u) - mx) * my);
              r1[2] = siluf(a1[2]) * ((__uint_as_float(o4.w << 16) - mx) * my); r1[3] = siluf(a1[3]) * ((__uint_as_float(o4.w & 0xffff0000u) - mx) * my);
              *reinterpret_cast<uint4*>(o1 + (size_t)tok * 2048 + col0 + bj * 128) = pk8(r0, r1);
            }
          }
        }
      });
    } break;
    default: break;
    }
  }
}

#ifndef DBL
#define DBL 0u
#endif
#define GSYNC() xcd_barrier(xb)
#define PHASE(n) if (ph0 <= n && n < ph1) { run_phase<n>(p, smem); if ((DBL >> n) & 1u) { GSYNC(); run_phase<n>(p, smem); } if (n + 1 < ph1) GSYNC(); }
__global__ void __launch_bounds__(512) mega(P p, int ph0, int ph1) {
  extern __shared__ __attribute__((aligned(16))) char smem[];
  cg::grid_group grid = cg::this_grid();
  if (ph0 < 0) grid.sync();
  volatile LAS unsigned* xst = (volatile LAS unsigned*)(smem + LDS_BYTES - 16);
  if (threadIdx.x == 0) { xst[0] = 0u; xst[1] = 0u; }
  __syncthreads();
  XcdBarrier xb = xcd_barrier_post((unsigned*)(p.ws + BARW), xst);
  PHASE(0) PHASE(1) PHASE(2) PHASE(3) PHASE(4) PHASE(5) PHASE(6) PHASE(7) PHASE(8) PHASE(9) PHASE(11)
  PHASE(12) PHASE(13) PHASE(14) PHASE(15) PHASE(16) PHASE(17) PHASE(18) PHASE(19) PHASE(20) PHASE(21) PHASE(22)
}

extern "C" void kernel_launch(void* const* d_in, const int* in_sizes, int n_in, void* d_out, int out_size, void* d_ws, size_t ws_size, hipStream_t stream) {
  static int grid_blocks = 0;
  if (!grid_blocks) {
    int dev = 0, cus = 0, per_cu = 0;
    hipGetDevice(&dev);
    hipDeviceGetAttribute(&cus, hipDeviceAttributeMultiprocessorCount, dev);
    hipFuncSetAttribute((const void*)mega, hipFuncAttributeMaxDynamicSharedMemorySize, LDS_BYTES);
    hipOccupancyMaxActiveBlocksPerMultiprocessor(&per_cu, (const void*)mega, 512, LDS_BYTES);
    if (per_cu < 1) { fprintf(stderr, "occupancy query returned %d\n", per_cu); per_cu = 1; }
    grid_blocks = cus * 1;
    if (ws_size < 345 * MiB) fprintf(stderr, "workspace too small: %zu\n", ws_size);
  }
  P p{};
  p.x = (const float*)d_in[0]; p.p = (const float*)d_in[1]; p.pos = (const int*)d_in[2];
  p.fox_w_in = (const float*)d_in[3]; p.fox_b_f = (const float*)d_in[4]; p.fox_w_out = (const float*)d_in[5];
  p.ret_w_in = (const float*)d_in[6]; p.ret_w_out = (const float*)d_in[7];
  p.ln1_g = (const float*)d_in[8]; p.ln1_b = (const float*)d_in[9]; p.ln2_g = (const float*)d_in[10]; p.ln2_b = (const float*)d_in[11];
  p.w_group = (const float*)d_in[12]; p.b_group = (const float*)d_in[13]; p.w_router = (const float*)d_in[14]; p.b_router = (const float*)d_in[15];
  p.w_gate = (const float*)d_in[16]; p.w_up = (const float*)d_in[17]; p.w_down = (const float*)d_in[18];
  p.ple_proj = (const float*)d_in[19]; p.ple_gate = (const float*)d_in[20]; p.ple_b = (const float*)d_in[21];
  p.out = (float*)d_out; p.ws = (char*)d_ws;
#if MEGA
  hipMemsetAsync((char*)d_ws + BARW, 0, XCD_BAR_WORDS * 4, stream);
  int ph0 = 0, ph1 = NPH;
  void* args[] = {&p, &ph0, &ph1};
  hipError_t e = hipLaunchCooperativeKernel((const void*)mega, dim3(grid_blocks), dim3(512), args, LDS_BYTES, stream);
  if (e != hipSuccess) fprintf(stderr, "cooperative launch failed: %s (grid %d)\n", hipGetErrorString(e), grid_blocks);
#else
  for (int ph = 0; ph < NPH; ++ph) hipLaunchKernelGGL(mega, dim3(grid_blocks), dim3(512), LDS_BYTES, stream, p, ph, ph + 1);
#endif
}
```

```cpp
#include <hip/hip_runtime.h>
#include <hip/hip_cooperative_groups.h>
#include <cstdio>
#include <cstdint>
namespace cg = cooperative_groups;

#ifndef MEGA
#define MEGA 1
#endif

typedef unsigned short u16;
using bf16x8 = __attribute__((ext_vector_type(8))) short;
using f32x4 = __attribute__((ext_vector_type(4))) float;
#define DEVI __device__ __forceinline__

constexpr int T = 16384, SEQ = 4096;
constexpr size_t MiB = 1ull << 20;
constexpr float ALPHA = 1.4142135623730951f;
constexpr float LN_EPS = 1e-5f;
constexpr int NPH = 23;
constexpr int LDS_BYTES = 131072 + 16;

constexpr size_t W0_QKV = 0, W0_OUT = 7 * MiB, W0_GU = 9 * MiB, W0_D = 41 * MiB, W0_PG = 57 * MiB, W0_PP = 59 * MiB;
constexpr size_t QKV0 = 60 * MiB, X1B0 = 156 * MiB, YBUF0 = 60 * MiB, HBUF0 = 124 * MiB, X2B0 = 156 * MiB;
constexpr size_t VR0 = 156 * MiB, PP0 = 220 * MiB, XB0 = 284 * MiB, O0 = 284 * MiB, X3B = 284 * MiB;
constexpr size_t PB = 316 * MiB, CS = 324 * MiB, LOGF = 340 * MiB, C8 = 341 * MiB, LISTS = 342 * MiB, TOKW = 343 * MiB;
constexpr size_t GNST = 343 * MiB + 512 * 1024, CNT = 344 * MiB, BARW = 344 * MiB + 4096, SLOTMAP = 343 * MiB + 256 * 1024;
constexpr size_t WRIN = 0, WROUT = 12 * MiB, Q1 = 16 * MiB, K1 = 48 * MiB, KTD = 80 * MiB, VT = 112 * MiB, O1 = 48 * MiB;
constexpr size_t KV = 176 * MiB, SP = 240 * MiB, W1_GU = 176 * MiB, W1_D = 208 * MiB, W1_PG = 224 * MiB, W1_PP = 226 * MiB;
constexpr size_t VR1 = 112 * MiB, PP1 = 240 * MiB, X1B1 = 112 * MiB, HBUF1 = 80 * MiB, YBUF1 = 0, X2B1 = 112 * MiB;

struct P {
  const float *x, *p; const int* pos;
  const float *fox_w_in, *fox_b_f, *fox_w_out, *ret_w_in, *ret_w_out, *ln1_g, *ln1_b, *ln2_g, *ln2_b;
  const float *w_group, *b_group, *w_router, *b_router, *w_gate, *w_up, *w_down, *ple_proj, *ple_gate, *ple_b;
  float* out; char* ws;
};

DEVI float bf2f(u16 b) { return __uint_as_float(((unsigned)b) << 16); }
DEVI u16 f2bf(float f) { unsigned u = __float_as_uint(f); u += 0x7FFFu + ((u >> 16) & 1u); return (u16)(u >> 16); }
DEVI unsigned pack2(float a, float b) { return (unsigned)f2bf(a) | ((unsigned)f2bf(b) << 16); }
DEVI float wsum(float v) {
#pragma unroll
  for (int o = 32; o >= 1; o >>= 1) v += __shfl_xor(v, o);
  return v;
}
DEVI float siluf(float v) { return v / (1.f + __expf(-v)); }
DEVI float logsig(float z) { return fminf(z, 0.f) - log1pf(__expf(-fabsf(z))); }

struct GemmLoad {
  const u16 *A, *B, *A2, *B2;
  unsigned ao[4], bo[4], ao2[4], bo2[4];
  int nt1, nt2;
};
DEVI void glds16(const u16* g, char* l) {
  __builtin_amdgcn_global_load_lds((const __attribute__((address_space(1))) void*)g, (__attribute__((address_space(3))) void*)l, 16, 0, 0);
}
DEVI int ld_kc(int tid) { return ((tid & 7) ^ ((tid >> 4) & 7)) * 8; }
template <class Epi>
DEVI void gemm_tile(const GemmLoad& L, int nt_max, char* lds, int tid, Epi&& epi) {
  const int wid = tid >> 6, lane = tid & 63, wr = wid >> 1, wc = wid & 1, fr = lane & 15, fq = lane >> 4;
  f32x4 acc[4][4];
#pragma unroll
  for (int m = 0; m < 4; ++m)
#pragma unroll
    for (int n = 0; n < 4; ++n) acc[m][n] = f32x4{0.f, 0.f, 0.f, 0.f};
  const int nt = L.nt1 + L.nt2;
  auto stage = [&](int t, int buf) {
    char* sa = lds + buf * 32768 + tid * 16; char* sb = sa + 16384;
    const bool s1 = t < L.nt1; const int tt = s1 ? t : t - L.nt1;
    const u16* Ab = s1 ? L.A : L.A2; const u16* Bb = s1 ? L.B : L.B2;
#pragma unroll
    for (int i = 0; i < 4; ++i) {
      const unsigned oa = s1 ? L.ao[i] : L.ao2[i], ob = s1 ? L.bo[i] : L.bo2[i];
      glds16(Ab + oa + tt * 64, sa + i * 4096); glds16(Bb + ob + tt * 64, sb + i * 4096);
    }
  };
  const int sw = fr >> 1;
  if (nt > 0) stage(0, 0);
  for (int t = 0; t < nt_max; ++t) {
    asm volatile("s_waitcnt vmcnt(0)" ::: "memory");
    __syncthreads();
    if (t + 1 < nt) stage(t + 1, (t + 1) & 1);
    if (t < nt) {
      const char* sa = lds + (t & 1) * 32768 + (wr * 64 + fr) * 128; const char* sb = lds + (t & 1) * 32768 + 16384 + (wc * 64 + fr) * 128;
#pragma unroll
      for (int kk = 0; kk < 2; ++kk) {
        const int co = ((fq + 4 * kk) ^ sw) * 16;
        bf16x8 af[4], bfv[4];
#pragma unroll
        for (int m = 0; m < 4; ++m) af[m] = *reinterpret_cast<const bf16x8*>(sa + m * 2048 + co);
#pragma unroll
        for (int n = 0; n < 4; ++n) bfv[n] = *reinterpret_cast<const bf16x8*>(sb + n * 2048 + co);
#pragma unroll
        for (int m = 0; m < 4; ++m)
#pragma unroll
          for (int n = 0; n < 4; ++n) acc[m][n] = __builtin_amdgcn_mfma_f32_16x16x32_bf16(bfv[n], af[m], acc[m][n], 0, 0, 0);
      }
    }
  }
  __syncthreads();
  epi(acc, wr, wc, fr, fq);
}
template <class TF>
DEVI void run_tiles(int ntiles, int vb, int nvb, TF&& f) {
  const int niter = (ntiles + nvb - 1) / nvb;
  for (int it = 0; it < niter; ++it) { const int tile = it * nvb + vb; const bool valid = tile < ntiles; f(valid ? tile : 0, valid); }
}
DEVI void set_seg1(GemmLoad& L, const u16* A, size_t lda, const u16* B, size_t ldb, int nt, int tid) {
  const int r = tid >> 3, kc = ld_kc(tid);
  L.A = A; L.B = B; L.A2 = A; L.B2 = B;
#pragma unroll
  for (int i = 0; i < 4; ++i) { L.ao[i] = (unsigned)((r + 32 * i) * lda + kc); L.bo[i] = (unsigned)((r + 32 * i) * ldb + kc); L.ao2[i] = L.ao[i]; L.bo2[i] = L.bo[i]; }
  L.nt1 = nt; L.nt2 = 0;
}
DEVI void set_seg2(GemmLoad& L, const u16* A, size_t lda, const u16* B, size_t ldb, int nt, int tid) {
  const int r = tid >> 3, kc = ld_kc(tid);
  L.A2 = A; L.B2 = B;
#pragma unroll
  for (int i = 0; i < 4; ++i) { L.ao2[i] = (unsigned)((r + 32 * i) * lda + kc); L.bo2[i] = (unsigned)((r + 32 * i) * ldb + kc); }
  L.nt2 = nt;
}
DEVI uint2 pk4(const f32x4& a) { unsigned lo, hi; asm("v_cvt_pk_bf16_f32 %0, %1, %2" : "=v"(lo) : "v"(a[0]), "v"(a[1])); asm("v_cvt_pk_bf16_f32 %0, %1, %2" : "=v"(hi) : "v"(a[2]), "v"(a[3])); return make_uint2(lo, hi); }

DEVI int rowmap(int mode, int n) {
  if (mode == 0) return n;
  if (mode == 1 || mode == 2) return (n >> 7) * 256 + (mode == 2 ? 128 : 0) + (n & 127);
  const int hh = n >> 8, ip = n & 255, comp = ip >> 7, i = ip & 127, th = i >> 6, w = i & 63, wc = w >> 5, rr = w & 31;
  return hh * 256 + th * 128 + wc * 64 + comp * 32 + rr;
}
DEVI void tconv(const float* __restrict__ src, size_t sbs, int ldsrc, int K, int N, int nbatch, u16* __restrict__ dst, size_t dbs, int mode, float* tl) {
  const int tid = threadIdx.x; const int tk = K >> 6, tn = N >> 8; const int per = tk * tn, nt = per * nbatch;
  const int ty = tid >> 6, tx = tid & 63;
  float r[8][4];
  auto ldtile = [&](int tile) {
    const int b = tile / per, tt = tile % per; const int k0 = (tt / tn) << 6, n0 = (tt % tn) << 8;
    const float* s = src + (size_t)b * sbs;
#pragma unroll
    for (int rr = 0; rr < 8; ++rr)
#pragma unroll
      for (int c = 0; c < 4; ++c) r[rr][c] = s[(size_t)(k0 + ty * 8 + rr) * ldsrc + n0 + c * 64 + tx];
  };
  int tile = blockIdx.x;
  if (tile < nt) ldtile(tile);
  for (; tile < nt; tile += gridDim.x) {
    const int b = tile / per, tt = tile % per; const int k0 = (tt / tn) << 6, n0 = (tt % tn) << 8;
    u16* d = dst + (size_t)b * dbs;
#pragma unroll
    for (int rr = 0; rr < 8; ++rr)
#pragma unroll
      for (int c = 0; c < 4; ++c) tl[(ty * 8 + rr) * 257 + c * 64 + tx] = r[rr][c];
    __syncthreads();
    if (tile + (int)gridDim.x < nt) ldtile(tile + (int)gridDim.x);
    { const int n = tid >> 1, kh = (tid & 1) * 32;
      const int nr = rowmap(mode, n0 + n);
#pragma unroll
      for (int q = 0; q < 4; ++q) {
        const int kb = kh + q * 8;
        const unsigned w0 = pack2(tl[(kb + 0) * 257 + n], tl[(kb + 1) * 257 + n]);
        const unsigned w1 = pack2(tl[(kb + 2) * 257 + n], tl[(kb + 3) * 257 + n]);
        const unsigned w2 = pack2(tl[(kb + 4) * 257 + n], tl[(kb + 5) * 257 + n]);
        const unsigned w3 = pack2(tl[(kb + 6) * 257 + n], tl[(kb + 7) * 257 + n]);
        *reinterpret_cast<uint4*>(d + (size_t)nr * K + k0 + kb) = make_uint4(w0, w1, w2, w3);
      } }
    __syncthreads();
  }
}
DEVI void econv(const float* __restrict__ src, u16* __restrict__ dst, size_t n) {
  const size_t gt = (size_t)blockIdx.x * 512 + threadIdx.x, gn = (size_t)gridDim.x * 512;
  for (size_t i = gt * 4; i < n; i += gn * 16) {
    float4 v[4];
#pragma unroll
    for (int u = 0; u < 4; ++u) { const size_t j = i + (size_t)u * gn * 4; v[u] = j < n ? *reinterpret_cast<const float4*>(src + j) : make_float4(0.f, 0.f, 0.f, 0.f); }
#pragma unroll
    for (int u = 0; u < 4; ++u) { const size_t j = i + (size_t)u * gn * 4; if (j < n) *reinterpret_cast<uint2*>(dst + j) = make_uint2(pack2(v[u].x, v[u].y), pack2(v[u].z, v[u].w)); }
  }
}


DEVI f32x4 bflo4(uint2 v) { return f32x4{__uint_as_float(v.x << 16), __uint_as_float(v.x & 0xffff0000u), __uint_as_float(v.y << 16), __uint_as_float(v.y & 0xffff0000u)}; }
DEVI float gamma_log2(int h) { return log2f(1.0f - exp2f(-5.0f - (float)h)); }

DEVI int moe_ntiles(const int* cnt, int ntn) { int s = 0; for (int i = 0; i < 16; ++i) s += ((cnt[i] + 127) >> 7) * ntn; return s; }
DEVI int moe_rem_ntiles(const int* cnt, int ntn) { int s = 0; for (int i = 0; i < 16; ++i) s += (((cnt[i] & 255) + 127) >> 7) * ntn; return s; }
DEVI void moe_rem_tile(const int* cnt, int tile, int ntn, int& e, int& mt, int& nt, int& base, int& ce) {
  int at = 0, b = 0; e = 0; mt = 0; nt = 0; base = 0; ce = 0;
  for (int i = 0; i < 16; ++i) {
    const int c = cnt[i]; const int tl = (((c & 255) + 127) >> 7) * ntn;
    if (tile >= at && tile < at + tl) { const int r = tile - at; e = i; mt = r / ntn; nt = r % ntn; base = b; ce = c; }
    at += tl; b += c;
  }
}
DEVI void moe_tile(const int* cnt, int tile, int ntn, int& e, int& mt, int& nt, int& base, int& ce) {
  int at = 0, b = 0; e = 0; mt = 0; nt = 0; base = 0; ce = 0;
  for (int i = 0; i < 16; ++i) {
    const int c = cnt[i]; const int tl = ((c + 127) >> 7) * ntn;
    if (tile >= at && tile < at + tl) { const int r = tile - at; e = i; mt = r / ntn; nt = r % ntn; base = b; ce = c; }
    at += tl; b += c;
  }
}


namespace fa {
using s16x4 = __attribute__((ext_vector_type(4))) short;
using f32x16 = __attribute__((ext_vector_type(16))) float;
using u32x4 = __attribute__((ext_vector_type(4))) unsigned;
constexpr int D = 64, DMQ = 3072, DMO = 1024, NW = 8, QBLK = 32, QB = 256, KVBLK = 64, NQB = SEQ / QB, THR = 64;
constexpr float C2 = 0.125f * 1.4426950408889634f;
constexpr int SLOTB = 8192, LDS_K = 0, LDS_V = 3 * SLOTB, LDS_WS = 6 * SLOTB, LDS_OST = LDS_WS + NW * 256, LDS_C8 = LDS_OST + NW * 4096, LDS_TOTAL = LDS_C8 + 16384;
#define SBAR() __builtin_amdgcn_sched_barrier(0)
#define PIN(x) asm volatile("" : "+v"(x))
#define MFMA(a, b, c) __builtin_amdgcn_mfma_f32_32x32x16_bf16(a, b, c, 0, 0, 0)
#define WAIT_BAR(N) asm volatile("s_waitcnt vmcnt(" #N ") lgkmcnt(0)\n\ts_barrier" ::: "memory")
DEVI int crow(int r, int hi) { return (r & 3) + 8 * (r >> 2) + 4 * hi; }
DEVI unsigned cvtpk(float lo, float hi) { unsigned r; asm("v_cvt_pk_bf16_f32 %0, %1, %2" : "=v"(r) : "v"(lo), "v"(hi)); return r; }
DEVI void glds16a(const void* g, unsigned lds_base) {
  unsigned sv; asm volatile("s_mov_b32 %0, m0\n\ts_mov_b32 m0, %2\n\ts_nop 0\n\tglobal_load_lds_dwordx4 %1, off\n\ts_mov_b32 m0, %0" : "=&s"(sv) : "v"(g), "s"(lds_base) : "memory"); }
typedef __attribute__((address_space(3))) const char* lds_cptr;
typedef short v4i16_t __attribute__((ext_vector_type(4)));
DEVI void kload2(bf16x8* kf, lds_cptr kp, int d0) { kf[2 * d0] = *(const __attribute__((address_space(3))) bf16x8*)(kp + d0 * 2048); kf[2 * d0 + 1] = *(const __attribute__((address_space(3))) bf16x8*)(kp + d0 * 2048 + 512); }
DEVI s16x4 vtr(lds_cptr p) { return __builtin_bit_cast(s16x4, __builtin_amdgcn_ds_read_tr16_b64_v4i16((__attribute__((address_space(3))) v4i16_t*)p)); }
#define MX3(a, b, c) __builtin_fmaxf(__builtin_fmaxf((a), (b)), (c))
DEVI float rowmax(const f32x16& p0, const f32x16& p1) {
  float a = MX3(p0[0], p0[1], p1[0]), b = MX3(p0[2], p0[3], p1[1]); a = MX3(a, p1[2], p1[3]);
#pragma unroll
  for (int r = 4; r < 16; r += 4) { a = MX3(a, p0[r], p0[r + 1]); b = MX3(b, p0[r + 2], p0[r + 3]); a = MX3(a, p1[r], p1[r + 1]); b = MX3(b, p1[r + 2], p1[r + 3]); }
  float m = __builtin_fmaxf(a, b); auto rr = __builtin_amdgcn_permlane32_swap(__float_as_uint(m), __float_as_uint(m), false, false);
  return __builtin_fmaxf(__uint_as_float(rr[0]), __uint_as_float(rr[1])); }
DEVI void cmask(f32x16& p0, f32x16& p1, int jb, int qrel, int hi) {
  const int kb = 64 * jb + 4 * hi;
#pragma unroll
  for (int r = 0; r < 16; ++r) { const int kv = kb + (r & 3) + 8 * (r >> 2); if (kv > qrel) p0[r] = -INFINITY; if (kv + 32 > qrel) p1[r] = -INFINITY; } }

DEVI void attn_unit(int b, int h, int qb, const u16* Q, const u16* __restrict__ K, const u16* __restrict__ V, u16* O, const float* __restrict__ c8g, char* lds) {
  int tid = threadIdx.x; asm volatile("" : "+v"(tid));
  const int lane = tid & 63, r32 = lane & 31, hi = lane >> 5; const int wid = __builtin_amdgcn_readfirstlane(tid >> 6);
  const long rowbase = (long)b * SEQ; const int q0 = qb * QB, NT = (q0 + QB) / KVBLK;
  const u16* Qw = Q + (rowbase + q0 + wid * QBLK) * DMQ + h * D;
  const unsigned lds0 = (unsigned)(uintptr_t)lds; float* wsf = (float*)(lds + LDS_WS) + wid * 64;
  { const int nv = (q0 + QB) >> 2; float4* dstc = (float4*)(lds + LDS_C8); const float4* srcc = (const float4*)c8g;
    for (int i = tid; i < nv; i += 512) dstc[i] = srcc[i]; }
  const float cq8 = c8g[q0 + wid * QBLK + r32];
  const lds_cptr c8p = (lds_cptr)lds + LDS_C8 + 16 * hi;
  const u16* ksrc = K + rowbase * DMQ + h * D + (long)lane * DMQ + wid * 8;
  const u16* vsrc = V + rowbase * DMQ + h * D + (long)(16 * (wid & 3) + (lane >> 2)) * DMQ + (wid >> 2) * 32 + (lane & 3) * 8;
  const unsigned kdst = lds0 + LDS_K + wid * 1024, vdst = lds0 + LDS_V + wid * 1024;
#define DMA_K(t, slot) glds16a(ksrc + (long)(t) * KVBLK * DMQ, (unsigned)__builtin_amdgcn_readfirstlane(kdst + (slot)))
#define DMA_V(t, slot) glds16a(vsrc + (long)(t) * KVBLK * DMQ, (unsigned)__builtin_amdgcn_readfirstlane(vdst + (slot)))
  const lds_cptr vp0 = (lds_cptr)lds + LDS_V + ((lane >> 4) & 1) * 32 + (lane & 3) * 8 + (4 * hi + ((lane & 15) >> 2)) * 64;
  const lds_cptr kp0 = (lds_cptr)lds + LDS_K + hi * 1024 + r32 * 16;
  DMA_K(0, 0); DMA_V(0, 0); DMA_K(1, SLOTB);
  bf16x8 qr[4];
#pragma unroll
  for (int d0 = 0; d0 < 4; ++d0) qr[d0] = *reinterpret_cast<const bf16x8*>(&Qw[(long)r32 * DMQ + d0 * 16 + hi * 8]);
  float mhat = 0.f, l_reg = 0.f; f32x16 o[2]; o[0] = f32x16{}; o[1] = f32x16{};
  const int qrel = wid * QBLK + r32; bool resc = false;
  f32x16 pA0, pA1, pB0, pB1; bf16x8 kf[8]; s16x4 vlo[8], vhi[8]; u32x4 pw0, pw1, pw2, pw3;
  int sl_prev = 0, sl_cur = 0, sl_next = SLOTB;
#define ROT() do { sl_prev = sl_cur; sl_cur = sl_next; sl_next = (sl_next == 2 * SLOTB) ? 0 : sl_next + SLOTB; } while (0)
#define EX(v) __builtin_amdgcn_exp2f(__builtin_fmaf((v), C2, nmh))
#define RESC() do { if (resc) { _Pragma("unroll") for (int d_ = 0; d_ < 2; ++d_) _Pragma("unroll") for (int r = 0; r < 16; ++r) o[d_][r] *= wsf[crow(r, hi)]; } } while (0)
#define BIAS(C0, C1, t) do { const lds_cptr cb_ = c8p + (t) * 256; \
    _Pragma("unroll") for (int g_ = 0; g_ < 4; ++g_) { \
      const f32x4 u_ = *(const __attribute__((address_space(3))) f32x4*)(cb_ + g_ * 32); \
      const f32x4 w_ = *(const __attribute__((address_space(3))) f32x4*)(cb_ + 128 + g_ * 32); \
      C0[4 * g_ + 0] = cq8 - u_[0]; C0[4 * g_ + 1] = cq8 - u_[1]; C0[4 * g_ + 2] = cq8 - u_[2]; C0[4 * g_ + 3] = cq8 - u_[3]; \
      C1[4 * g_ + 0] = cq8 - w_[0]; C1[4 * g_ + 1] = cq8 - w_[1]; C1[4 * g_ + 2] = cq8 - w_[2]; C1[4 * g_ + 3] = cq8 - w_[3]; } } while (0)
  DMA_K(2, 2 * SLOTB);
  WAIT_BAR(3);
  _Pragma("unroll") for (int d0 = 0; d0 < 4; ++d0) kload2(kf, kp0, d0);
  BIAS(pA0, pA1, 0);
  pA0 = MFMA(kf[0], qr[0], pA0); pA1 = MFMA(kf[1], qr[0], pA1); pA0 = MFMA(kf[2], qr[1], pA0); pA1 = MFMA(kf[3], qr[1], pA1);
  pA0 = MFMA(kf[4], qr[2], pA0); pA1 = MFMA(kf[5], qr[2], pA1); pA0 = MFMA(kf[6], qr[3], pA0); pA1 = MFMA(kf[7], qr[3], pA1);
  if (NT == 4) cmask(pA0, pA1, 0, qrel, hi);
  { const float rm = rowmax(pA0, pA1); mhat = rm * C2; const float nmh = -mhat;
#pragma unroll
    for (int r = 0; r < 16; ++r) { pA0[r] = EX(pA0[r]); pA1[r] = EX(pA1[r]); } }
  WAIT_BAR(0);
  DMA_K(3, 0); DMA_V(1, SLOTB); ROT();
  _Pragma("unroll") for (int d0 = 0; d0 < 4; ++d0) kload2(kf, kp0 + sl_cur, d0);
  WAIT_BAR(2);
#define PKW(P, i) cvtpk(P[i], P[i + 1])
#define PAF(k) __builtin_bit_cast(bf16x8, pw##k)
#define VFR(i) (bf16x8){vlo[i][0], vlo[i][1], vlo[i][2], vlo[i][3], vhi[i][0], vhi[i][1], vhi[i][2], vhi[i][3]}
#define VRD(i) do { vlo[i] = vtr(vp_ + (((i) >> 2) * 4096 + ((i) & 3) * 1024)); vhi[i] = vtr(vp_ + (((i) >> 2) * 4096 + ((i) & 3) * 1024 + 512)); } while (0)
#define KRD(G, d0) do { if (G) { kload2(kf, kp0 + sl_next, d0); SBAR(); } } while (0)
#define GAPA(MF, a0, a1, a2, a3, W0, W1, PW) do { MF; sacc += a0; sacc += a1; sacc += a2; sacc += a3; W0; W1; PIN(PW); PIN(sacc); SBAR(); } while (0)
#define GAPB(MF, X, i) do { MF; X[i] = EX(X[i]); X[i + 1] = EX(X[i + 1]); X[i + 2] = EX(X[i + 2]); X[i + 3] = EX(X[i + 3]); PIN(X); SBAR(); } while (0)
#define GAPBQ(MF, X, i, Q, G, tn, k) do { MF; X[i] = EX(X[i]); X[i + 1] = EX(X[i + 1]); X[i + 2] = EX(X[i + 2]); X[i + 3] = EX(X[i + 3]); \
    if (G) { const f32x4 u_ = *(const __attribute__((address_space(3))) f32x4*)(c8p + (tn) * 256 + ((k) >> 2) * 128 + ((k) & 3) * 32); \
      Q[4 * ((k) & 3) + 0] = cq8 - u_[0]; Q[4 * ((k) & 3) + 1] = cq8 - u_[1]; Q[4 * ((k) & 3) + 2] = cq8 - u_[2]; Q[4 * ((k) & 3) + 3] = cq8 - u_[3]; } \
    PIN(X); PIN(Q); SBAR(); } while (0)
#define STEP(C0, C1, P0, P1, t, MASK, GK, GV, GL) do { SBAR(); \
    const lds_cptr vp_ = vp0 + sl_prev; \
    VRD(0); SBAR(); float sacc = P0[0] + P0[1]; \
                    GAPA(C0 = MFMA(kf[0], qr[0], C0), P0[2], P0[3], P0[4], P0[5],     pw0[0] = PKW(P0, 0),  pw0[1] = PKW(P0, 2),  pw0); \
    VRD(4); SBAR(); GAPA(C1 = MFMA(kf[1], qr[0], C1), P0[6], P0[7], P0[8], P0[9],     pw0[2] = PKW(P0, 4),  pw0[3] = PKW(P0, 6),  pw0); \
    VRD(1); SBAR(); GAPA(C0 = MFMA(kf[2], qr[1], C0),    P0[10], P0[11], P0[12], P0[13], pw1[0] = PKW(P0, 8),  pw1[1] = PKW(P0, 10), pw1); \
    VRD(5); SBAR(); GAPA(C1 = MFMA(kf[3], qr[1], C1),    P0[14], P0[15], P1[0], P1[1],   pw1[2] = PKW(P0, 12), pw1[3] = PKW(P0, 14), pw1); \
    VRD(2); SBAR(); GAPA(C0 = MFMA(kf[4], qr[2], C0),    P1[2], P1[3], P1[4], P1[5],     pw2[0] = PKW(P1, 0),  pw2[1] = PKW(P1, 2),  pw2); \
    VRD(6); SBAR(); GAPA(C1 = MFMA(kf[5], qr[2], C1),    P1[6], P1[7], P1[8], P1[9],     pw2[2] = PKW(P1, 4),  pw2[3] = PKW(P1, 6),  pw2); \
    VRD(3); SBAR(); GAPA(C0 = MFMA(kf[6], qr[3], C0),    P1[10], P1[11], P1[12], P1[13], pw3[0] = PKW(P1, 8),  pw3[1] = PKW(P1, 10), pw3); \
    VRD(7); SBAR(); GAPA(C1 = MFMA(kf[7], qr[3], C1),    P1[14], P1[15], 0.f, 0.f,       pw3[2] = PKW(P1, 12), pw3[3] = PKW(P1, 14), pw3); \
    l_reg += sacc; \
    if (GK) DMA_K((t) + 3, sl_cur); if (GV) DMA_V((t) + 1, sl_next); \
    if (MASK) cmask(C0, C1, (t) - (NT - 4), qrel, hi); \
    { const float rm = __builtin_fmaf(rowmax(C0, C1), C2, -mhat); resc = false; \
      if (__builtin_expect(__any(rm > (float)THR), 0)) { const float dl = __builtin_fmaxf(rm, 0.f); mhat += dl; \
          const float f = __builtin_amdgcn_exp2f(-dl); l_reg *= f; if (hi == 0) wsf[r32] = f; resc = true; } } \
    const float nmh = -mhat; SBAR(); \
    GAPBQ(o[0] = MFMA(PAF(0), VFR(0), o[0]), C0, 0, P0, GL, (t) + 1, 0);              GAPBQ(o[1] = MFMA(PAF(0), VFR(4), o[1]), C0, 4, P0, GL, (t) + 1, 1); \
    KRD(GL, 0); GAPBQ(o[0] = MFMA(PAF(1), VFR(1), o[0]), C0, 8, P0, GL, (t) + 1, 2);  KRD(GL, 1); GAPBQ(o[1] = MFMA(PAF(1), VFR(5), o[1]), C0, 12, P0, GL, (t) + 1, 3); \
    KRD(GL, 2); GAPBQ(o[0] = MFMA(PAF(2), VFR(2), o[0]), C1, 0, P1, GL, (t) + 1, 4);  KRD(GL, 3); GAPBQ(o[1] = MFMA(PAF(2), VFR(6), o[1]), C1, 4, P1, GL, (t) + 1, 5); \
    GAPBQ(o[0] = MFMA(PAF(3), VFR(3), o[0]), C1, 8, P1, GL, (t) + 1, 6);              GAPBQ(o[1] = MFMA(PAF(3), VFR(7), o[1]), C1, 12, P1, GL, (t) + 1, 7); \
    } while (0)
  BIAS(pB0, pB1, 1);
  int t = 1;
  for (; t + 5 < NT; t += 2) {
    STEP(pB0, pB1, pA0, pA1, t, false, true, true, true);     WAIT_BAR(2); RESC(); ROT();
    STEP(pA0, pA1, pB0, pB1, t + 1, false, true, true, true); WAIT_BAR(2); RESC(); ROT();
  }
#define ENDW(tt) do { if ((tt) + 3 < NT) { WAIT_BAR(2); } else if ((tt) + 2 < NT) { WAIT_BAR(1); } else { WAIT_BAR(0); } } while (0)
  for (; t + 1 < NT; t += 2) {
    STEP(pB0, pB1, pA0, pA1, t, true, (t + 3 < NT), (t + 1 < NT), (t + 1 < NT));         ENDW(t);     RESC(); ROT();
    STEP(pA0, pA1, pB0, pB1, t + 1, true, (t + 4 < NT), (t + 2 < NT), (t + 2 < NT));     ENDW(t + 1); RESC(); ROT();
  }
  STEP(pB0, pB1, pA0, pA1, NT - 1, true, false, false, false); RESC();
  { float sacc = pB0[0] + pB0[1];
#pragma unroll
    for (int r = 2; r < 16; ++r) sacc += pB0[r];
#pragma unroll
    for (int r = 0; r < 16; ++r) sacc += pB1[r];
    l_reg += sacc;
    pw0 = (u32x4){PKW(pB0, 0), PKW(pB0, 2), PKW(pB0, 4), PKW(pB0, 6)}; pw1 = (u32x4){PKW(pB0, 8), PKW(pB0, 10), PKW(pB0, 12), PKW(pB0, 14)};
    pw2 = (u32x4){PKW(pB1, 0), PKW(pB1, 2), PKW(pB1, 4), PKW(pB1, 6)}; pw3 = (u32x4){PKW(pB1, 8), PKW(pB1, 10), PKW(pB1, 12), PKW(pB1, 14)};
    const lds_cptr vp_ = vp0 + sl_cur; _Pragma("unroll") for (int i = 0; i < 8; ++i) VRD(i);
    o[0] = MFMA(PAF(0), VFR(0), o[0]); o[1] = MFMA(PAF(0), VFR(4), o[1]); o[0] = MFMA(PAF(1), VFR(1), o[0]); o[1] = MFMA(PAF(1), VFR(5), o[1]);
    o[0] = MFMA(PAF(2), VFR(2), o[0]); o[1] = MFMA(PAF(2), VFR(6), o[1]); o[0] = MFMA(PAF(3), VFR(3), o[0]); o[1] = MFMA(PAF(3), VFR(7), o[1]); }
  { auto rr = __builtin_amdgcn_permlane32_swap(__float_as_uint(l_reg), __float_as_uint(l_reg), false, false); l_reg = __uint_as_float(rr[0]) + __uint_as_float(rr[1]); }
  if (hi == 0) wsf[32 + r32] = l_reg; asm volatile("s_waitcnt lgkmcnt(0)" ::: "memory");
  float rli[16];
#pragma unroll
  for (int r = 0; r < 16; ++r) rli[r] = __builtin_amdgcn_rcpf(wsf[32 + crow(r, hi)]);
  u16* Ow = O + (rowbase + q0 + wid * QBLK) * DMO + h * D; u16* stg = (u16*)(lds + LDS_OST) + wid * 2048;
#pragma unroll
  for (int r = 0; r < 16; ++r) { const int orow = crow(r, hi);
#pragma unroll
    for (int d0 = 0; d0 < 2; ++d0) stg[orow * 64 + d0 * 32 + r32] = f2bf(o[d0][r] * rli[r]); }
  asm volatile("s_waitcnt lgkmcnt(0)" ::: "memory");
#pragma unroll
  for (int i = 0; i < 4; ++i) { const int row = i * 8 + (lane >> 3), ch = lane & 7; *(u32x4*)(Ow + (long)row * DMO + ch * 8) = *(const u32x4*)(stg + row * 64 + ch * 8); }
  asm volatile("s_waitcnt lgkmcnt(0)\n\ts_barrier" ::: "memory");
#undef DMA_K
#undef DMA_V
#undef ROT
#undef EX
#undef RESC
#undef BIAS
#undef PKW
#undef PAF
#undef VFR
#undef VRD
#undef KRD
#undef ENDW
#undef GAPA
#undef GAPB
#undef GAPBQ
#undef STEP
}
}

namespace pg8 {
#define PG8_LAS __attribute__((address_space(3)))
typedef unsigned short bf16_t;
typedef short bf16x8 __attribute__((ext_vector_type(8)));
typedef float f32x4 __attribute__((ext_vector_type(4)));
typedef unsigned u32x4 __attribute__((ext_vector_type(4)));
constexpr int BM = 256, BK = 64, HALF = 128, HTB = HALF * BK * 2  , STAGE_BYTES = 8 * HTB, NXCD = 8, WGM = 8;

__host__ __device__ __forceinline__ int lds_byte(int r, int c) { const int st = (r >> 4) * 2 + (c >> 5), rr = r & 15, cc = c & 31, ob = rr * 64 + cc * 2; return st * 1024 + (ob ^ (((ob >> 9) & 1) << 5)); }
__host__ __device__ __forceinline__ void stage_rc(int b, int& R, int& C) { const int st = b / 1024, sb = b % 1024, swz = sb ^ (((sb >> 9) & 1) << 5); R = (st >> 1) * 16 + swz / 64; C = (st & 1) * 32 + (swz % 64) / 2; }
__host__ __device__ __forceinline__ int perm32(int rho) { const int n = rho >> 4, i = rho & 15; return 8 * (i >> 2) + 4 * n + (i & 3); }

struct Unit { int pm, pn; };
struct Gemm { const bf16_t* A; const bf16_t* Bt; int M, N, K; };

struct StaticOrder {
    int nM, nN, nwg, G, c;
    __host__ __device__ void init(int M, int N, int G_, int c_) { nM = M / BM; nN = N / BM; nwg = nM * nN; G = G_; c = c_; }
    __host__ __device__ bool next(int i, Unit& u) const {
        const long L = (long)i * G + c; if (L >= nwg) return false;
        int wgid = (int)L; { const int q = nwg / NXCD, r = nwg % NXCD, xcd = wgid % NXCD, off = wgid / NXCD; wgid = (xcd < r ? xcd * (q + 1) : r * (q + 1) + (xcd - r) * q) + off; }
        const int nig = WGM * nN, gid = wgid / nig, fm = gid * WGM, gsz = (nM - fm) < WGM ? (nM - fm) : WGM;
        u.pm = fm + ((wgid % nig) % gsz); u.pn = (wgid % nig) / gsz; return true;
    }
    __device__ __forceinline__ void a_ready(const Unit&) const {}
    __device__ __forceinline__ void done(const Unit&) const {}
};
__device__ __forceinline__ unsigned cvt_pk_bf16(float lo, float hi) { unsigned r; asm volatile("v_cvt_pk_bf16_f32 %0, %1, %2" : "=v"(r) : "v"(lo), "v"(hi)); return r; }
template <class Epi, class Sched, bool STAMP = false>
__device__ __forceinline__ void gemm_phase(PG8_LAS unsigned char* lds, const Gemm g, const Sched& S, const Epi& E, unsigned long long* stamps) {
    const int tid = threadIdx.x, wid = __builtin_amdgcn_readfirstlane(tid >> 6), lane = tid & 63, wr = wid >> 2, wc = wid & 3, fr = lane & 15, fq = lane >> 4;
    const int K = g.K, nt = K / BK;
    int ts_lo = 0, ts_hi = 0, nts = 0; const unsigned long long rt_entry = STAMP ? (unsigned long long)wall_clock64() : 0ull;
#define PG8_STAMP() do { if (STAMP && wid == 0 && nts < 64) { const unsigned long long _c = (unsigned long long)clock64(); \
        ts_lo = (lane == nts) ? (int)(unsigned)_c : ts_lo; ts_hi = (lane == nts) ? (int)(unsigned)(_c >> 32) : ts_hi; ++nts; } } while (0)
    PG8_STAMP();
    unsigned voffA[2], voffB[2];
#pragma unroll
    for (int i = 0; i < 2; ++i) { int R, C; stage_rc(tid * 16 + i * 8192, R, C); const int Rb = Epi::PERM ? ((R & ~31) + perm32(R & 31)) : R;
        voffA[i] = (unsigned)(R * K + C) * 2u; voffB[i] = (unsigned)(Rb * K + C) * 2u; }
    const size_t kstep = (size_t)(BK * 2);
    const size_t hstep = (size_t)HALF * K * 2;
    const size_t tstep = 2 * hstep;
    const unsigned ldsw = (unsigned)wid * 1024u;
    const int aoff = lds_byte(wr * 64 + fr, fq * 8), boff = lds_byte(wc * 32 + fr, fq * 8);
#define PG8_SA(b, h) (((b) * 2 + (h)) * HTB)
#define PG8_SB(b, h) ((4 + (b) * 2 + (h)) * HTB)
#define PG8_STAGE(bufoff, gbase, voff) do { _Pragma("unroll") for (int _i = 0; _i < 2; ++_i) \
        __builtin_amdgcn_global_load_lds((const unsigned*)((const char*)(gbase) + (voff)[_i]), (PG8_LAS unsigned*)(lds + (bufoff) + ldsw + _i * 8192), 16, 0, 0); } while (0)
#define PG8_LDA(dst, b, h) do { _Pragma("unroll") for (int m = 0; m < 4; ++m) _Pragma("unroll") for (int k = 0; k < 2; ++k) dst[m][k] = *(const PG8_LAS bf16x8*)(lds + PG8_SA(b, h) + aoff + m * 2048 + k * 1024); } while (0)
#define PG8_LDB(dst, b, h) do { _Pragma("unroll") for (int n = 0; n < 2; ++n) _Pragma("unroll") for (int k = 0; k < 2; ++k) dst[n][k] = *(const PG8_LAS bf16x8*)(lds + PG8_SB(b, h) + boff + n * 2048 + k * 1024); } while (0)
#define PG8_MMA(ai, bj, At, Bt) do { __builtin_amdgcn_s_setprio(1); _Pragma("unroll") for (int m = 0; m < 4; ++m) _Pragma("unroll") for (int n = 0; n < 2; ++n) _Pragma("unroll") for (int k = 0; k < 2; ++k) \
        acc[ai][bj][m][n] = __builtin_amdgcn_mfma_f32_16x16x32_bf16(Bt[n][k], At[m][k], acc[ai][bj][m][n], 0, 0, 0); __builtin_amdgcn_s_setprio(0); } while (0)
#define PG8_WAIT_V(n) asm volatile("s_waitcnt vmcnt(" #n ")" ::: "memory")
#define PG8_WAIT_L(n) asm volatile("s_waitcnt lgkmcnt(" #n ")" ::: "memory")
#define PG8_BAR __builtin_amdgcn_s_barrier()
#define PG8_SCHED __builtin_amdgcn_sched_barrier(0)
    Unit cur, nxt; int ui = 0;
    if (!S.next(0, cur)) return;
    f32x4 acc[2][2][4][2];
#pragma unroll
    for (int a = 0; a < 2; ++a)
#pragma unroll
        for (int b = 0; b < 2; ++b)
#pragma unroll
            for (int m = 0; m < 4; ++m)
#pragma unroll
                for (int n = 0; n < 2; ++n) acc[a][b][m][n] = (f32x4){0.f, 0.f, 0.f, 0.f};
    bf16x8 At[4][2], B0[2][2], B1[2][2];
    const char* cA = (const char*)g.A + (size_t)cur.pm * tstep; const char* cB = (const char*)g.Bt + (size_t)cur.pn * tstep;
    S.a_ready(cur);
    PG8_STAGE(PG8_SB(0, 0), cB, voffB); PG8_STAGE(PG8_SA(0, 0), cA, voffA); PG8_STAGE(PG8_SB(0, 1), cB + hstep, voffB); PG8_STAGE(PG8_SA(0, 1), cA + hstep, voffA);
    if (wr == 1) PG8_BAR;
    PG8_WAIT_V(4); PG8_BAR;
    PG8_STAGE(PG8_SB(1, 0), cB + kstep, voffB); PG8_STAGE(PG8_SA(1, 0), cA + kstep, voffA); PG8_STAGE(PG8_SB(1, 1), cB + hstep + kstep, voffB);
    PG8_WAIT_V(6); PG8_BAR;
    PG8_STAMP();
    for (;;) {
        const bool has_next = S.next(ui + 1, nxt);
        const char* nA = has_next ? (const char*)g.A + (size_t)nxt.pm * tstep : cA; const char* nB = has_next ? (const char*)g.Bt + (size_t)nxt.pn * tstep : cB;
        for (int t = 0; t < nt; t += 2) {
            const bool last = (t == nt - 2);
            const char* a1 = cA + (size_t)(t + 1) * kstep;
            const char* a2 = last ? nA : cA + (size_t)(t + 2) * kstep; const char* b2 = last ? nB : cB + (size_t)(t + 2) * kstep;
            const char* a3 = a2 + kstep; const char* b3 = b2 + kstep;
            if (last && has_next) S.a_ready(nxt);
            PG8_LDB(B0, 0, 0); PG8_SCHED; PG8_LDA(At, 0, 0); PG8_STAGE(PG8_SA(1, 1), a1 + hstep, voffA);
            PG8_WAIT_L(8); PG8_BAR; PG8_WAIT_L(0); PG8_MMA(0, 0, At, B0); PG8_BAR; PG8_SCHED;
            PG8_LDB(B1, 0, 1); PG8_STAGE(PG8_SB(0, 0), b2, voffB);
            PG8_BAR; PG8_WAIT_L(0); PG8_MMA(0, 1, At, B1); PG8_BAR;
            PG8_LDA(At, 0, 1); PG8_STAGE(PG8_SA(0, 0), a2, voffA);
            PG8_BAR; PG8_WAIT_L(0); PG8_MMA(1, 0, At, B0); PG8_BAR; PG8_SCHED;
            PG8_STAGE(PG8_SB(0, 1), b2 + hstep, voffB);
            PG8_WAIT_V(6); PG8_BAR; PG8_MMA(1, 1, At, B1); PG8_BAR;
            PG8_LDB(B0, 1, 0); PG8_SCHED; PG8_LDA(At, 1, 0); PG8_STAGE(PG8_SA(0, 1), a2 + hstep, voffA);
            PG8_WAIT_L(8); PG8_BAR; PG8_WAIT_L(0); PG8_MMA(0, 0, At, B0); PG8_BAR; PG8_SCHED;
            PG8_LDB(B1, 1, 1); PG8_STAGE(PG8_SB(1, 0), b3, voffB);
            PG8_BAR; PG8_WAIT_L(0); PG8_MMA(0, 1, At, B1); PG8_BAR;
            PG8_LDA(At, 1, 1); PG8_STAGE(PG8_SA(1, 0), a3, voffA);
            PG8_BAR; PG8_WAIT_L(0); PG8_MMA(1, 0, At, B0); PG8_BAR; PG8_SCHED;
            PG8_STAGE(PG8_SB(1, 1), b3 + hstep, voffB);
            PG8_WAIT_V(6); PG8_BAR; PG8_MMA(1, 1, At, B1); PG8_BAR;
        }
        PG8_STAMP();
        if constexpr (!Epi::AFTER_DRAIN) { E(acc, cur, wr, wc, fr, fq); S.done(cur); }
        PG8_STAMP();
        if (!has_next) break;
#pragma unroll
        for (int a = 0; a < 2; ++a)
#pragma unroll
            for (int b = 0; b < 2; ++b)
#pragma unroll
                for (int m = 0; m < 4; ++m)
#pragma unroll
                    for (int n = 0; n < 2; ++n) acc[a][b][m][n] = (f32x4){0.f, 0.f, 0.f, 0.f};
        cur = nxt; cA = nA; cB = nB; ++ui;
    }
    PG8_WAIT_V(0);
    if (wr == 0) PG8_BAR;
    PG8_BAR;
    if constexpr (Epi::AFTER_DRAIN) { E.fused(acc, cur, wr, wc, fr, fq, lds, wid, lane); S.done(cur); }
    PG8_STAMP();
    if (STAMP && wid == 0) { stamps[lane] = lane < nts ? (((unsigned long long)(unsigned)ts_hi << 32) | (unsigned)ts_lo) : 0ull;
        if (lane == 62) stamps[62] = rt_entry; if (lane == 63) stamps[63] = (unsigned long long)wall_clock64(); }
#undef PG8_STAMP
#undef PG8_SA
#undef PG8_SB
#undef PG8_STAGE
#undef PG8_LDA
#undef PG8_LDB
#undef PG8_MMA
#undef PG8_WAIT_V
#undef PG8_WAIT_L
#undef PG8_BAR
#undef PG8_SCHED
}
}

namespace pg8 {
struct BUnit { long aoff, boff; int id; };
template <bool PERM, int K, int lda, int ldb, class UF, class Epi>
__device__ __forceinline__ void gemm_phase_b(PG8_LAS unsigned char* lds, const bf16_t* Ab, const bf16_t* Bb, const int nunits, const UF& uf, const Epi& E) {
    constexpr bool STAMP = false; unsigned long long* stamps = nullptr; (void)stamps;
    const int Gg = (int)gridDim.x, cc_ = (int)blockIdx.x;
    auto nextu = [&](int i, BUnit& u) -> bool { const long L = (long)i * Gg + cc_; if (L >= nunits) return false; u = uf((int)L); return true; };
    const int tid = threadIdx.x, wid = __builtin_amdgcn_readfirstlane(tid >> 6), lane = tid & 63, wr = wid >> 2, wc = wid & 3, fr = lane & 15, fq = lane >> 4;
    const int nt = K / BK;
    int ts_lo = 0, ts_hi = 0, nts = 0; const unsigned long long rt_entry = STAMP ? (unsigned long long)wall_clock64() : 0ull;
#define PG8_STAMP() do { if (STAMP && wid == 0 && nts < 64) { const unsigned long long _c = (unsigned long long)clock64(); \
        ts_lo = (lane == nts) ? (int)(unsigned)_c : ts_lo; ts_hi = (lane == nts) ? (int)(unsigned)(_c >> 32) : ts_hi; ++nts; } } while (0)
    PG8_STAMP();
    unsigned voffA[2], voffB[2];
#pragma unroll
    for (int i = 0; i < 2; ++i) { int R, C; stage_rc(tid * 16 + i * 8192, R, C); const int Rb = PERM ? ((R & ~31) + perm32(R & 31)) : R;
        voffA[i] = (unsigned)(R * lda + C) * 2u; voffB[i] = (unsigned)(Rb * ldb + C) * 2u; }
    const size_t kstep = (size_t)(BK * 2);
    const size_t hstepA = (size_t)HALF * lda * 2, hstepB = (size_t)HALF * ldb * 2;
    const unsigned ldsw = (unsigned)wid * 1024u;
    const int aoff = lds_byte(wr * 64 + fr, fq * 8), boff = lds_byte(wc * 32 + fr, fq * 8);
#define PG8_SA(b, h) (((b) * 2 + (h)) * HTB)
#define PG8_SB(b, h) ((4 + (b) * 2 + (h)) * HTB)
#define PG8_STAGE(bufoff, gbase, voff) do { _Pragma("unroll") for (int _i = 0; _i < 2; ++_i) \
        __builtin_amdgcn_global_load_lds((const unsigned*)((const char*)(gbase) + (voff)[_i]), (PG8_LAS unsigned*)(lds + (bufoff) + ldsw + _i * 8192), 16, 0, 0); } while (0)
#define PG8_LDA(dst, b, h) do { _Pragma("unroll") for (int m = 0; m < 4; ++m) _Pragma("unroll") for (int k = 0; k < 2; ++k) dst[m][k] = *(const PG8_LAS bf16x8*)(lds + PG8_SA(b, h) + aoff + m * 2048 + k * 1024); } while (0)
#define PG8_LDB(dst, b, h) do { _Pragma("unroll") for (int n = 0; n < 2; ++n) _Pragma("unroll") for (int k = 0; k < 2; ++k) dst[n][k] = *(const PG8_LAS bf16x8*)(lds + PG8_SB(b, h) + boff + n * 2048 + k * 1024); } while (0)
#define PG8_MMA(ai, bj, At, Bt) do { __builtin_amdgcn_s_setprio(1); _Pragma("unroll") for (int m = 0; m < 4; ++m) _Pragma("unroll") for (int n = 0; n < 2; ++n) _Pragma("unroll") for (int k = 0; k < 2; ++k) \
        acc[ai][bj][m][n] = __builtin_amdgcn_mfma_f32_16x16x32_bf16(Bt[n][k], At[m][k], acc[ai][bj][m][n], 0, 0, 0); __builtin_amdgcn_s_setprio(0); } while (0)
#define PG8_WAIT_V(n) asm volatile("s_waitcnt vmcnt(" #n ")" ::: "memory")
#define PG8_WAIT_L(n) asm volatile("s_waitcnt lgkmcnt(" #n ")" ::: "memory")
#define PG8_BAR __builtin_amdgcn_s_barrier()
#define PG8_SCHED __builtin_amdgcn_sched_barrier(0)
    BUnit cur, nxt; int ui = 0;
    if (!nextu(0, cur)) return;
    f32x4 acc[2][2][4][2];
#pragma unroll
    for (int a = 0; a < 2; ++a)
#pragma unroll
        for (int b = 0; b < 2; ++b)
#pragma unroll
            for (int m = 0; m < 4; ++m)
#pragma unroll
                for (int n = 0; n < 2; ++n) acc[a][b][m][n] = (f32x4){0.f, 0.f, 0.f, 0.f};
    bf16x8 At[4][2], B0[2][2], B1[2][2];
    const char* cA = (const char*)Ab + cur.aoff * 2; const char* cB = (const char*)Bb + cur.boff * 2;
    PG8_STAGE(PG8_SB(0, 0), cB, voffB); PG8_STAGE(PG8_SA(0, 0), cA, voffA); PG8_STAGE(PG8_SB(0, 1), cB + hstepB, voffB); PG8_STAGE(PG8_SA(0, 1), cA + hstepA, voffA);
    if (wr == 1) PG8_BAR;
    PG8_WAIT_V(4); PG8_BAR;
    PG8_STAGE(PG8_SB(1, 0), cB + kstep, voffB); PG8_STAGE(PG8_SA(1, 0), cA + kstep, voffA); PG8_STAGE(PG8_SB(1, 1), cB + hstepB + kstep, voffB);
    PG8_WAIT_V(6); PG8_BAR;
    PG8_STAMP();
    for (;;) {
        const bool has_next = nextu(ui + 1, nxt);
        const char* nA = has_next ? (const char*)Ab + nxt.aoff * 2 : cA; const char* nB = has_next ? (const char*)Bb + nxt.boff * 2 : cB;
        for (int t = 0; t < nt; t += 2) {
            const bool last = (t == nt - 2);
            const char* a1 = cA + (size_t)(t + 1) * kstep;
            const char* a2 = last ? nA : cA + (size_t)(t + 2) * kstep; const char* b2 = last ? nB : cB + (size_t)(t + 2) * kstep;
            const char* a3 = a2 + kstep; const char* b3 = b2 + kstep;
            PG8_LDB(B0, 0, 0); PG8_SCHED; PG8_LDA(At, 0, 0); PG8_STAGE(PG8_SA(1, 1), a1 + hstepA, voffA);
            PG8_WAIT_L(8); PG8_BAR; PG8_WAIT_L(0); PG8_MMA(0, 0, At, B0); PG8_BAR; PG8_SCHED;
            PG8_LDB(B1, 0, 1); PG8_STAGE(PG8_SB(0, 0), b2, voffB);
            PG8_BAR; PG8_WAIT_L(0); PG8_MMA(0, 1, At, B1); PG8_BAR;
            PG8_LDA(At, 0, 1); PG8_STAGE(PG8_SA(0, 0), a2, voffA);
            PG8_BAR; PG8_WAIT_L(0); PG8_MMA(1, 0, At, B0); PG8_BAR; PG8_SCHED;
            PG8_STAGE(PG8_SB(0, 1), b2 + hstepB, voffB);
            PG8_WAIT_V(6); PG8_BAR; PG8_MMA(1, 1, At, B1); PG8_BAR;
            PG8_LDB(B0, 1, 0); PG8_SCHED; PG8_LDA(At, 1, 0); PG8_STAGE(PG8_SA(0, 1), a2 + hstepA, voffA);
            PG8_WAIT_L(8); PG8_BAR; PG8_WAIT_L(0); PG8_MMA(0, 0, At, B0); PG8_BAR; PG8_SCHED;
            PG8_LDB(B1, 1, 1); PG8_STAGE(PG8_SB(1, 0), b3, voffB);
            PG8_BAR; PG8_WAIT_L(0); PG8_MMA(0, 1, At, B1); PG8_BAR;
            PG8_LDA(At, 1, 1); PG8_STAGE(PG8_SA(1, 0), a3, voffA);
            PG8_BAR; PG8_WAIT_L(0); PG8_MMA(1, 0, At, B0); PG8_BAR; PG8_SCHED;
            PG8_STAGE(PG8_SB(1, 1), b3 + hstepB, voffB);
            PG8_WAIT_V(6); PG8_BAR; PG8_MMA(1, 1, At, B1); PG8_BAR;
        }
        PG8_STAMP();
        E(acc, cur, wr, wc, fr, fq);
        PG8_STAMP();
        if (!has_next) break;
#pragma unroll
        for (int a = 0; a < 2; ++a)
#pragma unroll
            for (int b = 0; b < 2; ++b)
#pragma unroll
                for (int m = 0; m < 4; ++m)
#pragma unroll
                    for (int n = 0; n < 2; ++n) acc[a][b][m][n] = (f32x4){0.f, 0.f, 0.f, 0.f};
        cur = nxt; cA = nA; cB = nB; ++ui;
    }
    PG8_WAIT_V(0);
    if (wr == 0) PG8_BAR;
    PG8_BAR;
    PG8_STAMP();
    if (STAMP && wid == 0) { stamps[lane] = lane < nts ? (((unsigned long long)(unsigned)ts_hi << 32) | (unsigned)ts_lo) : 0ull;
        if (lane == 62) stamps[62] = rt_entry; if (lane == 63) stamps[63] = (unsigned long long)wall_clock64(); }
#undef PG8_STAMP
#undef PG8_SA
#undef PG8_SB
#undef PG8_STAGE
#undef PG8_LDA
#undef PG8_LDB
#undef PG8_MMA
#undef PG8_WAIT_V
#undef PG8_WAIT_L
#undef PG8_BAR
#undef PG8_SCHED
}
}

namespace pg8 {
struct MUnit { int e, mt, pn, base, ce; };
template <int MODE, bool PERM, class Epi>
__device__ __forceinline__ void gemm_phase_moe(PG8_LAS unsigned char* lds, const bf16_t* Ab, const bf16_t* Bb, const int K, const size_t bstrideE,
                                               const int* __restrict__ cnt, const int* __restrict__ lists, const int listT, const Epi& E) {
    const int tid = threadIdx.x, wid = __builtin_amdgcn_readfirstlane(tid >> 6), lane = tid & 63, wr = wid >> 2, wc = wid & 3, fr = lane & 15, fq = lane >> 4;
    const int nt = K / BK; const int G = (int)gridDim.x, c = (int)blockIdx.x;
    int ce16[16];
#pragma unroll
    for (int j = 0; j < 16; ++j) ce16[j] = cnt[j];
    auto next = [&](int i, MUnit& u) -> bool {
        const int L = i * G + c; int at = 0, b = 0; bool found = false; u.e = 0; u.mt = 0; u.pn = 0; u.base = 0; u.ce = 1;
#pragma unroll
        for (int j = 0; j < 16; ++j) { const int cj = ce16[j]; const int tl = (cj >> 8) * 4;
            if (!found && L < at + tl) { const int r = L - at; u.e = j; u.mt = r >> 2; u.pn = r & 3; u.base = b; u.ce = cj; found = true; }
            at += tl; b += cj; }
        return found;
    };
    int Rl[2], Cl[2]; unsigned voffB[2];
#pragma unroll
    for (int i = 0; i < 2; ++i) { int R, C; stage_rc(tid * 16 + i * 8192, R, C); Rl[i] = R; Cl[i] = C; const int Rb = PERM ? ((R & ~31) + perm32(R & 31)) : R; voffB[i] = (unsigned)(Rb * K + C) * 2u; }
    auto aoffs = [&](const MUnit& u, unsigned (&v)[2][2]) {
#pragma unroll
        for (int h = 0; h < 2; ++h)
#pragma unroll
            for (int i = 0; i < 2; ++i) { int slot = u.mt * 256 + h * 128 + Rl[i]; slot = slot < u.ce ? slot : u.ce - 1;
                const int row = (MODE == 0) ? (lists[u.e * listT + slot] >> 1) : (u.base + slot);
                v[h][i] = (unsigned)(row * K + Cl[i]) * 2u; }
    };
    const size_t kstep = (size_t)(BK * 2); const size_t hstep = (size_t)HALF * K * 2; const size_t tstep = 2 * hstep;
    const unsigned ldsw = (unsigned)wid * 1024u;
    const int aoff = lds_byte(wr * 64 + fr, fq * 8), boff = lds_byte(wc * 32 + fr, fq * 8);
#define PG8_SA(b, h) (((b) * 2 + (h)) * HTB)
#define PG8_SB(b, h) ((4 + (b) * 2 + (h)) * HTB)
#define PG8_STAGE(bufoff, gbase, voff) do { _Pragma("unroll") for (int _i = 0; _i < 2; ++_i) \
        __builtin_amdgcn_global_load_lds((const unsigned*)((const char*)(gbase) + (voff)[_i]), (PG8_LAS unsigned*)(lds + (bufoff) + ldsw + _i * 8192), 16, 0, 0); } while (0)
#define PG8_LDA(dst, b, h) do { _Pragma("unroll") for (int m = 0; m < 4; ++m) _Pragma("unroll") for (int k = 0; k < 2; ++k) dst[m][k] = *(const PG8_LAS bf16x8*)(lds + PG8_SA(b, h) + aoff + m * 2048 + k * 1024); } while (0)
#define PG8_LDB(dst, b, h) do { _Pragma("unroll") for (int n = 0; n < 2; ++n) _Pragma("unroll") for (int k = 0; k < 2; ++k) dst[n][k] = *(const PG8_LAS bf16x8*)(lds + PG8_SB(b, h) + boff + n * 2048 + k * 1024); } while (0)
#define PG8_MMA(ai, bj, At, Bt) do { __builtin_amdgcn_s_setprio(1); _Pragma("unroll") for (int m = 0; m < 4; ++m) _Pragma("unroll") for (int n = 0; n < 2; ++n) _Pragma("unroll") for (int k = 0; k < 2; ++k) \
        acc[ai][bj][m][n] = __builtin_amdgcn_mfma_f32_16x16x32_bf16(Bt[n][k], At[m][k], acc[ai][bj][m][n], 0, 0, 0); __builtin_amdgcn_s_setprio(0); } while (0)
#define PG8_WAIT_V(n) asm volatile("s_waitcnt vmcnt(" #n ")" ::: "memory")
#define PG8_WAIT_L(n) asm volatile("s_waitcnt lgkmcnt(" #n ")" ::: "memory")
#define PG8_BAR __builtin_amdgcn_s_barrier()
#define PG8_SCHED __builtin_amdgcn_sched_barrier(0)
    MUnit cur, nxt; int ui = 0;
    if (!next(0, cur)) return;
    f32x4 acc[2][2][4][2];
#pragma unroll
    for (int a = 0; a < 2; ++a)
#pragma unroll
        for (int b = 0; b < 2; ++b)
#pragma unroll
            for (int m = 0; m < 4; ++m)
#pragma unroll
                for (int n = 0; n < 2; ++n) acc[a][b][m][n] = (f32x4){0.f, 0.f, 0.f, 0.f};
    bf16x8 At[4][2], B0[2][2], B1[2][2];
    unsigned curA[2][2], nxtA[2][2];
    aoffs(cur, curA);
    const char* gA = (const char*)Ab;
    const char* cB = (const char*)Bb + (size_t)cur.e * bstrideE + (size_t)cur.pn * tstep;
    PG8_STAGE(PG8_SB(0, 0), cB, voffB); PG8_STAGE(PG8_SA(0, 0), gA, curA[0]); PG8_STAGE(PG8_SB(0, 1), cB + hstep, voffB); PG8_STAGE(PG8_SA(0, 1), gA, curA[1]);
    if (wr == 1) PG8_BAR;
    PG8_WAIT_V(4); PG8_BAR;
    PG8_STAGE(PG8_SB(1, 0), cB + kstep, voffB); PG8_STAGE(PG8_SA(1, 0), gA + kstep, curA[0]); PG8_STAGE(PG8_SB(1, 1), cB + hstep + kstep, voffB);
    PG8_WAIT_V(6); PG8_BAR;
    for (;;) {
        const bool has_next = next(ui + 1, nxt);
        if (has_next) aoffs(nxt, nxtA);
        else {
#pragma unroll
            for (int h = 0; h < 2; ++h)
#pragma unroll
                for (int i = 0; i < 2; ++i) nxtA[h][i] = curA[h][i];
        }
        const char* nB = has_next ? (const char*)Bb + (size_t)nxt.e * bstrideE + (size_t)nxt.pn * tstep : cB;
        for (int t = 0; t < nt; t += 2) {
            const bool last = (t == nt - 2);
            const char* a1 = gA + (size_t)(t + 1) * kstep;
            const char* a2 = last ? gA : gA + (size_t)(t + 2) * kstep; const char* b2 = last ? nB : cB + (size_t)(t + 2) * kstep;
            const char* a3 = a2 + kstep; const char* b3 = b2 + kstep;
            unsigned s0[2], s1[2];
            s0[0] = last ? nxtA[0][0] : curA[0][0]; s0[1] = last ? nxtA[0][1] : curA[0][1];
            s1[0] = last ? nxtA[1][0] : curA[1][0]; s1[1] = last ? nxtA[1][1] : curA[1][1];
            PG8_LDB(B0, 0, 0); PG8_SCHED; PG8_LDA(At, 0, 0); PG8_STAGE(PG8_SA(1, 1), a1, curA[1]);
            PG8_WAIT_L(8); PG8_BAR; PG8_WAIT_L(0); PG8_MMA(0, 0, At, B0); PG8_BAR; PG8_SCHED;
            PG8_LDB(B1, 0, 1); PG8_STAGE(PG8_SB(0, 0), b2, voffB);
            PG8_BAR; PG8_WAIT_L(0); PG8_MMA(0, 1, At, B1); PG8_BAR;
            PG8_LDA(At, 0, 1); PG8_STAGE(PG8_SA(0, 0), a2, s0);
            PG8_BAR; PG8_WAIT_L(0); PG8_MMA(1, 0, At, B0); PG8_BAR; PG8_SCHED;
            PG8_STAGE(PG8_SB(0, 1), b2 + hstep, voffB);
            PG8_WAIT_V(6); PG8_BAR; PG8_MMA(1, 1, At, B1); PG8_BAR;
            PG8_LDB(B0, 1, 0); PG8_SCHED; PG8_LDA(At, 1, 0); PG8_STAGE(PG8_SA(0, 1), a2, s1);
            PG8_WAIT_L(8); PG8_BAR; PG8_WAIT_L(0); PG8_MMA(0, 0, At, B0); PG8_BAR; PG8_SCHED;
            PG8_LDB(B1, 1, 1); PG8_STAGE(PG8_SB(1, 0), b3, voffB);
            PG8_BAR; PG8_WAIT_L(0); PG8_MMA(0, 1, At, B1); PG8_BAR;
            PG8_LDA(At, 1, 1); PG8_STAGE(PG8_SA(1, 0), a3, s0);
            PG8_BAR; PG8_WAIT_L(0); PG8_MMA(1, 0, At, B0); PG8_BAR; PG8_SCHED;
            PG8_STAGE(PG8_SB(1, 1), b3 + hstep, voffB);
            PG8_WAIT_V(6); PG8_BAR; PG8_MMA(1, 1, At, B1); PG8_BAR;
        }
        E(acc, cur, wr, wc, fr, fq);
        if (!has_next) break;
#pragma unroll
        for (int a = 0; a < 2; ++a)
#pragma unroll
            for (int b = 0; b < 2; ++b)
#pragma unroll
                for (int m = 0; m < 4; ++m)
#pragma unroll
                    for (int n = 0; n < 2; ++n) acc[a][b][m][n] = (f32x4){0.f, 0.f, 0.f, 0.f};
        cur = nxt; cB = nB; ++ui;
#pragma unroll
        for (int h = 0; h < 2; ++h)
#pragma unroll
            for (int i = 0; i < 2; ++i) curA[h][i] = nxtA[h][i];
    }
    PG8_WAIT_V(0);
    if (wr == 0) PG8_BAR;
    PG8_BAR;
#undef PG8_SA
#undef PG8_SB
#undef PG8_STAGE
#undef PG8_LDA
#undef PG8_LDB
#undef PG8_MMA
#undef PG8_WAIT_V
#undef PG8_WAIT_L
#undef PG8_BAR
#undef PG8_SCHED
}
}

template <bool PERM_, class F> struct EpiL {
  static constexpr bool PERM = PERM_, AFTER_DRAIN = false; F f;
  __device__ __forceinline__ void operator()(const pg8::f32x4 (&acc)[2][2][4][2], const pg8::Unit& u, int wr, int wc, int fr, int fq) const { f(acc, u, wr, wc, fr, fq); }
};
template <bool PERM_, class F>
DEVI void big_gemm(char* smem, const u16* A, const u16* Bt, int M, int N, int K, F f) {
  pg8::Gemm g{A, Bt, M, N, K}; pg8::StaticOrder S; S.init(M, N, (int)gridDim.x, (int)blockIdx.x);
  EpiL<PERM_, F> E{f};
  pg8::gemm_phase<EpiL<PERM_, F>, pg8::StaticOrder, false>((PG8_LAS unsigned char*)smem, g, S, E, nullptr);
}
DEVI uint4 pk8(const f32x4& a, const f32x4& b) { return make_uint4(pg8::cvt_pk_bf16(a[0], a[1]), pg8::cvt_pk_bf16(a[2], a[3]), pg8::cvt_pk_bf16(b[0], b[1]), pg8::cvt_pk_bf16(b[2], b[3])); }

#define XB_TMO      128
#define XB_XCNT(j)  (256  + 64 * (j))
#define XB_XSUB(j)  (1280 + 64 * (j))
#define XB_XGEN(j)  (2304 + 64 * (j))
#define XB_TOP      3328
#define XB_TOPGEN   3392
#define XCD_BAR_WORDS 3456
#define XB_SPIN_CAP (1u << 18)
#define LAS __attribute__((address_space(3)))

__device__ __forceinline__ unsigned xb_ld(unsigned* p)              { return __hip_atomic_load(p, __ATOMIC_RELAXED, __HIP_MEMORY_SCOPE_AGENT); }
__device__ __forceinline__ unsigned xb_add(unsigned* p, unsigned v) { return __hip_atomic_fetch_add(p, v, __ATOMIC_RELAXED, __HIP_MEMORY_SCOPE_AGENT); }
__device__ __forceinline__ unsigned xb_xcc_id() { return (unsigned)__builtin_amdgcn_s_getreg((3 << 11) | 20) & 0xFu; }
#define XB_SPIN(cond, bar) do { unsigned _sp = 0; while (cond) { __builtin_amdgcn_s_sleep(1); \
    if ((++_sp & 255u) == 0u) { if (xb_ld(&(bar)[XB_TMO])) break; if (_sp > XB_SPIN_CAP) { atomicAdd(&(bar)[XB_TMO], 1u); break; } } } } while (0)

struct XcdBarrier {
    unsigned* bar; unsigned x;
    volatile LAS unsigned* st;
};

__device__ __forceinline__ XcdBarrier xcd_barrier_post(unsigned* bar, volatile LAS unsigned* st) {
    XcdBarrier b; b.bar = bar; b.x = xb_xcc_id(); b.st = st;
    if (threadIdx.x == 0) (void)xb_add(&bar[XB_XCNT(b.x)], 1u);
    return b;
}
__device__ __forceinline__ void xcd_barrier_complete(unsigned* bar, unsigned x, unsigned& nloc, unsigned& nx) {
    const unsigned G = gridDim.x * gridDim.y * gridDim.z;
    unsigned sum, cnt, mine, sp = 0u;
    for (;;) {
        sum = 0u; cnt = 0u; mine = 0u;
#pragma unroll
        for (unsigned j = 0; j < 16; ++j) { const unsigned c = xb_ld(&bar[XB_XCNT(j)]); sum += c; cnt += (c > 0u) ? 1u : 0u; mine = (j == x) ? c : mine; }
        if (sum == G) break;
        __builtin_amdgcn_s_sleep(1);
        if ((++sp & 255u) == 0u) { if (xb_ld(&bar[XB_TMO])) break; if (sp > XB_SPIN_CAP) { atomicAdd(&bar[XB_TMO], 1u); break; } }
    }
    nloc = mine > 0u ? mine : 1u; nx = cnt > 0u ? cnt : 1u;
}

__device__ __forceinline__ void xcd_barrier(const XcdBarrier& b) {
    asm volatile("s_waitcnt vmcnt(0)" ::: "memory");
    __syncthreads();
    if (threadIdx.x == 0) {
        unsigned* bar = b.bar;
        __builtin_amdgcn_s_waitcnt(0);
        unsigned nloc = b.st[0], nx = b.st[1];
        if (nloc == 0u) { xcd_barrier_complete(bar, b.x, nloc, nx); b.st[0] = nloc; b.st[1] = nx; }
        const unsigned old = xb_add(&bar[XB_XSUB(b.x)], 1u);
        const unsigned gen = old / nloc;
        if (old + 1u == (gen + 1u) * nloc) {
            __builtin_amdgcn_fence(__ATOMIC_RELEASE, "agent");
            asm volatile("s_waitcnt vmcnt(0)" ::: "memory");
            const unsigned og = xb_add(&bar[XB_TOP], 1u);
            const unsigned tg = og / nx;
            if (og + 1u == (tg + 1u) * nx) xb_add(&bar[XB_TOPGEN], 1u);
            else XB_SPIN(xb_ld(&bar[XB_TOPGEN]) == tg, bar);
            __builtin_amdgcn_fence(__ATOMIC_ACQUIRE, "agent");
            xb_add(&bar[XB_XGEN(b.x)], 1u);
            asm volatile("s_waitcnt vmcnt(0)" ::: "memory");
        } else {
            XB_SPIN(xb_ld(&bar[XB_XGEN(b.x)]) == gen, bar);
            __builtin_amdgcn_fence(__ATOMIC_ACQUIRE, "agent");
            asm volatile("s_waitcnt vmcnt(0)" ::: "memory");
        }
    }
    __syncthreads();
}


template <int ph>
DEVI void run_phase(const P& p, char* smem) {
  const int half = threadIdx.x >> 8, tid = threadIdx.x & 255;
  const int vb = blockIdx.x * 2 + half, nvb = gridDim.x * 2;
  const int vbx = ((gridDim.x & 7u) == 0u) ? (int)((blockIdx.x & 7u) * (unsigned)(nvb >> 3) + (blockIdx.x >> 3) * 2u + (unsigned)half) : vb;
  (void)vbx;
  char* hl = smem + half * 65536;
  const int lane = threadIdx.x & 63;
  const int gw = blockIdx.x * 8 + (threadIdx.x >> 6), nw = gridDim.x * 8;
  char* ws = p.ws;
  (void)hl; (void)lane; (void)gw; (void)nw; (void)vb; (void)nvb; (void)tid;
  {
    constexpr int layer = (ph >= 10) ? 1 : 0;
    switch (ph) {
    case 0: {
      float* tl = (float*)smem;
      if (blockIdx.x == 0 && threadIdx.x < 32) ((int*)(ws + CNT))[threadIdx.x] = 0;
      econv(p.x, (u16*)(ws + XB0), (size_t)T * 1024);
      econv(p.p, (u16*)(ws + PB), (size_t)T * 256);
      tconv(p.fox_w_in, 0, 3088, 1024, 3072, 1, (u16*)(ws + W0_QKV), 0, 0, tl);
      {
        const int gt = blockIdx.x * 512 + threadIdx.x;
        if (gt < 16384) { const int n = gt >> 10, k = gt & 1023; ((u16*)(ws + W0_QKV))[(size_t)(3072 + n) * 1024 + k] = f2bf(p.fox_w_in[(size_t)k * 3088 + 3072 + n]); }
      }
      tconv(p.fox_w_out, 0, 1024, 1024, 1024, 1, (u16*)(ws + W0_OUT), 0, 0, tl);
      tconv(p.w_gate, 1024 * 512, 512, 1024, 512, 16, (u16*)(ws + W0_GU), 1024 * 1024, 1, tl);
      tconv(p.w_up, 1024 * 512, 512, 1024, 512, 16, (u16*)(ws + W0_GU), 1024 * 1024, 2, tl);
      tconv(p.w_down, 512 * 1024, 1024, 512, 1024, 16, (u16*)(ws + W0_D), 1024 * 512, 0, tl);
      tconv(p.ple_gate, 0, 1024, 1024, 1024, 1, (u16*)(ws + W0_PG), 0, 0, tl);
      tconv(p.ple_proj, 0, 1024, 256, 1024, 1, (u16*)(ws + W0_PP), 0, 0, tl);
    } break;
    case 1: {
      const u16* xb = (const u16*)(ws + XB0); const u16* w = (const u16*)(ws + W0_QKV);
      u16* qkv = (u16*)(ws + QKV0); float* logf_ = (float*)(ws + LOGF);
      big_gemm<true>(smem, xb, w, T, 3072, 1024, [=](const f32x4 (&acc)[2][2][4][2], const pg8::Unit& u, int wr, int wc, int fr, int fq) {
        const int row0 = u.pm * 256 + wr * 64 + fr, col0 = u.pn * 256 + wc * 32 + 8 * fq;
#pragma unroll
        for (int ai = 0; ai < 2; ++ai)
#pragma unroll
          for (int m = 0; m < 4; ++m) { u16* rowp = qkv + (size_t)(row0 + ai * 128 + m * 16) * 3072 + col0;
#pragma unroll
            for (int bj = 0; bj < 2; ++bj) *reinterpret_cast<uint4*>(rowp + bj * 128) = pk8(acc[ai][bj][m][0], acc[ai][bj][m][1]); }
      });
      run_tiles(128, vb, nvb, [&](int tile, bool valid) {
        const int mt = tile;
        GemmLoad L; set_seg1(L, xb + (size_t)mt * 128 * 1024, 1024, w + (size_t)24 * 128 * 1024, 1024, valid ? 16 : 0, tid);
        gemm_tile(L, 16, hl, tid, [&](f32x4 (&acc)[4][4], int wr, int wc, int fr, int fq) {
          if (!valid || wc != 0) return;
#pragma unroll
          for (int m = 0; m < 4; ++m) {
            const int row = mt * 128 + wr * 64 + m * 16 + fr;
#pragma unroll
            for (int j = 0; j < 4; ++j) { const int h = fq * 4 + j;
              logf_[(size_t)((row >> 12) * 16 + h) * SEQ + (row & 4095)] = logsig(acc[m][0][j] + p.fox_b_f[h]); }
          }
        });
      });
    } break;
    case 2: {
      const float* logf_ = (const float*)(ws + LOGF); float* c8 = (float*)(ws + C8); float* red = (float*)smem;
      for (int bh = blockIdx.x; bh < 64; bh += gridDim.x) {
        const float4 a = *reinterpret_cast<const float4*>(logf_ + (size_t)bh * SEQ + threadIdx.x * 8), b4 = *reinterpret_cast<const float4*>(logf_ + (size_t)bh * SEQ + threadIdx.x * 8 + 4);
        float e0 = a.x, e1 = e0 + a.y, e2 = e1 + a.z, e3 = e2 + a.w, e4 = e3 + b4.x, e5 = e4 + b4.y, e6 = e5 + b4.z, e7 = e6 + b4.w;
        float incl = e7;
#pragma unroll
        for (int o = 1; o < 64; o <<= 1) { const float t2 = __shfl_up(incl, o); if (lane >= o) incl += t2; }
        const int wv = threadIdx.x >> 6;
        if (lane == 63) red[wv] = incl;
        __syncthreads();
        float base = incl - e7;
#pragma unroll
        for (int w2 = 0; w2 < 8; ++w2) base += (w2 < wv) ? red[w2] : 0.f;
        __syncthreads();
        float* dst = c8 + (size_t)bh * SEQ + threadIdx.x * 8;
        *reinterpret_cast<float4*>(dst) = make_float4(8.f * (base + e0), 8.f * (base + e1), 8.f * (base + e2), 8.f * (base + e3));
        *reinterpret_cast<float4*>(dst + 4) = make_float4(8.f * (base + e4), 8.f * (base + e5), 8.f * (base + e6), 8.f * (base + e7));
      }
    } break;
    case 3: {
      const u16* qkv = (const u16*)(ws + QKV0); const float* c8 = (const float*)(ws + C8); u16* O = (u16*)(ws + O0);
      for (int item = blockIdx.x; item < 512; item += gridDim.x) {
        const int x = item & 7, kk = item >> 3, bh = x + 8 * (kk >> 3), j = kk & 7;
        fa::attn_unit(bh >> 4, bh & 15, j, qkv, qkv + 1024, qkv + 2048, O, c8 + (size_t)bh * SEQ, smem);
        fa::attn_unit(bh >> 4, bh & 15, fa::NQB - 1 - j, qkv, qkv + 1024, qkv + 2048, O, c8 + (size_t)bh * SEQ, smem);
      }
    } break;
    case 4: case 17: {
      const u16* A = (const u16*)(ws + (layer ? O1 : O0)); const u16* W = (const u16*)(ws + (layer ? WROUT : W0_OUT));
      const int K = layer ? 2048 : 1024;
      const float* xf = p.x; const u16* x3b = (const u16*)(ws + X3B); u16* vr = (u16*)(ws + (layer ? VR1 : VR0));
      big_gemm<true>(smem, A, W, T, 1024, K, [=](const f32x4 (&acc)[2][2][4][2], const pg8::Unit& u, int wr, int wc, int fr, int fq) {
        const int row0 = u.pm * 256 + wr * 64 + fr, col0 = u.pn * 256 + wc * 32 + 8 * fq;
#pragma unroll
        for (int ai = 0; ai < 2; ++ai) {
          f32x4 x0[4][2], x1[4][2];
#pragma unroll
          for (int m = 0; m < 4; ++m)
#pragma unroll
            for (int bj = 0; bj < 2; ++bj) { const size_t idx = (size_t)(row0 + ai * 128 + m * 16) * 1024 + col0 + bj * 128;
              if (layer == 0) { x0[m][bj] = *reinterpret_cast<const f32x4*>(xf + idx); x1[m][bj] = *reinterpret_cast<const f32x4*>(xf + idx + 4); }
              else { const uint4 xv = *reinterpret_cast<const uint4*>(x3b + idx); x0[m][bj] = bflo4(make_uint2(xv.x, xv.y)); x1[m][bj] = bflo4(make_uint2(xv.z, xv.w)); } }
#pragma unroll
          for (int m = 0; m < 4; ++m)
#pragma unroll
            for (int bj = 0; bj < 2; ++bj) { const size_t idx = (size_t)(row0 + ai * 128 + m * 16) * 1024 + col0 + bj * 128;
              *reinterpret_cast<uint4*>(vr + idx) = pk8(x0[m][bj] * ALPHA + acc[ai][bj][m][0], x1[m][bj] * ALPHA + acc[ai][bj][m][1]); }
        }
      });
      const u16* pb = (const u16*)(ws + PB); const u16* wpp = (const u16*)(ws + (layer ? W1_PP : W0_PP)); u16* pp = (u16*)(ws + (layer ? PP1 : PP0));
      big_gemm<true>(smem, pb, wpp, T, 1024, 256, [=](const f32x4 (&acc)[2][2][4][2], const pg8::Unit& u, int wr, int wc, int fr, int fq) {
        const int row0 = u.pm * 256 + wr * 64 + fr, col0 = u.pn * 256 + wc * 32 + 8 * fq;
#pragma unroll
        for (int ai = 0; ai < 2; ++ai)
#pragma unroll
          for (int m = 0; m < 4; ++m) { const size_t off = (size_t)(row0 + ai * 128 + m * 16) * 1024 + col0;
#pragma unroll
            for (int bj = 0; bj < 2; ++bj) *reinterpret_cast<uint4*>(pp + off + bj * 128) = pk8(acc[ai][bj][m][0], acc[ai][bj][m][1]); }
      });
    } break;
    case 5: case 18: {
      u16* x1b = (u16*)(ws + (layer ? X1B1 : X1B0));
      const float* g = p.ln1_g + layer * 1024; const float* bb = p.ln1_b + layer * 1024;
      const float* wg = p.w_group + (size_t)layer * 1024 * 4; const float* wrt = p.w_router + (size_t)layer * 1024 * 16;
      const float* bg = p.b_group + layer * 4; const float* br = p.b_router + layer * 16;
      int* cnt = (int*)(ws + CNT) + layer * 16; int* lists = (int*)(ws + LISTS); float* tokw = (float*)(ws + TOKW);
      float* wl = (float*)smem;
      int* lcnt = (int*)(smem + 90112); int* gbs = lcnt + 16; int* ent_e = lcnt + 32; int* ent_r = ent_e + 512; int* ent_t = ent_r + 512;
      if (threadIdx.x < 16) lcnt[threadIdx.x] = 0;
      int itn = 0;
#pragma unroll
      for (int kk = 0; kk < 2; ++kk) {
        const int k = threadIdx.x + kk * 512;
        const float4 g4 = *reinterpret_cast<const float4*>(wg + (size_t)k * 4);
        const float4 r0 = *reinterpret_cast<const float4*>(wrt + (size_t)k * 16), r1 = *reinterpret_cast<const float4*>(wrt + (size_t)k * 16 + 4);
        const float4 r2 = *reinterpret_cast<const float4*>(wrt + (size_t)k * 16 + 8), r3 = *reinterpret_cast<const float4*>(wrt + (size_t)k * 16 + 12);
        float* dw = wl + (k >> 2) * 84 + (k & 3) * 20;
        *reinterpret_cast<float4*>(dw) = g4; *reinterpret_cast<float4*>(dw + 4) = r0; *reinterpret_cast<float4*>(dw + 8) = r1;
        *reinterpret_cast<float4*>(dw + 12) = r2; *reinterpret_cast<float4*>(dw + 16) = r3;
      }
      __syncthreads();
      uint2 cur[2][4], nxt[2][4];
#pragma unroll
      for (int tt = 0; tt < 2; ++tt)
#pragma unroll
        for (int i = 0; i < 4; ++i) { cur[tt][i] = (gw * 2 < T) ? *reinterpret_cast<const uint2*>(x1b + (size_t)(gw * 2 + tt) * 1024 + i * 256 + lane * 4) : make_uint2(0u, 0u); nxt[tt][i] = cur[tt][i]; }
      for (int tok0 = gw * 2; tok0 < T; tok0 += nw * 2) {
        float4 v[2][4]; float lg[2][20];
        const int tokn = tok0 + nw * 2;
        if (tokn < T) {
#pragma unroll
          for (int tt = 0; tt < 2; ++tt)
#pragma unroll
            for (int i = 0; i < 4; ++i) nxt[tt][i] = *reinterpret_cast<const uint2*>(x1b + (size_t)(tokn + tt) * 1024 + i * 256 + lane * 4);
        }
#pragma unroll
        for (int tt = 0; tt < 2; ++tt)
#pragma unroll
          for (int i = 0; i < 4; ++i) { const f32x4 f = bflo4(cur[tt][i]); v[tt][i] = make_float4(f[0], f[1], f[2], f[3]); }
        float mu[2], rstd[2];
#pragma unroll
        for (int tt = 0; tt < 2; ++tt) {
          float s = 0.f;
#pragma unroll
          for (int i = 0; i < 4; ++i) s += v[tt][i].x + v[tt][i].y + v[tt][i].z + v[tt][i].w;
          mu[tt] = wsum(s) * (1.f / 1024.f);
          float sq = 0.f;
#pragma unroll
          for (int i = 0; i < 4; ++i) { v[tt][i].x -= mu[tt]; v[tt][i].y -= mu[tt]; v[tt][i].z -= mu[tt]; v[tt][i].w -= mu[tt];
            sq += v[tt][i].x * v[tt][i].x + v[tt][i].y * v[tt][i].y + v[tt][i].z * v[tt][i].z + v[tt][i].w * v[tt][i].w; }
          rstd[tt] = rsqrtf(wsum(sq) * (1.f / 1024.f) + LN_EPS);
#pragma unroll
          for (int o = 0; o < 20; ++o) lg[tt][o] = 0.f;
        }
#pragma unroll
        for (int i = 0; i < 4; ++i) {
          const int c0 = i * 256 + lane * 4;
          const float4 gg = *reinterpret_cast<const float4*>(g + c0), be = *reinterpret_cast<const float4*>(bb + c0);
#pragma unroll
          for (int tt = 0; tt < 2; ++tt) {
            v[tt][i].x = v[tt][i].x * rstd[tt] * gg.x + be.x; v[tt][i].y = v[tt][i].y * rstd[tt] * gg.y + be.y;
            v[tt][i].z = v[tt][i].z * rstd[tt] * gg.z + be.z; v[tt][i].w = v[tt][i].w * rstd[tt] * gg.w + be.w;
            *reinterpret_cast<uint2*>(x1b + (size_t)(tok0 + tt) * 1024 + c0) = make_uint2(pack2(v[tt][i].x, v[tt][i].y), pack2(v[tt][i].z, v[tt][i].w));
          }
          int woff = (i * 64 + lane) * 84; asm volatile("" : "+v"(woff));
          const float* wrow = wl + woff;
#pragma unroll
          for (int e = 0; e < 4; ++e) {
            const float xa = e == 0 ? v[0][i].x : (e == 1 ? v[0][i].y : (e == 2 ? v[0][i].z : v[0][i].w));
            const float xb_ = e == 0 ? v[1][i].x : (e == 1 ? v[1][i].y : (e == 2 ? v[1][i].z : v[1][i].w));
#pragma unroll
            for (int q4 = 0; q4 < 5; ++q4) {
              const float4 w4 = *reinterpret_cast<const float4*>(wrow + e * 20 + q4 * 4);
              lg[0][q4 * 4 + 0] += xa * w4.x; lg[0][q4 * 4 + 1] += xa * w4.y; lg[0][q4 * 4 + 2] += xa * w4.z; lg[0][q4 * 4 + 3] += xa * w4.w;
              lg[1][q4 * 4 + 0] += xb_ * w4.x; lg[1][q4 * 4 + 1] += xb_ * w4.y; lg[1][q4 * 4 + 2] += xb_ * w4.z; lg[1][q4 * 4 + 3] += xb_ * w4.w;
            }
          }
        }
#pragma unroll
        for (int tt = 0; tt < 2; ++tt)
#pragma unroll
          for (int o = 0; o < 20; ++o) lg[tt][o] = wsum(lg[tt][o]);
        if (lane < 2) {
          const int tok = tok0 + lane;
          float l20[20];
#pragma unroll
          for (int o = 0; o < 20; ++o) l20[o] = lane == 0 ? lg[0][o] : lg[1][o];
          float gl[4];
#pragma unroll
          for (int i = 0; i < 4; ++i) gl[i] = l20[i] + bg[i];
          int gi = 0; float gm = gl[0];
#pragma unroll
          for (int i = 1; i < 4; ++i) if (gl[i] > gm) { gm = gl[i]; gi = i; }
          float gs = 0.f;
#pragma unroll
          for (int i = 0; i < 4; ++i) gs += __expf(gl[i] - gm);
          const float gval = 1.f / gs;
          float el[4];
#pragma unroll
          for (int i = 0; i < 4; ++i) {
            const float t0 = l20[4 + i] + br[i], t1 = l20[8 + i] + br[4 + i], t2 = l20[12 + i] + br[8 + i], t3 = l20[16 + i] + br[12 + i];
            el[i] = gi == 0 ? t0 : (gi == 1 ? t1 : (gi == 2 ? t2 : t3));
          }
          int i0 = 0; float m0 = el[0];
#pragma unroll
          for (int i = 1; i < 4; ++i) if (el[i] > m0) { m0 = el[i]; i0 = i; }
          int i1 = -1; float m1 = -INFINITY;
#pragma unroll
          for (int i = 0; i < 4; ++i) if (i != i0 && el[i] > m1) { m1 = el[i]; i1 = i; }
          const float e1 = __expf(m1 - m0); const float w0 = gval / (1.f + e1), w1 = gval * e1 / (1.f + e1);
          const int ex0 = gi * 4 + i0, ex1 = gi * 4 + i1;
          const int r0 = atomicAdd(&lcnt[ex0], 1), r1 = atomicAdd(&lcnt[ex1], 1);
          const int idx = (((threadIdx.x >> 6) * 16 + itn) * 2 + lane) * 2;
          if (idx < 511) { ent_e[idx] = ex0; ent_r[idx] = r0; ent_t[idx] = tok * 2; ent_e[idx + 1] = ex1; ent_r[idx + 1] = r1; ent_t[idx + 1] = tok * 2 + 1; }
          tokw[tok * 2] = w0; tokw[tok * 2 + 1] = w1;
        }
        ++itn;
#pragma unroll
        for (int tt = 0; tt < 2; ++tt)
#pragma unroll
          for (int i = 0; i < 4; ++i) cur[tt][i] = nxt[tt][i];
      }
      __syncthreads();
      if (threadIdx.x < 16) { const int c = lcnt[threadIdx.x]; gbs[threadIdx.x] = c ? atomicAdd(&cnt[threadIdx.x], c) : 0; }
      __syncthreads();
      {
        const int wv = threadIdx.x >> 6, l2 = threadIdx.x & 63;
        if (l2 < itn * 4) { const int idx = wv * 64 + l2; const int e = ent_e[idx]; lists[e * T + gbs[e] + ent_r[idx]] = ent_t[idx]; }
      }
    } break;
    case 6: case 19: {
      const u16* x1b = (const u16*)(ws + (layer ? X1B1 : X1B0)); const u16* wgu = (const u16*)(ws + (layer ? W1_GU : W0_GU));
      u16* hb = (u16*)(ws + (layer ? HBUF1 : HBUF0));
      const int* cnt = (const int*)(ws + CNT) + layer * 16; const int* lists = (const int*)(ws + LISTS);
      auto epi = [=](const f32x4 (&acc)[2][2][4][2], const pg8::MUnit& u, int wr, int wc, int fr, int fq) {
        const int col0 = u.pn * 128 + wc * 32 + 8 * fq;
#pragma unroll
        for (int ai = 0; ai < 2; ++ai)
#pragma unroll
          for (int m = 0; m < 4; ++m) {
            const int slot = u.mt * 256 + ai * 128 + wr * 64 + m * 16 + fr;
            if (slot < u.ce) { f32x4 h0, h1;
#pragma unroll
              for (int j = 0; j < 4; ++j) { h0[j] = siluf(acc[ai][0][m][0][j]) * acc[ai][1][m][0][j]; h1[j] = siluf(acc[ai][0][m][1][j]) * acc[ai][1][m][1][j]; }
              *reinterpret_cast<uint4*>(hb + (size_t)(u.base + slot) * 512 + col0) = pk8(h0, h1); }
          }
      };
      pg8::gemm_phase_moe<0, true>((PG8_LAS unsigned char*)smem, x1b, wgu, 1024, (size_t)1024 * 1024 * 2, cnt, lists, T, epi);
      const int ntiles = moe_rem_ntiles(cnt, 8);
      run_tiles(ntiles, vbx, nvb, [&](int tile, bool valid) {
        int e, mt, ntile, base, ce; moe_rem_tile(cnt, tile, 8, e, mt, ntile, base, ce);
        if (ce == 0) valid = false;
        const int s_first = (ce >> 8) * 256 + mt * 128;
        GemmLoad L; const int r = tid >> 3, kc = ld_kc(tid);
        set_seg1(L, x1b, 0, wgu + (size_t)e * 1024 * 1024, 0, valid ? 16 : 0, tid);
#pragma unroll
        for (int i = 0; i < 4; ++i) { int s0 = s_first + r + 32 * i; if (s0 >= ce) s0 = ce > 0 ? ce - 1 : 0;
          const int t0 = valid ? (lists[e * T + s0] >> 1) : 0; L.ao[i] = (unsigned)(t0 * 1024 + kc);
          const int rr = r + 32 * i, wq = rr >> 6, w = rr & 63, comp = w >> 5, cc = ntile * 64 + wq * 32 + (w & 31);
          L.bo[i] = (unsigned)(((cc >> 7) * 256 + comp * 128 + (cc & 127)) * 1024 + kc); }
        gemm_tile(L, 16, hl, tid, [&](f32x4 (&acc)[4][4], int wr, int wc, int fr, int fq) {
          if (!valid) return;
#pragma unroll
          for (int m = 0; m < 4; ++m) {
            const int slot = s_first + wr * 64 + m * 16 + fr;
            if (slot < ce) {
#pragma unroll
              for (int n = 0; n < 2; ++n) { f32x4 hv;
#pragma unroll
                for (int j = 0; j < 4; ++j) hv[j] = siluf(acc[m][n][j]) * acc[m][n + 2][j];
                *reinterpret_cast<uint2*>(hb + (size_t)(base + slot) * 512 + ntile * 64 + wc * 32 + n * 16 + fq * 4) = pk4(hv); }
            }
          }
        });
      });
    } break;
    case 7: case 20: {
      const u16* hb = (const u16*)(ws + (layer ? HBUF1 : HBUF0)); const u16* wd = (const u16*)(ws + (layer ? W1_D : W0_D));
      u16* yb = (u16*)(ws + (layer ? YBUF1 : YBUF0));
      const int* cnt = (const int*)(ws + CNT) + layer * 16; const int* lists = (const int*)(ws + LISTS); const float* tokw = (const float*)(ws + TOKW); int* smap = (int*)(ws + SLOTMAP);
      auto epi = [=](const f32x4 (&acc)[2][2][4][2], const pg8::MUnit& u, int wr, int wc, int fr, int fq) {
        const int col0 = u.pn * 256 + wc * 32 + 8 * fq;
        int tk[2][4]; float wgt[2][4];
#pragma unroll
        for (int ai = 0; ai < 2; ++ai)
#pragma unroll
          for (int m = 0; m < 4; ++m) { int slot = u.mt * 256 + ai * 128 + wr * 64 + m * 16 + fr; slot = slot < u.ce ? slot : u.ce - 1; tk[ai][m] = lists[u.e * T + slot]; }
#pragma unroll
        for (int ai = 0; ai < 2; ++ai)
#pragma unroll
          for (int m = 0; m < 4; ++m) wgt[ai][m] = tokw[tk[ai][m]];
#pragma unroll
        for (int ai = 0; ai < 2; ++ai)
#pragma unroll
          for (int m = 0; m < 4; ++m) {
            const int slot = u.mt * 256 + ai * 128 + wr * 64 + m * 16 + fr;
            if (slot < u.ce) {
              if (u.pn == 0 && wc == 0 && fq == 0) smap[tk[ai][m]] = u.base + slot;
#pragma unroll
              for (int bj = 0; bj < 2; ++bj) *reinterpret_cast<uint4*>(yb + (size_t)(u.base + slot) * 1024 + col0 + bj * 128) = pk8(acc[ai][bj][m][0] * wgt[ai][m], acc[ai][bj][m][1] * wgt[ai][m]); }
          }
      };
      pg8::gemm_phase_moe<1, true>((PG8_LAS unsigned char*)smem, hb, wd, 512, (size_t)1024 * 512 * 2, cnt, lists, T, epi);
      const int ntiles = moe_rem_ntiles(cnt, 8);
      run_tiles(ntiles, vbx, nvb, [&](int tile, bool valid) {
        int e, mt, ntile, base, ce; moe_rem_tile(cnt, tile, 8, e, mt, ntile, base, ce);
        if (ce == 0) valid = false;
        const int s_first = (ce >> 8) * 256 + mt * 128;
        GemmLoad L; const int r = tid >> 3, kc = ld_kc(tid);
        set_seg1(L, hb, 0, wd + (size_t)e * 1024 * 512 + (size_t)ntile * 128 * 512, 512, valid ? 8 : 0, tid);
#pragma unroll
        for (int i = 0; i < 4; ++i) { int s0 = s_first + r + 32 * i; if (s0 >= ce) s0 = ce > 0 ? ce - 1 : 0; L.ao[i] = (unsigned)((base + s0) * 512 + kc); }
        gemm_tile(L, 8, hl, tid, [&](f32x4 (&acc)[4][4], int wr, int wc, int fr, int fq) {
          if (!valid) return;
#pragma unroll
          for (int m = 0; m < 4; ++m) {
            const int slot = s_first + wr * 64 + m * 16 + fr;
            if (slot < ce) {
              const int tk = lists[e * T + slot]; const float wgt = tokw[tk];
              if (ntile == 0 && wc == 0 && fq == 0) smap[tk] = base + slot;
#pragma unroll
              for (int n = 0; n < 4; ++n) *reinterpret_cast<uint2*>(yb + (size_t)(base + slot) * 1024 + ntile * 128 + wc * 64 + n * 16 + fq * 4) = pk4(acc[m][n] * wgt);
            }
          }
        });
      });
    } break;
    case 8: case 21: {
      u16* xr = (u16*)(ws + (layer ? X2B1 : X2B0)); const u16* yb = (const u16*)(ws + (layer ? YBUF1 : YBUF0)); const int* smap = (const int*)(ws + SLOTMAP);
      const float* g = p.ln2_g + layer * 1024; const float* bb = p.ln2_b + layer * 1024;
      uint2 cx[2][4], ca[2][4], cc[2][4], nx[2][4], na[2][4], nc[2][4];
      int sn[2][2], sn2[2][2];
      const int step = nw * 2;
#pragma unroll
      for (int tt = 0; tt < 2; ++tt) {
        const int tok = gw * 2 + tt; const int s0 = smap[tok * 2], s1 = smap[tok * 2 + 1];
        const int tn = tok + step < T ? tok + step : tok; sn[tt][0] = smap[tn * 2]; sn[tt][1] = smap[tn * 2 + 1]; sn2[tt][0] = sn[tt][0]; sn2[tt][1] = sn[tt][1];
#pragma unroll
        for (int i = 0; i < 4; ++i) { const int c0 = i * 256 + lane * 4;
          cx[tt][i] = *reinterpret_cast<const uint2*>(xr + (size_t)tok * 1024 + c0);
          ca[tt][i] = *reinterpret_cast<const uint2*>(yb + (size_t)s0 * 1024 + c0); cc[tt][i] = *reinterpret_cast<const uint2*>(yb + (size_t)s1 * 1024 + c0);
          nx[tt][i] = cx[tt][i]; na[tt][i] = ca[tt][i]; nc[tt][i] = cc[tt][i]; }
      }
      for (int tok0 = gw * 2; tok0 < T; tok0 += step) {
        const int tokn = tok0 + step, tokn2 = tokn + step;
        if (tokn < T) {
#pragma unroll
          for (int tt = 0; tt < 2; ++tt)
#pragma unroll
            for (int i = 0; i < 4; ++i) { const int c0 = i * 256 + lane * 4; const int tok = tokn + tt;
              nx[tt][i] = *reinterpret_cast<const uint2*>(xr + (size_t)tok * 1024 + c0);
              na[tt][i] = *reinterpret_cast<const uint2*>(yb + (size_t)sn[tt][0] * 1024 + c0); nc[tt][i] = *reinterpret_cast<const uint2*>(yb + (size_t)sn[tt][1] * 1024 + c0); }
        }
        if (tokn2 < T) {
#pragma unroll
          for (int tt = 0; tt < 2; ++tt) { sn2[tt][0] = smap[(tokn2 + tt) * 2]; sn2[tt][1] = smap[(tokn2 + tt) * 2 + 1]; }
        }
#pragma unroll
        for (int tt = 0; tt < 2; ++tt) {
          const int tok = tok0 + tt; f32x4 v[4];
#pragma unroll
          for (int i = 0; i < 4; ++i) v[i] = bflo4(cx[tt][i]) * ALPHA + (bflo4(ca[tt][i]) + bflo4(cc[tt][i]));
          float s = 0.f;
#pragma unroll
          for (int i = 0; i < 4; ++i) s += (v[i][0] + v[i][1]) + (v[i][2] + v[i][3]);
          const float mu = wsum(s) * (1.f / 1024.f);
          float sq = 0.f;
#pragma unroll
          for (int i = 0; i < 4; ++i) { v[i] = v[i] - mu; sq += (v[i][0] * v[i][0] + v[i][1] * v[i][1]) + (v[i][2] * v[i][2] + v[i][3] * v[i][3]); }
          const float rstd = rsqrtf(wsum(sq) * (1.f / 1024.f) + LN_EPS);
#pragma unroll
          for (int i = 0; i < 4; ++i) {
            const int c0 = i * 256 + lane * 4;
            const f32x4 gg = *reinterpret_cast<const f32x4*>(g + c0), be = *reinterpret_cast<const f32x4*>(bb + c0);
            *reinterpret_cast<uint2*>(xr + (size_t)tok * 1024 + c0) = pk4(v[i] * rstd * gg + be);
          }
        }
#pragma unroll
        for (int tt = 0; tt < 2; ++tt)
#pragma unroll
          for (int i = 0; i < 4; ++i) { cx[tt][i] = nx[tt][i]; ca[tt][i] = na[tt][i]; cc[tt][i] = nc[tt][i]; }
#pragma unroll
        for (int tt = 0; tt < 2; ++tt) { sn[tt][0] = sn2[tt][0]; sn[tt][1] = sn2[tt][1]; }
      }
    } break;
    case 9: case 22: {
      const u16* A = (const u16*)(ws + (layer ? X2B1 : X2B0)); const u16* W = (const u16*)(ws + (layer ? W1_PG : W0_PG));
      const u16* pp = (const u16*)(ws + (layer ? PP1 : PP0));
      const float* bgate = p.ple_b + layer * 1024; u16* x3b = (u16*)(ws + X3B); float* outp = p.out;
      big_gemm<true>(smem, A, W, T, 1024, 1024, [=](const f32x4 (&acc)[2][2][4][2], const pg8::Unit& u, int wr, int wc, int fr, int fq) {
        const int row0 = u.pm * 256 + wr * 64 + fr, col0 = u.pn * 256 + wc * 32 + 8 * fq;
#pragma unroll
        for (int bj = 0; bj < 2; ++bj) {
          const f32x4 b0 = *reinterpret_cast<const f32x4*>(bgate + col0 + bj * 128), b1 = *reinterpret_cast<const f32x4*>(bgate + col0 + bj * 128 + 4);
#pragma unroll
          for (int ai = 0; ai < 2; ++ai) {
            uint4 xv[4], pv[4];
#pragma unroll
            for (int m = 0; m < 4; ++m) { const size_t idx = (size_t)(row0 + ai * 128 + m * 16) * 1024 + col0 + bj * 128;
              xv[m] = *reinterpret_cast<const uint4*>(A + idx); pv[m] = *reinterpret_cast<const uint4*>(pp + idx); }
#pragma unroll
            for (int m = 0; m < 4; ++m) { const size_t idx = (size_t)(row0 + ai * 128 + m * 16) * 1024 + col0 + bj * 128;
              const f32x4 x0 = bflo4(make_uint2(xv[m].x, xv[m].y)), x1 = bflo4(make_uint2(xv[m].z, xv[m].w)), p0 = bflo4(make_uint2(pv[m].x, pv[m].y)), p1 = bflo4(make_uint2(pv[m].z, pv[m].w));
              const f32x4 a0 = acc[ai][bj][m][0] + b0, a1 = acc[ai][bj][m][1] + b1; f32x4 r0, r1;
#pragma unroll
              for (int j = 0; j < 4; ++j) { r0[j] = x0[j] + p0[j] / (1.f + __expf(-a0[j])); r1[j] = x1[j] + p1[j] / (1.f + __expf(-a1[j])); }
              if (layer == 0) *reinterpret_cast<uint4*>(x3b + idx) = pk8(r0, r1);
              else { *reinterpret_cast<f32x4*>(outp + idx) = r0; *reinterpret_cast<f32x4*>(outp + idx + 4) = r1; } }
          }
        }
      });
      if (layer == 0) {

      float* tl = (float*)smem;
      tconv(p.ret_w_in, 0, 6144, 1024, 6144, 1, (u16*)(ws + WRIN), 0, 0, tl);
      tconv(p.ret_w_out, 0, 1024, 2048, 1024, 1, (u16*)(ws + WROUT), 0, 0, tl);
      econv(p.p + (size_t)T * 256, (u16*)(ws + PB), (size_t)T * 256);
      float2* cs = (float2*)(ws + CS);
      const size_t gt = (size_t)blockIdx.x * 512 + threadIdx.x, gn = (size_t)gridDim.x * 512;
      for (size_t i = gt; i < (size_t)T * 128; i += gn) {
        const int tok = (int)(i >> 7), f = (int)(i & 127);
        const float invf = powf(10000.f, -(float)(2 * f) / 256.f);
        const float ang = (float)p.pos[tok] * invf;
        const double rev = (double)ang * 0.15915494309189535;
        const float fr_ = (float)(rev - rint(rev));
        cs[i] = make_float2(__builtin_amdgcn_cosf(fr_), __builtin_amdgcn_sinf(fr_));
      }
          }
    } break;
    case 10: break;
    case 11: {
      const u16* A = (const u16*)(ws + X3B); const u16* W = (const u16*)(ws + WRIN);
      u16* q1 = (u16*)(ws + Q1); u16* k1 = (u16*)(ws + K1); u16* ktd = (u16*)(ws + KTD); u16* vt = (u16*)(ws + VT);
      const float2* cs = (const float2*)(ws + CS);
      big_gemm<true>(smem, A, W, T, 2048, 1024, [=](const f32x4 (&acc)[2][2][4][2], const pg8::Unit& u, int wr, int wc, int fr, int fq) {
        const int row0 = u.pm * 256 + wr * 64 + fr;
        {
          const int isk = u.pn >> 2, hh = u.pn & 3; const int i0 = wc * 32 + 8 * fq;
          const float lg2 = gamma_log2(hh);
#pragma unroll
          for (int ai = 0; ai < 2; ++ai) {
            float4 cta[4][2], ctb[4][2];
#pragma unroll
            for (int m = 0; m < 4; ++m)
#pragma unroll
              for (int n = 0; n < 2; ++n) { const int tok = row0 + ai * 128 + m * 16;
                cta[m][n] = *reinterpret_cast<const float4*>(cs + (size_t)tok * 128 + i0 + 4 * n); ctb[m][n] = *reinterpret_cast<const float4*>(cs + (size_t)tok * 128 + i0 + 4 * n + 2); }
#pragma unroll
            for (int m = 0; m < 4; ++m) {
              const int tok = row0 + ai * 128 + m * 16;
              f32x4 r1[2], r2[2];
#pragma unroll
              for (int n = 0; n < 2; ++n) {
                const float4 ca = cta[m][n], cb = ctb[m][n];
                const f32x4 x1 = acc[ai][0][m][n], x2 = acc[ai][1][m][n];
                r1[n][0] = x1[0] * ca.x - x2[0] * ca.y; r2[n][0] = x2[0] * ca.x + x1[0] * ca.y;
                r1[n][1] = x1[1] * ca.z - x2[1] * ca.w; r2[n][1] = x2[1] * ca.z + x1[1] * ca.w;
                r1[n][2] = x1[2] * cb.x - x2[2] * cb.y; r2[n][2] = x2[2] * cb.x + x1[2] * cb.y;
                r1[n][3] = x1[3] * cb.z - x2[3] * cb.w; r2[n][3] = x2[3] * cb.z + x1[3] * cb.w;
              }
              if (!isk) {
                *reinterpret_cast<uint4*>(q1 + (size_t)tok * 1024 + hh * 256 + i0) = pk8(r1[0], r1[1]);
                *reinterpret_cast<uint4*>(q1 + (size_t)tok * 1024 + hh * 256 + 128 + i0) = pk8(r2[0], r2[1]);
              } else {
                *reinterpret_cast<uint4*>(k1 + (size_t)tok * 1024 + hh * 256 + i0) = pk8(r1[0] * 0.0625f, r1[1] * 0.0625f);
                *reinterpret_cast<uint4*>(k1 + (size_t)tok * 1024 + hh * 256 + 128 + i0) = pk8(r2[0] * 0.0625f, r2[1] * 0.0625f);
                const float kdec = exp2f((float)(255 - (tok & 255)) * lg2) * 0.0625f;
#pragma unroll
                for (int n = 0; n < 2; ++n)
#pragma unroll
                  for (int j = 0; j < 4; ++j) {
                    ktd[(size_t)(hh * 256 + i0 + 4 * n + j) * T + tok] = f2bf(r1[n][j] * kdec);
                    ktd[(size_t)(hh * 256 + 128 + i0 + 4 * n + j) * T + tok] = f2bf(r2[n][j] * kdec);
                  }
              }
            }
          }
        }
      });
      big_gemm<true>(smem, W + (size_t)2048 * 1024, A, 2048, T, 1024, [=](const f32x4 (&acc)[2][2][4][2], const pg8::Unit& u, int wr, int wc, int fr, int fq) {
        const int row0 = u.pm * 256 + wr * 64 + fr, col0 = u.pn * 256 + wc * 32 + 8 * fq;
#pragma unroll
        for (int ai = 0; ai < 2; ++ai)
#pragma unroll
          for (int m = 0; m < 4; ++m) { u16* rowp = vt + (size_t)(row0 + ai * 128 + m * 16) * T + col0;
#pragma unroll
            for (int bj = 0; bj < 2; ++bj) *reinterpret_cast<uint4*>(rowp + bj * 128) = pk8(acc[ai][bj][m][0], acc[ai][bj][m][1]); }
      });
    } break;
    case 12: {
      const u16* q1 = (const u16*)(ws + Q1); const u16* k1 = (const u16*)(ws + K1); const u16* ktd = (const u16*)(ws + KTD); const u16* vt = (const u16*)(ws + VT);
      u16* kv = (u16*)(ws + KV); u16* sp = (u16*)(ws + SP);
      pg8::gemm_phase_b<true, 256, T, T>((PG8_LAS unsigned char*)smem, vt, ktd, 512,
        [=](int L) { const int item = L >> 1, pm = L & 1; const int b = item >> 6, h = (item >> 4) & 3, c = item & 15; const long t0 = (long)b * SEQ + c * 256;
                     pg8::BUnit u; u.aoff = (long)(h * 512 + pm * 256) * T + t0; u.boff = (long)(h * 256) * T + t0; u.id = L; return u; },
        [=](const f32x4 (&acc)[2][2][4][2], const pg8::BUnit& u, int wr, int wc, int fr, int fq) {
          const int item = u.id >> 1, pm = u.id & 1;
          u16* base = kv + (size_t)item * 131072 + (size_t)(pm * 256 + wr * 64 + fr) * 256 + wc * 32 + 8 * fq;
#pragma unroll
          for (int ai = 0; ai < 2; ++ai)
#pragma unroll
            for (int m = 0; m < 4; ++m)
#pragma unroll
              for (int bj = 0; bj < 2; ++bj) *reinterpret_cast<uint4*>(base + (size_t)(ai * 128 + m * 16) * 256 + bj * 128) = pk8(acc[ai][bj][m][0], acc[ai][bj][m][1]);
        });
      run_tiles(256 * 3, vbx, nvb, [&](int tile, bool valid) {
        const int item = tile / 3, tt = tile % 3; const int mt = tt ? 1 : 0, ntile = tt == 2 ? 1 : 0; const int b = item >> 6, h = (item >> 4) & 3, c = item & 15;
        const size_t t0 = (size_t)b * SEQ + c * 256;
        GemmLoad L; set_seg1(L, q1 + (t0 + mt * 128) * 1024 + h * 256, 1024, k1 + (t0 + ntile * 128) * 1024 + h * 256, 1024, valid ? 4 : 0, tid);
        const float lg2 = gamma_log2(h);
        gemm_tile(L, 4, hl, tid, [&](f32x4 (&acc)[4][4], int wr, int wc, int fr, int fq) {
          if (!valid) return;
#pragma unroll
          for (int n = 0; n < 4; ++n) {
            const int jj = ntile * 128 + wc * 64 + n * 16 + fq * 4;
            f32x4 sc;
#pragma unroll
            for (int j = 0; j < 4; ++j) sc[j] = exp2f(-(float)(jj + j + 1) * lg2);
#pragma unroll
            for (int m = 0; m < 4; ++m) {
              const int ii = mt * 128 + wr * 64 + m * 16 + fr; f32x4 r;
#pragma unroll
              for (int j = 0; j < 4; ++j) r[j] = (jj + j <= ii) ? acc[m][n][j] * sc[j] : 0.f;
              *reinterpret_cast<uint2*>(sp + (size_t)item * 65536 + (size_t)ii * 256 + jj) = pk4(r);
            }
          }
        });
      });
    } break;
    case 13: {
      u16* kv = (u16*)(ws + KV);
      const size_t gt = (size_t)blockIdx.x * 512 + threadIdx.x, gn = (size_t)gridDim.x * 512;
      for (size_t i = gt; i < (size_t)16 * 16384; i += gn) {
        const int bh = (int)(i >> 14); const size_t el = (i & 16383) * 8; const int h = bh & 3;
        const float cd = exp2f(256.f * gamma_log2(h));
        uint4 v[16];
#pragma unroll
        for (int c = 0; c < 16; ++c) v[c] = c < 15 ? *reinterpret_cast<const uint4*>(kv + (size_t)(bh * 16 + c) * 131072 + el) : make_uint4(0u, 0u, 0u, 0u);
        float s[8];
#pragma unroll
        for (int e = 0; e < 8; ++e) s[e] = 0.f;
#pragma unroll
        for (int c = 0; c < 16; ++c) {
          *reinterpret_cast<uint4*>(kv + (size_t)(bh * 16 + c) * 131072 + el) = make_uint4(pack2(s[0], s[1]), pack2(s[2], s[3]), pack2(s[4], s[5]), pack2(s[6], s[7]));
          s[0] = s[0] * cd + __uint_as_float(v[c].x << 16); s[1] = s[1] * cd + __uint_as_float(v[c].x & 0xffff0000u);
          s[2] = s[2] * cd + __uint_as_float(v[c].y << 16); s[3] = s[3] * cd + __uint_as_float(v[c].y & 0xffff0000u);
          s[4] = s[4] * cd + __uint_as_float(v[c].z << 16); s[5] = s[5] * cd + __uint_as_float(v[c].z & 0xffff0000u);
          s[6] = s[6] * cd + __uint_as_float(v[c].w << 16); s[7] = s[7] * cd + __uint_as_float(v[c].w & 0xffff0000u);
        }
      }
    } break;
    case 14: {
      const u16* q1 = (const u16*)(ws + Q1); const u16* vt = (const u16*)(ws + VT); const u16* kv = (const u16*)(ws + KV); const u16* sp = (const u16*)(ws + SP);
      u16* o1 = (u16*)(ws + O1);
      run_tiles(256 * 8, vbx, nvb, [&](int tile, bool valid) {
        const int item = tile >> 3, mt = (tile >> 2) & 1, ntile = tile & 3; const int b = item >> 6, h = (item >> 4) & 3, c = item & 15;
        const size_t t0 = (size_t)b * SEQ + c * 256;
        GemmLoad L; set_seg1(L, sp + (size_t)item * 65536 + (size_t)mt * 128 * 256, 256, vt + (size_t)(h * 512 + ntile * 128) * T + t0, T, valid ? 2 * (mt + 1) : 0, tid);
        set_seg2(L, q1 + (t0 + mt * 128) * 1024 + h * 256, 1024, kv + (size_t)item * 131072 + (size_t)ntile * 128 * 256, 256, valid ? 4 : 0, tid);
        const float lg2 = gamma_log2(h);
        gemm_tile(L, 8, hl, tid, [&](f32x4 (&acc)[4][4], int wr, int wc, int fr, int fq) {
          if (!valid) return;
#pragma unroll
          for (int m = 0; m < 4; ++m) {
            const int ii = mt * 128 + wr * 64 + m * 16 + fr; const float sc = exp2f((float)(ii + 1) * lg2);
#pragma unroll
            for (int n = 0; n < 4; ++n) *reinterpret_cast<uint2*>(o1 + (t0 + ii) * 2048 + h * 512 + ntile * 128 + wc * 64 + n * 16 + fq * 4) = pk4(acc[m][n] * sc);
          }
        });
      });
    } break;
    case 15: {
      const u16* o1 = (const u16*)(ws + O1); float2* st = (float2*)(ws + GNST);
      for (int it0 = gw * 4; it0 < T * 4; it0 += nw * 4) {
        uint4 vv[4];
#pragma unroll
        for (int u4 = 0; u4 < 4; ++u4) vv[u4] = *reinterpret_cast<const uint4*>(o1 + (size_t)(it0 + u4) * 512 + lane * 8);
#pragma unroll
        for (int u4 = 0; u4 < 4; ++u4) {
          const uint4 v = vv[u4];
          const float f0 = __uint_as_float(v.x << 16), f1 = __uint_as_float(v.x & 0xffff0000u), f2 = __uint_as_float(v.y << 16), f3 = __uint_as_float(v.y & 0xffff0000u);
          const float f4 = __uint_as_float(v.z << 16), f5 = __uint_as_float(v.z & 0xffff0000u), f6 = __uint_as_float(v.w << 16), f7 = __uint_as_float(v.w & 0xffff0000u);
          const float mu = wsum(((f0 + f1) + (f2 + f3)) + ((f4 + f5) + (f6 + f7))) * (1.f / 512.f);
          const float d0 = f0 - mu, d1 = f1 - mu, d2 = f2 - mu, d3 = f3 - mu, d4 = f4 - mu, d5 = f5 - mu, d6 = f6 - mu, d7 = f7 - mu;
          const float rstd = rsqrtf(wsum(((d0 * d0 + d1 * d1) + (d2 * d2 + d3 * d3)) + ((d4 * d4 + d5 * d5) + (d6 * d6 + d7 * d7))) * (1.f / 512.f) + LN_EPS);
          if (lane == 0) st[it0 + u4] = make_float2(mu, rstd);
        }
      }
      float* tl = (float*)smem;
      const size_t lo = (size_t)16 * 1024 * 512;
      tconv(p.w_gate + lo, 1024 * 512, 512, 1024, 512, 16, (u16*)(ws + W1_GU), 1024 * 1024, 1, tl);
      tconv(p.w_up + lo, 1024 * 512, 512, 1024, 512, 16, (u16*)(ws + W1_GU), 1024 * 1024, 2, tl);
      tconv(p.w_down + lo, 512 * 1024, 1024, 512, 1024, 16, (u16*)(ws + W1_D), 1024 * 512, 0, tl);
      tconv(p.ple_gate + (size_t)1024 * 1024, 0, 1024, 1024, 1024, 1, (u16*)(ws + W1_PG), 0, 0, tl);
      tconv(p.ple_proj + (size_t)256 * 1024, 0, 1024, 256, 1024, 1, (u16*)(ws + W1_PP), 0, 0, tl);
    } break;
    case 16: {
      const u16* A = (const u16*)(ws + X3B); const u16* W = (const u16*)(ws + WRIN) + (size_t)4096 * 1024;
      u16* o1 = (u16*)(ws + O1); const float2* st = (const float2*)(ws + GNST);
      big_gemm<true>(smem, A, W, T, 2048, 1024, [=](const f32x4 (&acc)[2][2][4][2], const pg8::Unit& u, int wr, int wc, int fr, int fq) {
        const int row0 = u.pm * 256 + wr * 64 + fr, col0 = u.pn * 256 + wc * 32 + 8 * fq; const int hh = u.pn >> 1;
#pragma unroll
        for (int ai = 0; ai < 2; ++ai) {
          float2 ms[4]; uint4 ov[4][2];
#pragma unroll
          for (int m = 0; m < 4; ++m) { const int tok = row0 + ai * 128 + m * 16; ms[m] = st[tok * 4 + hh];
#pragma unroll
            for (int bj = 0; bj < 2; ++bj) ov[m][bj] = *reinterpret_cast<const uint4*>(o1 + (size_t)tok * 2048 + col0 + bj * 128); }
#pragma unroll
          for (int m = 0; m < 4; ++m) {
            const int tok = row0 + ai * 128 + m * 16; const float mx = ms[m].x, my = ms[m].y;
#pragma unroll
            for (int bj = 0; bj < 2; ++bj) {
              const uint4 o4 = ov[m][bj];
              const f32x4 a0 = acc[ai][bj][m][0], a1 = acc[ai][bj][m][1]; f32x4 r0, r1;
              r0[0] = siluf(a0[0]) * ((__uint_as_float(o4.x << 16) - mx) * my); r0[1] = siluf(a0[1]) * ((__uint_as_float(o4.x & 0xffff0000u) - mx) * my);
              r0[2] = siluf(a0[2]) * ((__uint_as_float(o4.y << 16) - mx) * my); r0[3] = siluf(a0[3]) * ((__uint_as_float(o4.y & 0xffff0000u) - mx) * my);
              r1[0] = siluf(a1[0]) * ((__uint_as_float(o4.z << 16) - mx) * my); r1[1] = siluf(a1[1]) * ((__uint_as_float(o4.z & 0xffff0000u) - mx) * my);
              r1[2] = siluf(a1[2]) * ((__uint_as_float(o4.w << 16) - mx) * my); r1[3] = siluf(a1[3]) * ((__uint_as_float(o4.w & 0xffff0000u) - mx) * my);
              *reinterpret_cast<uint4*>(o1 + (size_t)tok * 2048 + col0 + bj * 128) = pk8(r0, r1);
            }
          }
        }
      });
    } break;
    default: break;
    }
  }
}

#ifndef DBL
#define DBL 0u
#endif
#define GSYNC() xcd_barrier(xb)
#define PHASE(n) if (ph0 <= n && n < ph1) { run_phase<n>(p, smem); if ((DBL >> n) & 1u) { GSYNC(); run_phase<n>(p, smem); } if (n + 1 < ph1) GSYNC(); }
__global__ void __launch_bounds__(512) mega(P p, int ph0, int ph1) {
  extern __shared__ __attribute__((aligned(16))) char smem[];
  cg::grid_group grid = cg::this_grid();
  if (ph0 < 0) grid.sync();
  volatile LAS unsigned* xst = (volatile LAS unsigned*)(smem + LDS_BYTES - 16);
  if (threadIdx.x == 0) { xst[0] = 0u; xst[1] = 0u; }
  __syncthreads();
  XcdBarrier xb = xcd_barrier_post((unsigned*)(p.ws + BARW), xst);
  PHASE(0) PHASE(1) PHASE(2) PHASE(3) PHASE(4) PHASE(5) PHASE(6) PHASE(7) PHASE(8) PHASE(9) PHASE(11)
  PHASE(12) PHASE(13) PHASE(14) PHASE(15) PHASE(16) PHASE(17) PHASE(18) PHASE(19) PHASE(20) PHASE(21) PHASE(22)
}

extern "C" void kernel_launch(void* const* d_in, const int* in_sizes, int n_in, void* d_out, int out_size, void* d_ws, size_t ws_size, hipStream_t stream) {
  static int grid_blocks = 0;
  if (!grid_blocks) {
    int dev = 0, cus = 0, per_cu = 0;
    hipGetDevice(&dev);
    hipDeviceGetAttribute(&cus, hipDeviceAttributeMultiprocessorCount, dev);
    hipFuncSetAttribute((const void*)mega, hipFuncAttributeMaxDynamicSharedMemorySize, LDS_BYTES);
    hipOccupancyMaxActiveBlocksPerMultiprocessor(&per_cu, (const void*)mega, 512, LDS_BYTES);
    if (per_cu < 1) { fprintf(stderr, "occupancy query returned %d\n", per_cu); per_cu = 1; }
    grid_blocks = cus * 1;
    if (ws_size < 345 * MiB) fprintf(stderr, "workspace too small: %zu\n", ws_size);
  }
  P p{};
  p.x = (const float*)d_in[0]; p.p = (const float*)d_in[1]; p.pos = (const int*)d_in[2];
  p.fox_w_in = (const float*)d_in[3]; p.fox_b_f = (const float*)d_in[4]; p.fox_w_out = (const float*)d_in[5];
  p.ret_w_in = (const float*)d_in[6]; p.ret_w_out = (const float*)d_in[7];
  p.ln1_g = (const float*)d_in[8]; p.ln1_b = (const float*)d_in[9]; p.ln2_g = (const float*)d_in[10]; p.ln2_b = (const float*)d_in[11];
  p.w_group = (const float*)d_in[12]; p.b_group = (const float*)d_in[13]; p.w_router = (const float*)d_in[14]; p.b_router = (const float*)d_in[15];
  p.w_gate = (const float*)d_in[16]; p.w_up = (const float*)d_in[17]; p.w_down = (const float*)d_in[18];
  p.ple_proj = (const float*)d_in[19]; p.ple_gate = (const float*)d_in[20]; p.ple_b = (const float*)d_in[21];
  p.out = (float*)d_out; p.ws = (char*)d_ws;
#if MEGA
  hipMemsetAsync((char*)d_ws + BARW, 0, XCD_BAR_WORDS * 4, stream);
  int ph0 = 0, ph1 = NPH;
  void* args[] = {&p, &ph0, &ph1};
  hipError_t e = hipLaunchCooperativeKernel((const void*)mega, dim3(grid_blocks), dim3(512), args, LDS_BYTES, stream);
  if (e != hipSuccess) fprintf(stderr, "cooperative launch failed: %s (grid %d)\n", hipGetErrorString(e), grid_blocks);
#else
  for (int ph = 0; ph < NPH; ++ph) hipLaunchKernelGGL(mega, dim3(grid_blocks), dim3(512), LDS_BYTES, stream, p, ph, ph + 1);
#endif
}
```
